# Optimizing an MI355X kernel written in HIP

```python
import math
import jax, jax.numpy as jnp
from jax import lax
import numpy as np

D_MODEL = 2048
BATCH = 2
SEQ = 8192
DEPTH = 4

N_MIXERS = 2
N_MOBA = (DEPTH + 1) // 2
N_RET = DEPTH // 2

MOBA_HEAD_DIM = 128
MOBA_HEADS = D_MODEL // MOBA_HEAD_DIM
MOBA_BLOCK = 256
MOBA_TOPK = 3
MOBA_Q_CHUNK = 32
ROPE_THETA = 10000.0

RET_HEADS = max(4, D_MODEL // 256)
RET_QK_DIM = D_MODEL // RET_HEADS
RET_V_DIM = 2 * D_MODEL // RET_HEADS
RET_CHUNK = 256
GN_EPS = 1e-5

FFN_DIM = 256 * ((8 * D_MODEL // 3 + 255) // 256)
CONV_WIDTH = 3

LN_EPS = 1e-5
DEEPNORM_ALPHA = (2 * DEPTH) ** 0.25
DEEPNORM_BETA = (8 * DEPTH) ** -0.25

PAD_MULT = math.lcm(MOBA_BLOCK, RET_CHUNK, MOBA_Q_CHUNK)

kernel_name = "moba_retnet_convffn_deepnorm_hybrid"


def rope_tables(n_pos, dim):
    inv = ROPE_THETA ** (-jnp.arange(0, dim, 2, dtype=jnp.float32) / dim)
    ang = jnp.arange(n_pos, dtype=jnp.float32)[:, None] * inv[None, :]
    return jnp.cos(ang), jnp.sin(ang)


def apply_rope(t, cos, sin):
    t1, t2 = jnp.split(t, 2, axis=-1)
    c = cos.astype(t.dtype)
    s = sin.astype(t.dtype)
    return jnp.concatenate([t1 * c - t2 * s, t1 * s + t2 * c], axis=-1)


def layer_norm(x, g, b):
    xf = x.astype(jnp.float32)
    mu = xf.mean(-1, keepdims=True)
    var = jnp.square(xf - mu).mean(-1, keepdims=True)
    return ((xf - mu) * lax.rsqrt(var + LN_EPS)).astype(x.dtype) * g + b


def moba_mixer(x, w_qkv, w_o, cos, sin):
    B, S, _ = x.shape
    H, Dh, BLK, C = MOBA_HEADS, MOBA_HEAD_DIM, MOBA_BLOCK, MOBA_Q_CHUNK
    qkv = jnp.einsum('bsd,de->bse', x, w_qkv).reshape(B, S, 3, H, Dh)
    q = jnp.transpose(qkv[:, :, 0], (0, 2, 1, 3))
    k = jnp.transpose(qkv[:, :, 1], (0, 2, 1, 3))
    v = jnp.transpose(qkv[:, :, 2], (0, 2, 1, 3))
    q = apply_rope(q, cos, sin) * (Dh ** -0.5)
    k = apply_rope(k, cos, sin)
    nb = S // BLK
    kb = k.reshape(B, H, nb, BLK, Dh)
    vb = v.reshape(B, H, nb, BLK, Dh)
    k_mean = kb.astype(jnp.float32).mean(axis=3)
    topk = min(MOBA_TOPK, nb)
    n_chunks = S // C
    q_chunks = q.reshape(B, H, n_chunks, C, Dh).transpose(2, 0, 1, 3, 4)
    b_idx = jnp.arange(B)[:, None, None, None]
    h_idx = jnp.arange(H)[None, :, None, None]

    def chunk_attn(args):
        q_c, c_idx = args
        start = c_idx * C
        blk = start // BLK
        gate = jnp.einsum('bhcd,bhnd->bhcn', q_c.astype(jnp.float32), k_mean)
        gate = jnp.where(jnp.arange(nb) < blk, gate, -jnp.inf)
        _, sel = lax.top_k(gate, topk)
        sel_valid = sel < blk
        k_sel = kb[b_idx, h_idx, sel]
        v_sel = vb[b_idx, h_idx, sel]
        l_sel = jnp.einsum('bhcd,bhctkd->bhctk', q_c, k_sel,
                           preferred_element_type=jnp.float32)
        l_sel = jnp.where(sel_valid[..., None], l_sel, -jnp.inf).reshape(B, H, C, topk * BLK)
        k_own = lax.dynamic_index_in_dim(kb, blk, axis=2, keepdims=False)
        v_own = lax.dynamic_index_in_dim(vb, blk, axis=2, keepdims=False)
        l_own = jnp.einsum('bhcd,bhkd->bhck', q_c, k_own,
                           preferred_element_type=jnp.float32)
        q_pos = start + jnp.arange(C)
        k_pos = blk * BLK + jnp.arange(BLK)
        l_own = jnp.where(k_pos[None, :] <= q_pos[:, None], l_own, -jnp.inf)
        p = jax.nn.softmax(jnp.concatenate([l_sel, l_own], axis=-1), axis=-1).astype(v.dtype)
        p_sel = p[..., :topk * BLK].reshape(B, H, C, topk, BLK)
        p_own = p[..., topk * BLK:]
        return (jnp.einsum('bhctk,bhctkd->bhcd', p_sel, v_sel)
                + jnp.einsum('bhck,bhkd->bhcd', p_own, v_own))

    o = lax.map(chunk_attn, (q_chunks, jnp.arange(n_chunks, dtype=jnp.int32)))
    o = o.transpose(1, 0, 3, 2, 4).reshape(B, S, H * Dh)
    return jnp.einsum('bse,ed->bsd', o, w_o)


def retention_mixer(x, w_q, w_k, w_v, w_g, w_o, cos, sin):
    B, S, _ = x.shape
    H, dk, dv, L = RET_HEADS, RET_QK_DIM, RET_V_DIM, RET_CHUNK
    nc = S // L

    def heads(t, d):
        return t.reshape(B, S, H, d).transpose(0, 2, 1, 3)

    q = apply_rope(heads(jnp.einsum('bsd,de->bse', x, w_q), dk), cos, sin)
    k = apply_rope(heads(jnp.einsum('bsd,de->bse', x, w_k), dk), cos, sin) * (dk ** -0.5)
    v = heads(jnp.einsum('bsd,de->bse', x, w_v), dv)
    log_gamma = jnp.log1p(-jnp.exp2(-5.0 - jnp.arange(H, dtype=jnp.float32)))
    pos = jnp.arange(L, dtype=jnp.float32)
    diff = pos[:, None] - pos[None, :]
    decay = jnp.where(diff >= 0,
                      jnp.exp(jnp.maximum(diff, 0.0)[None] * log_gamma[:, None, None]),
                      0.0)
    xi = jnp.exp((pos[None, :] + 1.0) * log_gamma[:, None])
    zeta = jnp.exp((L - 1.0 - pos[None, :]) * log_gamma[:, None])
    g_chunk = jnp.exp(L * log_gamma)

    qc = q.reshape(B, H, nc, L, dk)
    kc = k.reshape(B, H, nc, L, dk)
    vc = v.reshape(B, H, nc, L, dv)
    s = jnp.einsum('bhcnd,bhcmd->bhcnm', qc, kc,
                   preferred_element_type=jnp.float32) * decay[None, :, None]
    y_inner = jnp.einsum('bhcnm,bhcme->bhcne', s.astype(v.dtype), vc)

    def step(R, inp):
        q_i, k_i, v_i = inp
        cross = jnp.einsum('bhnd,bhde->bhne', q_i.astype(jnp.float32), R) * xi[None, :, :, None]
        R = R * g_chunk[None, :, None, None] + jnp.einsum(
            'bhmd,bhme->bhde', k_i.astype(jnp.float32) * zeta[None, :, :, None],
            v_i.astype(jnp.float32))
        return R, cross

    R0 = jnp.zeros((B, H, dk, dv), jnp.float32)
    _, y_cross = lax.scan(step, R0, (qc.transpose(2, 0, 1, 3, 4),
                                     kc.transpose(2, 0, 1, 3, 4),
                                     vc.transpose(2, 0, 1, 3, 4)))
    y = y_inner.astype(jnp.float32) + y_cross.transpose(1, 2, 0, 3, 4)
    y = y.reshape(B, H, S, dv)
    mu = y.mean(-1, keepdims=True)
    var = jnp.square(y - mu).mean(-1, keepdims=True)
    y = ((y - mu) * lax.rsqrt(var + GN_EPS)).astype(x.dtype)
    y = y.transpose(0, 2, 1, 3).reshape(B, S, H * dv)
    gate = jax.nn.silu(jnp.einsum('bsd,de->bse', x, w_g))
    return jnp.einsum('bse,ed->bsd', gate * y, w_o)


def conv_ffn(x, w_in, conv_w, conv_b, w_out):
    S = x.shape[1]
    u = jnp.einsum('bsd,df->bsf', x, w_in)
    up = jnp.pad(u, ((0, 0), (CONV_WIDTH - 1, 0), (0, 0)))
    c = conv_b + up[:, 0:S] * conv_w[0]
    for j in range(1, CONV_WIDTH):
        c = c + up[:, j:j + S] * conv_w[j]
    g, val = jnp.split(c, 2, axis=-1)
    return jnp.einsum('bsf,fd->bsd', jax.nn.gelu(g) * val, w_out)


def setup_inputs(seed: int = 0) -> dict:
    key = jax.random.key(seed)
    ks = jax.random.split(key, 14)
    D, F = D_MODEL, FFN_DIM
    nrm = lambda k, shape, scale: jax.random.normal(k, shape, jnp.float32) * scale
    return {
        "x": nrm(ks[0], (BATCH, SEQ, D), 1.0),
        "moba_wqkv": nrm(ks[1], (N_MOBA, D, 3 * D), D ** -0.5),
        "moba_wo": nrm(ks[2], (N_MOBA, D, D), D ** -0.5 * DEEPNORM_BETA),
        "ret_wq": nrm(ks[3], (N_RET, D, RET_HEADS * RET_QK_DIM), D ** -0.5),
        "ret_wk": nrm(ks[4], (N_RET, D, RET_HEADS * RET_QK_DIM), D ** -0.5),
        "ret_wv": nrm(ks[5], (N_RET, D, RET_HEADS * RET_V_DIM), D ** -0.5),
        "ret_wg": nrm(ks[6], (N_RET, D, RET_HEADS * RET_V_DIM), D ** -0.5),
        "ret_wo": nrm(ks[7], (N_RET, RET_HEADS * RET_V_DIM, D),
                      (RET_HEADS * RET_V_DIM) ** -0.5 * DEEPNORM_BETA),
        "ffn_w_in": nrm(ks[8], (DEPTH, D, 2 * F), D ** -0.5),
        "ffn_conv_w": nrm(ks[9], (DEPTH, CONV_WIDTH, 2 * F), CONV_WIDTH ** -0.5),
        "ffn_conv_b": nrm(ks[10], (DEPTH, 2 * F), 0.01),
        "ffn_w_out": nrm(ks[11], (DEPTH, F, D), F ** -0.5 * DEEPNORM_BETA),
        "ln_g": 1.0 + nrm(ks[12], (DEPTH, 2, D), 0.02),
        "ln_b": nrm(ks[13], (DEPTH, 2, D), 0.02),
    }


def reference(x, moba_wqkv, moba_wo, ret_wq, ret_wk, ret_wv, ret_wg, ret_wo,
              ffn_w_in, ffn_conv_w, ffn_conv_b, ffn_w_out, ln_g, ln_b):
    B, S, _ = x.shape
    s_pad = -(-S // PAD_MULT) * PAD_MULT
    cos_a, sin_a = rope_tables(s_pad, MOBA_HEAD_DIM)
    cos_r, sin_r = rope_tables(s_pad, RET_QK_DIM)
    h = jnp.pad(x, ((0, 0), (0, s_pad - S), (0, 0)))
    for i in range(DEPTH):
        j = i // N_MIXERS
        if i % N_MIXERS == 0:
            m = moba_mixer(h, moba_wqkv[j], moba_wo[j], cos_a, sin_a)
        else:
            m = retention_mixer(h, ret_wq[j], ret_wk[j], ret_wv[j], ret_wg[j], ret_wo[j],
                                cos_r, sin_r)
        h = layer_norm(DEEPNORM_ALPHA * h + m, ln_g[i, 0], ln_b[i, 0])
        f = conv_ffn(h, ffn_w_in[i], ffn_conv_w[i], ffn_conv_b[i], ffn_w_out[i])
        h = layer_norm(DEEPNORM_ALPHA * h + f, ln_g[i, 1], ln_b[i, 1])
    return h[:, :S]
```

```cpp
#include <hip/hip_runtime.h>
#include <cstdio>
#include <cstdint>

#ifndef MK_ONE_LAUNCH
#define MK_ONE_LAUNCH 1
#endif

#define GAS __attribute__((address_space(1)))
#define LAS __attribute__((address_space(3)))
typedef unsigned short bf16;
typedef float f32x4 __attribute__((ext_vector_type(4)));
typedef float f32x2 __attribute__((ext_vector_type(2)));
typedef unsigned u32x4 __attribute__((ext_vector_type(4)));
typedef unsigned u32x2 __attribute__((ext_vector_type(2)));
typedef short bf16x8 __attribute__((ext_vector_type(8)));

constexpr int NTOK = 16384, SEQ = 8192, DM = 2048;
constexpr int MH = 16, MHD = 128, MBLK = 256, MNB = 32;
constexpr int RH = 8, RDK = 256, RDV = 512, RL = 256;
constexpr int FF = 5632, FF2 = 11264;
constexpr float ALPHA = 1.681792830507429f;
constexpr float LN_EPS = 1e-5f, GN_EPS = 1e-5f;

__device__ const float INV_A[64] = {1.000000000e+00f, 8.659643531e-01f, 7.498942018e-01f, 6.493816376e-01f, 5.623413324e-01f, 4.869675338e-01f, 4.216965139e-01f, 3.651741147e-01f, 3.162277639e-01f, 2.738419771e-01f, 2.371373773e-01f, 2.053525001e-01f, 1.778279394e-01f, 1.539926529e-01f, 1.333521456e-01f, 1.154781953e-01f, 1.000000015e-01f, 8.659642935e-02f, 7.498942316e-02f, 6.493816525e-02f, 5.623413250e-02f, 4.869675264e-02f, 4.216964915e-02f, 3.651741147e-02f, 3.162277490e-02f, 2.738419548e-02f, 2.371373773e-02f, 2.053525113e-02f, 1.778279431e-02f, 1.539926510e-02f, 1.333521400e-02f, 1.154781971e-02f, 9.999999776e-03f, 8.659643121e-03f, 7.498942316e-03f, 6.493816152e-03f, 5.623413250e-03f, 4.869675264e-03f, 4.216964822e-03f, 3.651741194e-03f, 3.162277630e-03f, 2.738419687e-03f, 2.371373819e-03f, 2.053525066e-03f, 1.778279431e-03f, 1.539926510e-03f, 1.333521446e-03f, 1.154782018e-03f, 1.000000047e-03f, 8.659643354e-04f, 7.498941850e-04f, 6.493816036e-04f, 5.623413017e-04f, 4.869675322e-04f, 4.216965172e-04f, 3.651741135e-04f, 3.162277571e-04f, 2.738419571e-04f, 2.371373703e-04f, 2.053525095e-04f, 1.778279402e-04f, 1.539926598e-04f, 1.333521504e-04f, 1.154782003e-04f};
__device__ const float INV_R[128] = {1.000000000e+00f, 9.305720329e-01f, 8.659643531e-01f, 8.058421612e-01f, 7.498942018e-01f, 6.978305578e-01f, 6.493816376e-01f, 6.042963862e-01f, 5.623413324e-01f, 5.232990980e-01f, 4.869675338e-01f, 4.531583786e-01f, 4.216965139e-01f, 3.924189806e-01f, 3.651741147e-01f, 3.398208320e-01f, 3.162277639e-01f, 2.942727208e-01f, 2.738419771e-01f, 2.548296750e-01f, 2.371373773e-01f, 2.206734121e-01f, 2.053525001e-01f, 1.910952926e-01f, 1.778279394e-01f, 1.654817164e-01f, 1.539926529e-01f, 1.433012635e-01f, 1.333521456e-01f, 1.240937784e-01f, 1.154781953e-01f, 1.074607819e-01f, 1.000000015e-01f, 9.305720776e-02f, 8.659642935e-02f, 8.058422059e-02f, 7.498942316e-02f, 6.978306174e-02f, 6.493816525e-02f, 6.042964011e-02f, 5.623413250e-02f, 5.232991278e-02f, 4.869675264e-02f, 4.531583562e-02f, 4.216964915e-02f, 3.924189880e-02f, 3.651741147e-02f, 3.398208320e-02f, 3.162277490e-02f, 2.942727134e-02f, 2.738419548e-02f, 2.548296750e-02f, 2.371373773e-02f, 2.206734009e-02f, 2.053525113e-02f, 1.910953037e-02f, 1.778279431e-02f, 1.654817164e-02f, 1.539926510e-02f, 1.433012541e-02f, 1.333521400e-02f, 1.240937784e-02f, 1.154781971e-02f, 1.074607857e-02f, 9.999999776e-03f, 9.305720218e-03f, 8.659643121e-03f, 8.058422245e-03f, 7.498942316e-03f, 6.978305988e-03f, 6.493816152e-03f, 6.042963825e-03f, 5.623413250e-03f, 5.232991185e-03f, 4.869675264e-03f, 4.531583749e-03f, 4.216964822e-03f, 3.924189601e-03f, 3.651741194e-03f, 3.398208413e-03f, 3.162277630e-03f, 2.942727180e-03f, 2.738419687e-03f, 2.548296703e-03f, 2.371373819e-03f, 2.206734149e-03f, 2.053525066e-03f, 1.910952968e-03f, 1.778279431e-03f, 1.654817141e-03f, 1.539926510e-03f, 1.433012541e-03f, 1.333521446e-03f, 1.240937738e-03f, 1.154782018e-03f, 1.074607833e-03f, 1.000000047e-03f, 9.305720450e-04f, 8.659643354e-04f, 8.058421663e-04f, 7.498941850e-04f, 6.978305755e-04f, 6.493816036e-04f, 6.042963942e-04f, 5.623413017e-04f, 5.232990952e-04f, 4.869675322e-04f, 4.531583691e-04f, 4.216965172e-04f, 3.924189659e-04f, 3.651741135e-04f, 3.398208355e-04f, 3.162277571e-04f, 2.942727297e-04f, 2.738419571e-04f, 2.548296761e-04f, 2.371373703e-04f, 2.206734061e-04f, 2.053525095e-04f, 1.910952997e-04f, 1.778279402e-04f, 1.654817170e-04f, 1.539926598e-04f, 1.433012512e-04f, 1.333521504e-04f, 1.240937709e-04f, 1.154782003e-04f, 1.074607862e-04f};
__device__ __forceinline__ float log2g(int h) {
    const float t[8] = {-4.58036896131247886e-02f, -2.27200765000835289e-02f, -1.13153132278341461e-02f, -5.64656314114206186e-03f,
                        -2.82051906237866306e-03f, -1.40957025467135363e-03f, -7.04612976589372815e-04f, -3.52263471629021439e-04f};
    float r = t[0];
#pragma unroll
    for (int i = 1; i < 8; ++i) r = (h == i) ? t[i] : r;
    return r;
}

__device__ __forceinline__ float bflo(unsigned w) { return __uint_as_float(w << 16); }
__device__ __forceinline__ float bfhi(unsigned w) { return __uint_as_float(w & 0xffff0000u); }
__device__ __forceinline__ unsigned cvt_pk_bf16(float lo, float hi) { unsigned r; asm volatile("v_cvt_pk_bf16_f32 %0, %1, %2" : "=v"(r) : "v"(lo), "v"(hi)); return r; }
__device__ __forceinline__ float shx(float v, int mask, int lane) { return __builtin_bit_cast(float, __builtin_amdgcn_ds_bpermute((lane ^ mask) << 2, __builtin_bit_cast(int, v))); }
__device__ __forceinline__ float wave_sum(float v, int lane) {
#pragma unroll
    for (int o = 1; o < 64; o <<= 1) v += shx(v, o, lane);
    return v;
}
__device__ __forceinline__ float fast_exp2(float x) { return __builtin_amdgcn_exp2f(x); }
__device__ __forceinline__ float gelu_tanh(float x) {
    const float t = x * (-2.302208198f - 0.1029432397f * x * x);
    return x * __builtin_amdgcn_rcpf(1.0f + fast_exp2(t));
}
__device__ __forceinline__ float silu(float x) { return x * __builtin_amdgcn_rcpf(1.0f + fast_exp2(-x * 1.4426950408889634f)); }
__device__ __forceinline__ void sincos_acc(float angf, float& s, float& c) {
    const double a = (double)angf;
    const double k = __builtin_rint(a * 0.63661977236758134308);
    double r = __builtin_fma(-k, 1.57079632679489655800e+00, a);
    r = __builtin_fma(-k, 6.12323399573676603587e-17, r);
    const double r2 = r * r;
    double sp = 1.0 / 6227020800.0;
    sp = sp * r2 - 1.0 / 39916800.0; sp = sp * r2 + 1.0 / 362880.0; sp = sp * r2 - 1.0 / 5040.0; sp = sp * r2 + 1.0 / 120.0; sp = sp * r2 - 1.0 / 6.0; sp = sp * r2 + 1.0;
    const double sn = sp * r;
    double cp = -1.0 / 87178291200.0;
    cp = cp * r2 + 1.0 / 479001600.0; cp = cp * r2 - 1.0 / 3628800.0; cp = cp * r2 + 1.0 / 40320.0; cp = cp * r2 - 1.0 / 720.0; cp = cp * r2 + 1.0 / 24.0; cp = cp * r2 - 0.5; cp = cp * r2 + 1.0;
    const int q = ((int)k) & 3;
    const double ss = (q & 1) ? cp : sn, cc = (q & 1) ? sn : cp;
    s = (float)((q & 2) ? -ss : ss);
    c = (float)(((q + 1) & 2) ? -cc : cc);
}

namespace pg8 {
constexpr int BM = 256, BK = 64, HALF = 128, HTB = HALF * BK * 2, STAGE_BYTES = 8 * HTB, NXCD = 8, WGM = 8;
__host__ __device__ __forceinline__ int lds_byte(int r, int c) { const int st = (r >> 4) * 2 + (c >> 5), rr = r & 15, cc = c & 31, ob = rr * 64 + cc * 2; return st * 1024 + (ob ^ (((ob >> 9) & 1) << 5)); }
__host__ __device__ __forceinline__ void stage_rc(int b, int& R, int& C) { const int st = b / 1024, sb = b % 1024, swz = sb ^ (((sb >> 9) & 1) << 5); R = (st >> 1) * 16 + swz / 64; C = (st & 1) * 32 + (swz % 64) / 2; }
__host__ __device__ __forceinline__ int perm32(int rho) { const int n = rho >> 4, i = rho & 15; return 8 * (i >> 2) + 4 * n + (i & 3); }

struct Unit { int pm, pn; };
struct Desc {
    const bf16* A; const bf16* B; const bf16* A2; const bf16* B2;
    long lda, ldb, sAm, sAn, sBm, sBn;
    int shAm, shAn, shBm, shBn;
    int nM, nN, nt, nt1;
};
__host__ __device__ inline Desc plain_desc(const bf16* A, const bf16* Bt, int M, int N, int K) {
    Desc d; d.A = A; d.B = Bt; d.A2 = A; d.B2 = Bt; d.lda = K; d.ldb = K; d.sAm = 256L * K; d.sAn = 0; d.sBm = 0; d.sBn = 256L * K;
    d.shAm = 0; d.shAn = 0; d.shBm = 0; d.shBn = 0; d.nM = M / 256; d.nN = N / 256; d.nt = K / 64; d.nt1 = K / 64; return d;
}
struct StaticOrder {
    int nM, nN, nwg, G, c;
    __device__ void init(int nM_, int nN_, int G_, int c_) { nM = nM_; nN = nN_; nwg = nM * nN; G = G_; c = c_; }
    __device__ bool next(int i, Unit& u) const {
        const int L = i * G + c; if (L >= nwg) return false;
        const int wgid = (L & (NXCD - 1)) * (nwg >> 3) + (L >> 3);
        const int nig = WGM * nN, gid = wgid / nig, rem = wgid - gid * nig;
        u.pm = gid * WGM + (rem & (WGM - 1)); u.pn = rem >> 3; return true;
    }
};

__device__ __forceinline__ float row16_sum(float v) {
    v += __builtin_bit_cast(float, __builtin_amdgcn_update_dpp(0, __builtin_bit_cast(int, v), 0xB1, 0xf, 0xf, true));
    v += __builtin_bit_cast(float, __builtin_amdgcn_update_dpp(0, __builtin_bit_cast(int, v), 0x4E, 0xf, 0xf, true));
    v += __builtin_bit_cast(float, __builtin_amdgcn_update_dpp(0, __builtin_bit_cast(int, v), 0x141, 0xf, 0xf, true));
    v += __builtin_bit_cast(float, __builtin_amdgcn_update_dpp(0, __builtin_bit_cast(int, v), 0x140, 0xf, 0xf, true));
    return v;
}
template <class T> __device__ __forceinline__ T ldo(const void* b, unsigned off) { return *(const T*)((const char*)b + off); }
template <class T> __device__ __forceinline__ void sto(void* b, unsigned off, T v) { *(T*)((char*)b + off) = v; }
#define ACC8(ai, bj, m, e) acc[ai][bj][m][(e) >> 2][(e) & 3]
__device__ __forceinline__ u32x4 pack8(const float (&x)[8]) { u32x4 w; w.x = cvt_pk_bf16(x[0], x[1]); w.y = cvt_pk_bf16(x[2], x[3]); w.z = cvt_pk_bf16(x[4], x[5]); w.w = cvt_pk_bf16(x[6], x[7]); return w; }
struct EpiBf16 {
    static constexpr bool PERM = true;
    bf16* O; unsigned ldc;
    __device__ __forceinline__ void operator()(f32x4 (&acc)[2][2][4][2], const Unit& u, int wr, int wc, int fr, int fq) const {
        const unsigned o0 = ((unsigned)(u.pm * BM + wr * 64 + fr) * ldc + (unsigned)(u.pn * BM + wc * 32 + 8 * fq)) * 2u;
#pragma unroll
        for (int ai = 0; ai < 2; ++ai)
#pragma unroll
            for (int m = 0; m < 4; ++m) { const unsigned o = o0 + (unsigned)(ai * HALF + m * 16) * ldc * 2u;
#pragma unroll
                for (int bj = 0; bj < 2; ++bj) { float x[8];
#pragma unroll
                    for (int e = 0; e < 8; ++e) x[e] = ACC8(ai, bj, m, e);
                    sto<u32x4>(O, o + bj * HALF * 2, pack8(x)); } }
    }
};

struct LnFold { const f32x2* stats; const float* gw; const float* bw; };
__device__ __forceinline__ void ln_row_stats(const f32x2* fstats, unsigned off  , float& r, float& rmu) { const f32x2 v = ldo<f32x2>(fstats, off); r = v.x; rmu = v.y; }
__device__ __forceinline__ void ln_correct_nat(f32x4 (&acc)[2][2][4][2], const LnFold& ln, const Unit& u, int wr, int wc, int fr, int fq) {
    __builtin_amdgcn_sched_barrier(0);
    const unsigned so0 = (unsigned)(u.pm * BM + wr * 64 + fr) * 8u, co0 = (unsigned)(u.pn * BM + wc * 32 + 8 * fq) * 4u;
    f32x2 st[8]; f32x4 gb[2][4];
#pragma unroll
    for (int i = 0; i < 8; ++i) st[i] = ldo<f32x2>(ln.stats, so0 + ((i >> 2) * HALF + (i & 3) * 16) * 8);
#pragma unroll
    for (int bj = 0; bj < 2; ++bj) { gb[bj][0] = ldo<f32x4>(ln.gw, co0 + bj * HALF * 4); gb[bj][1] = ldo<f32x4>(ln.gw, co0 + bj * HALF * 4 + 16); gb[bj][2] = ldo<f32x4>(ln.bw, co0 + bj * HALF * 4); gb[bj][3] = ldo<f32x4>(ln.bw, co0 + bj * HALF * 4 + 16); }
    __builtin_amdgcn_sched_barrier(0);
#pragma unroll
    for (int bj = 0; bj < 2; ++bj) {
        float gw[8], bw[8];
#pragma unroll
        for (int e = 0; e < 4; ++e) { gw[e] = gb[bj][0][e]; gw[4 + e] = gb[bj][1][e]; bw[e] = gb[bj][2][e]; bw[4 + e] = gb[bj][3][e]; }
#pragma unroll
        for (int ai = 0; ai < 2; ++ai)
#pragma unroll
            for (int m = 0; m < 4; ++m) { const float r = st[ai * 4 + m].x, rmu = st[ai * 4 + m].y;
#pragma unroll
                for (int e = 0; e < 8; ++e) ACC8(ai, bj, m, e) = ACC8(ai, bj, m, e) * r - rmu * gw[e] + bw[e]; }
        __builtin_amdgcn_sched_barrier(0);
    }
}
__device__ __forceinline__ void ln_correct_swp(f32x4 (&acc)[2][2][4][2], const LnFold& ln, const Unit& u, int wr, int wc, int fr, int fq) {
    __builtin_amdgcn_sched_barrier(0);
    const unsigned ro0 = (unsigned)(u.pm * BM + wr * 64 + fr) * 4u, so0 = (unsigned)(u.pn * BM + wc * 32 + 8 * fq) * 8u;
    float r[2][8], rmu[2][8];
#pragma unroll
    for (int bj = 0; bj < 2; ++bj)
#pragma unroll
        for (int q = 0; q < 4; ++q) { const f32x4 v = ldo<f32x4>(ln.stats, so0 + bj * HALF * 8 + q * 16); r[bj][2 * q] = v[0]; rmu[bj][2 * q] = v[1]; r[bj][2 * q + 1] = v[2]; rmu[bj][2 * q + 1] = v[3]; }
    float g8[8], b8[8];
#pragma unroll
    for (int i = 0; i < 8; ++i) { g8[i] = ldo<float>(ln.gw, ro0 + ((i >> 2) * HALF + (i & 3) * 16) * 4); b8[i] = ldo<float>(ln.bw, ro0 + ((i >> 2) * HALF + (i & 3) * 16) * 4); }
#pragma unroll
    for (int ai = 0; ai < 2; ++ai)
#pragma unroll
        for (int m = 0; m < 4; ++m) { const float g = g8[ai * 4 + m], b = b8[ai * 4 + m];
#pragma unroll
            for (int bj = 0; bj < 2; ++bj)
#pragma unroll
                for (int e = 0; e < 8; ++e) ACC8(ai, bj, m, e) = ACC8(ai, bj, m, e) * r[bj][e] - rmu[bj][e] * g + b; }
    __builtin_amdgcn_sched_barrier(0);
}
struct EpiResLN {
    static constexpr bool PERM = true;
    const float* Xin; bf16* TN; const f32x2* stats_in; f32x2* stats_out; const float* g; const float* b; float alpha; LAS f32x2* red; int tid; unsigned* pcnt; f32x2* fs_out;
    __device__ __forceinline__ void operator()(f32x4 (&acc)[2][2][4][2], const Unit& u, int wr, int wc, int fr, int fq) const {
        const unsigned row0 = (unsigned)(u.pm * BM + wr * 64 + fr), col0 = (unsigned)(u.pn * BM + wc * 32 + 8 * fq); const bool first = stats_in == nullptr;
        float gv[2][8], bv[2][8];
#pragma unroll
        for (int bj = 0; bj < 2; ++bj)
#pragma unroll
            for (int e = 0; e < 8; ++e) { gv[bj][e] = 1.f; bv[bj][e] = 0.f; }
        if (!first) {
#pragma unroll
            for (int bj = 0; bj < 2; ++bj) { const unsigned co = (col0 + bj * HALF) * 4u; const f32x4 g0 = ldo<f32x4>(g, co), g1 = ldo<f32x4>(g, co + 16), b0 = ldo<f32x4>(b, co), b1 = ldo<f32x4>(b, co + 16);
#pragma unroll
                for (int e = 0; e < 4; ++e) { gv[bj][e] = g0[e]; gv[bj][4 + e] = g1[e]; bv[bj][e] = b0[e]; bv[bj][4 + e] = b1[e]; } } }
        u32x4 q0[8], q1[8]; f32x2 qs[8];
#define RL_LOAD(i) do { const unsigned row_ = row0 + (unsigned)(((i) >> 2) * HALF + ((i) & 3) * 16); const unsigned eo_ = row_ * DM + col0; \
            q0[i] = ldo<u32x4>(TN, eo_ * 2u); q1[i] = ldo<u32x4>(TN, (eo_ + HALF) * 2u); qs[i] = ldo<f32x2>(stats_in, row_ * 8u); } while (0)
        if (!first) { RL_LOAD(0); RL_LOAD(1); }
#pragma unroll
        for (int i = 0; i < 8; ++i) { const int ai = i >> 2, m = i & 3; const unsigned row = row0 + ai * HALF + m * 16; float r = 1.f, rmu = 0.f;
                if (!first) { if (i + 2 < 8) RL_LOAD(i + 2); r = qs[i].x; rmu = qs[i].y; }
                float sm = 0.f, sq = 0.f;
#pragma unroll
                for (int bj = 0; bj < 2; ++bj) { const unsigned eo = row * DM + col0 + bj * HALF; float to[8];
                    if (first) { const f32x4 t0 = ldo<f32x4>(Xin, eo * 4u), t1 = ldo<f32x4>(Xin, eo * 4u + 16);
#pragma unroll
                        for (int e = 0; e < 4; ++e) { to[e] = t0[e]; to[4 + e] = t1[e]; } }
                    else { const u32x4 tw = bj ? q1[i] : q0[i];
#pragma unroll
                        for (int q = 0; q < 4; ++q) { to[2 * q] = bflo(tw[q]); to[2 * q + 1] = bfhi(tw[q]); } }
                    float tn[8];
#pragma unroll
                    for (int e = 0; e < 8; ++e) { const float h = (to[e] * r - rmu) * gv[bj][e] + bv[bj][e];
                        const float v = alpha * h + ACC8(ai, bj, m, e); tn[e] = v; sm += v; sq += v * v; }
                    sto<u32x4>(TN, eo * 2u, pack8(tn)); }
                { const int ln_ = fq * 16 + fr; sm += shx(sm, 16, ln_); sm += shx(sm, 32, ln_); sq += shx(sq, 16, ln_); sq += shx(sq, 32, ln_); }
                if (fq == 0) red[(ai * HALF + wr * 64 + m * 16 + fr) * 4 + wc] = (f32x2){sm, sq}; asm volatile("" ::: "memory"); }
#undef RL_LOAD
        asm volatile("s_waitcnt lgkmcnt(0)" ::: "memory"); __builtin_amdgcn_s_barrier(); asm volatile("" ::: "memory");
        if (tid < 256) { const f32x2 a = red[tid * 4 + 0], b2 = red[tid * 4 + 1], c = red[tid * 4 + 2], d = red[tid * 4 + 3];
            const float S = (a.x + b2.x) + (c.x + d.x), Q = (a.y + b2.y) + (c.y + d.y);
            __hip_atomic_store((unsigned long long*)(stats_out + (size_t)(u.pm * BM + tid) * 8 + u.pn), ((unsigned long long)__float_as_uint(Q) << 32) | __float_as_uint(S), __ATOMIC_RELAXED, __HIP_MEMORY_SCOPE_AGENT); }
        asm volatile("s_waitcnt vmcnt(0)" ::: "memory"); __builtin_amdgcn_s_barrier(); asm volatile("" ::: "memory");
        LAS unsigned* flag = (LAS unsigned*)(red + 1024);
        if (tid == 0) { const unsigned old = __hip_atomic_fetch_add(pcnt + 64 * u.pm, 1u, __ATOMIC_RELAXED, __HIP_MEMORY_SCOPE_AGENT); flag[0] = (old == 7u) ? 1u : 0u; }
        asm volatile("s_waitcnt vmcnt(0) lgkmcnt(0)" ::: "memory"); __builtin_amdgcn_s_barrier(); asm volatile("" ::: "memory");
        if (flag[0] != 0u) {
            __builtin_amdgcn_fence(__ATOMIC_ACQUIRE, "agent"); asm volatile("s_waitcnt vmcnt(0)" ::: "memory");
            if (tid < 256) { const unsigned long long* p = (const unsigned long long*)(stats_out + (size_t)(u.pm * BM + tid) * 8); float S = 0.f, Q = 0.f;
                u32x4 w4[4];
                asm volatile("global_load_dwordx4 %0, %4, off sc1\n\tglobal_load_dwordx4 %1, %4, off offset:16 sc1\n\tglobal_load_dwordx4 %2, %4, off offset:32 sc1\n\tglobal_load_dwordx4 %3, %4, off offset:48 sc1\n\ts_waitcnt vmcnt(0)"
                             : "=&v"(w4[0]), "=&v"(w4[1]), "=&v"(w4[2]), "=&v"(w4[3]) : "v"(p) : "memory");
#pragma unroll
                for (int t = 0; t < 4; ++t) { S += __uint_as_float(w4[t].x) + __uint_as_float(w4[t].z); Q += __uint_as_float(w4[t].y) + __uint_as_float(w4[t].w); }
                const float mu = S * (1.0f / DM), var = Q * (1.0f / DM) - mu * mu, r = 1.0f / sqrtf(var + LN_EPS); fs_out[u.pm * BM + tid] = (f32x2){r, r * mu}; }
        }
    }
};
struct EpiMobaQKV {
    static constexpr bool PERM = true;
    bf16* O; const f32x2* tab; LnFold ln;
    __device__ __forceinline__ void operator()(f32x4 (&acc)[2][2][4][2], const Unit& u, int wr, int wc, int fr, int fq) const {
        ln_correct_nat(acc, ln, u, wr, wc, fr, fq);
        const int which = u.pn >> 3, hh = wc >> 1, i0 = 32 * (wc & 1) + 8 * fq;
        const unsigned row0 = (unsigned)(u.pm * BM + wr * 64 + fr);
        const unsigned o0 = (row0 * (3 * DM) + (unsigned)(u.pn * BM + hh * 128 + i0)) * 2u, t0 = ((row0 & (SEQ - 1)) * 64 + i0) * 8u;
        const float scale = which == 0 ? 0.08838834764831845f : 1.0f; const bool rope = which < 2;
#pragma unroll
        for (int ai = 0; ai < 2; ++ai)
#pragma unroll
            for (int m = 0; m < 4; ++m) { const unsigned to = t0 + (ai * HALF + m * 16) * (64 * 8);
#pragma unroll
                for (int q = 0; q < 4; ++q) { f32x4 t = ldo<f32x4>(tab, to + q * 16);
                    t[0] = rope ? t[0] : 1.f; t[1] = rope ? t[1] : 0.f; t[2] = rope ? t[2] : 1.f; t[3] = rope ? t[3] : 0.f;
                    const float a0 = ACC8(ai, 0, m, 2 * q), b0 = ACC8(ai, 1, m, 2 * q), a1 = ACC8(ai, 0, m, 2 * q + 1), b1 = ACC8(ai, 1, m, 2 * q + 1);
                    ACC8(ai, 0, m, 2 * q) = (a0 * t[0] - b0 * t[1]) * scale; ACC8(ai, 1, m, 2 * q) = (a0 * t[1] + b0 * t[0]) * scale;
                    ACC8(ai, 0, m, 2 * q + 1) = (a1 * t[2] - b1 * t[3]) * scale; ACC8(ai, 1, m, 2 * q + 1) = (a1 * t[3] + b1 * t[2]) * scale; }
                if (m & 1) asm volatile("" ::: "memory"); }
        __builtin_amdgcn_sched_barrier(0);
#pragma unroll
        for (int ai = 0; ai < 2; ++ai)
#pragma unroll
            for (int m = 0; m < 4; ++m) { const unsigned o = o0 + (ai * HALF + m * 16) * (3 * DM * 2); float x1[8], x2[8];
#pragma unroll
                for (int e = 0; e < 8; ++e) { x1[e] = ACC8(ai, 0, m, e); x2[e] = ACC8(ai, 1, m, e); }
                sto<u32x4>(O, o, pack8(x1)); sto<u32x4>(O, o + 128, pack8(x2)); }
    }
};
template <bool DUALT> struct EpiRopeNat256 {
    static constexpr bool PERM = true;
    bf16* O; unsigned ldc; const f32x2* tab; float scale; LnFold ln; bf16* OT;
    __device__ __forceinline__ void operator()(f32x4 (&acc)[2][2][4][2], const Unit& u, int wr, int wc, int fr, int fq) const {
        ln_correct_nat(acc, ln, u, wr, wc, fr, fq);
        const int i0 = 32 * wc + 8 * fq; const unsigned row0 = (unsigned)(u.pm * BM + wr * 64 + fr);
        const unsigned o0 = (row0 * ldc + (unsigned)(u.pn * BM + i0)) * 2u, t0 = ((row0 & (SEQ - 1)) * 128 + i0) * 8u;
        f32x4 tb[8][4];
#define RT_LOAD(i) do { const unsigned to_ = t0 + (unsigned)(((i) >> 2) * HALF + ((i) & 3) * 16) * (128 * 8); _Pragma("unroll") for (int q_ = 0; q_ < 4; ++q_) tb[i][q_] = ldo<f32x4>(tab, to_ + q_ * 16); } while (0)
        RT_LOAD(0); RT_LOAD(1);
#pragma unroll
        for (int i = 0; i < 8; ++i) { const int ai = i >> 2, m = i & 3; if (i + 2 < 8) RT_LOAD(i + 2);
            { const unsigned o = o0 + (ai * HALF + m * 16) * ldc * 2u; float x1[8], x2[8];
#pragma unroll
                for (int q = 0; q < 4; ++q) { const f32x4 t = tb[i][q];
                    const float a0 = ACC8(ai, 0, m, 2 * q), b0 = ACC8(ai, 1, m, 2 * q), a1 = ACC8(ai, 0, m, 2 * q + 1), b1 = ACC8(ai, 1, m, 2 * q + 1);
                    x1[2 * q] = (a0 * t[0] - b0 * t[1]) * scale; x2[2 * q] = (a0 * t[1] + b0 * t[0]) * scale; x1[2 * q + 1] = (a1 * t[2] - b1 * t[3]) * scale; x2[2 * q + 1] = (a1 * t[3] + b1 * t[2]) * scale; }
                const u32x4 p1 = pack8(x1), p2 = pack8(x2);
                sto<u32x4>(O, o, p1); sto<u32x4>(O, o + HALF * 2, p2);
                if (DUALT) { const unsigned t0o = (((unsigned)(u.pn * BM + i0)) * NTOK + row0 + ai * HALF + m * 16) * 2u;
#pragma unroll
                    for (int q = 0; q < 4; ++q) { sto<unsigned short>(OT, t0o + (2 * q) * (NTOK * 2), (unsigned short)(p1[q] & 0xffffu)); sto<unsigned short>(OT, t0o + (2 * q + 1) * (NTOK * 2), (unsigned short)(p1[q] >> 16));
                        sto<unsigned short>(OT, t0o + (HALF + 2 * q) * (NTOK * 2), (unsigned short)(p2[q] & 0xffffu)); sto<unsigned short>(OT, t0o + (HALF + 2 * q + 1) * (NTOK * 2), (unsigned short)(p2[q] >> 16)); } }
                if (m & 1) asm volatile("" ::: "memory"); } }
#undef RT_LOAD
    }
};
struct EpiVT {
    static constexpr bool PERM = true;
    bf16* O; unsigned ldc; LnFold ln;
    __device__ __forceinline__ void operator()(f32x4 (&acc)[2][2][4][2], const Unit& u, int wr, int wc, int fr, int fq) const {
        ln_correct_swp(acc, ln, u, wr, wc, fr, fq);
        const unsigned o0 = ((unsigned)(u.pm * BM + wr * 64 + fr) * ldc + (unsigned)(u.pn * BM + wc * 32 + 8 * fq)) * 2u; const float l2 = log2g(u.pm >> 1);
        float sc[2][8];
#pragma unroll
        for (int bj = 0; bj < 2; ++bj)
#pragma unroll
            for (int e = 0; e < 8; ++e) sc[bj][e] = fast_exp2(-(float)(bj * HALF + wc * 32 + 8 * fq + e + 1) * l2);
#pragma unroll
        for (int ai = 0; ai < 2; ++ai)
#pragma unroll
            for (int m = 0; m < 4; ++m) { const unsigned o = o0 + (unsigned)(ai * HALF + m * 16) * ldc * 2u;
#pragma unroll
                for (int bj = 0; bj < 2; ++bj) { float x[8];
#pragma unroll
                    for (int e = 0; e < 8; ++e) x[e] = ACC8(ai, bj, m, e) * sc[bj][e];
                    sto<u32x4>(O, o + bj * HALF * 2, pack8(x)); } }
    }
};
template <int ACT, bool LN> struct EpiAct {
    static constexpr bool PERM = true;
    bf16* O; unsigned ldc; LnFold ln;
    __device__ __forceinline__ void operator()(f32x4 (&acc)[2][2][4][2], const Unit& u, int wr, int wc, int fr, int fq) const {
        if (LN) ln_correct_nat(acc, ln, u, wr, wc, fr, fq);
        const unsigned o0 = ((unsigned)(u.pm * BM + wr * 64 + fr) * ldc + (unsigned)(u.pn * BM + wc * 32 + 8 * fq)) * 2u;
#pragma unroll
        for (int ai = 0; ai < 2; ++ai)
#pragma unroll
            for (int m = 0; m < 4; ++m) { const unsigned o = o0 + (unsigned)(ai * HALF + m * 16) * ldc * 2u; const int rl = ai * HALF + wr * 64 + m * 16 + fr;
#pragma unroll
                for (int bj = 0; bj < 2; ++bj) { float x[8];
#pragma unroll
                    for (int e = 0; e < 8; ++e) { float v = ACC8(ai, bj, m, e);
                        if (ACT == 1) v = silu(v);
                        if (ACT == 2) v = (bj * HALF + wc * 32 + 8 * fq + e <= rl) ? v : 0.f;
                        x[e] = v; }
                    sto<u32x4>(O, o + bj * HALF * 2, pack8(x)); } }
    }
};
struct EpiConv {
    static constexpr bool PERM = true;
    bf16* A; bf16* UH; const float* cw; const float* cb; LnFold ln;
    static __device__ __forceinline__ float conv1(float curf, float prvf, bool has_prev, int fr, float b, float w0, float w1, float w2) {
        const int cur = __builtin_bit_cast(int, curf), prv = __builtin_bit_cast(int, prvf); int r1 = 0, r2 = 0;
        if (has_prev) { r1 = __builtin_amdgcn_update_dpp(0, prv, 0x121, 0xf, 0xf, false); r2 = __builtin_amdgcn_update_dpp(0, prv, 0x122, 0xf, 0xf, false); }
        const int p1 = __builtin_amdgcn_update_dpp(r1, cur, 0x111, 0xf, 0xf, false), p2 = __builtin_amdgcn_update_dpp(r2, cur, 0x112, 0xf, 0xf, false);
        (void)fr;
        return b + w0 * __builtin_bit_cast(float, p2) + w1 * __builtin_bit_cast(float, p1) + w2 * curf;
    }
    __device__ __forceinline__ void operator()(f32x4 (&acc)[2][2][4][2], const Unit& u, int wr, int wc, int fr, int fq) const {
        ln_correct_nat(acc, ln, u, wr, wc, fr, fq);
        const unsigned cn = (unsigned)(u.pn * 128 + wc * 32 + 8 * fq);
#pragma unroll
        for (int ai = 0; ai < 2; ++ai) { const unsigned g4 = ((unsigned)u.pm * 4 + ai * 2 + wr) * 4u;
#pragma unroll
            for (int bj = 0; bj < 2; ++bj) { float x0[8], x3[8];
#pragma unroll
                for (int e = 0; e < 8; ++e) { x0[e] = ACC8(ai, bj, 0, e); x3[e] = ACC8(ai, bj, 3, e); }
                if (fr >= 14) sto<u32x4>(UH, ((g4 + (fr - 14)) * FF2 + bj * FF + cn) * 2u, pack8(x3));
                if (fr < 2) sto<u32x4>(UH, ((g4 + 2 + fr) * FF2 + bj * FF + cn) * 2u, pack8(x0)); } }
        __builtin_amdgcn_sched_barrier(0);
        unsigned ow[2][4][4];
        f32x2 cg0[4], cg1[4], cg2[4], cgb[4], cv0[4], cv1[4], cv2[4], cvb[4];
#pragma unroll
        for (int ep = 0; ep < 4; ++ep) { const unsigned co = (cn + 2 * ep) * 4u;
            cg0[ep] = ldo<f32x2>(cw, co); cg1[ep] = ldo<f32x2>(cw, co + FF2 * 4); cg2[ep] = ldo<f32x2>(cw, co + 2 * FF2 * 4); cgb[ep] = ldo<f32x2>(cb, co);
            cv0[ep] = ldo<f32x2>(cw, co + FF * 4); cv1[ep] = ldo<f32x2>(cw, co + (FF2 + FF) * 4); cv2[ep] = ldo<f32x2>(cw, co + (2 * FF2 + FF) * 4); cvb[ep] = ldo<f32x2>(cb, co + FF * 4); }
        __builtin_amdgcn_sched_barrier(0);
#pragma unroll
        for (int ep = 0; ep < 4; ++ep) {
#pragma unroll
            for (int ai = 0; ai < 2; ++ai)
#pragma unroll
                for (int m = 3; m >= 0; --m) { float r[2];
#pragma unroll
                    for (int hl = 0; hl < 2; ++hl) { const int e = 2 * ep + hl;
                        const float cg = conv1(ACC8(ai, 0, m, e), m > 0 ? ACC8(ai, 0, m > 0 ? m - 1 : 0, e) : 0.f, m > 0, fr, cgb[ep][hl], cg0[ep][hl], cg1[ep][hl], cg2[ep][hl]);
                        const float cv = conv1(ACC8(ai, 1, m, e), m > 0 ? ACC8(ai, 1, m > 0 ? m - 1 : 0, e) : 0.f, m > 0, fr, cvb[ep][hl], cv0[ep][hl], cv1[ep][hl], cv2[ep][hl]);
                        r[hl] = gelu_tanh(cg) * cv; }
                    ow[ai][m][ep] = cvt_pk_bf16(r[0], r[1]); }
            __builtin_amdgcn_sched_barrier(0);
        }
        const unsigned o0 = ((unsigned)(u.pm * BM + wr * 64 + fr) * FF + cn) * 2u;
#pragma unroll
        for (int ai = 0; ai < 2; ++ai)
#pragma unroll
            for (int m = 0; m < 4; ++m)
                if (m > 0 || fr >= 2) sto<u32x4>(A, o0 + (unsigned)(ai * HALF + m * 16) * (FF * 2), (u32x4){ow[ai][m][0], ow[ai][m][1], ow[ai][m][2], ow[ai][m][3]});
    }
};
#undef ACC8
template <class Epi>
__device__ __forceinline__ void gemm_phase(LAS unsigned char* lds, const int tid, const Desc g, const StaticOrder& S, const Epi& E) {
    const int wid = __builtin_amdgcn_readfirstlane(tid >> 6), lane = tid & 63, wr = wid >> 2, wc = wid & 3, fr = lane & 15, fq = lane >> 4;
    const int nt = g.nt, nt1 = g.nt1;
    unsigned voffA[2], voffB[2];
#pragma unroll
    for (int i = 0; i < 2; ++i) { int R, C; stage_rc(tid * 16 + i * 8192, R, C); const int Rb = Epi::PERM ? ((R & ~31) + perm32(R & 31)) : R;
        voffA[i] = (unsigned)(R * g.lda + C) * 2u; voffB[i] = (unsigned)(Rb * g.ldb + C) * 2u; }
    const size_t kstep = (size_t)(BK * 2);
    const size_t hstepA = (size_t)HALF * g.lda * 2, hstepB = (size_t)HALF * g.ldb * 2;
    const unsigned ldsw = (unsigned)wid * 1024u;
    const int aoff = lds_byte(wr * 64 + fr, fq * 8), boff = lds_byte(wc * 32 + fr, fq * 8);
#define PG8_SA(b, h) (((b) * 2 + (h)) * HTB)
#define PG8_SB(b, h) ((4 + (b) * 2 + (h)) * HTB)
#define PG8_STAGE(bufoff, gbase, voff) do { _Pragma("unroll") for (int _i = 0; _i < 2; ++_i) { unsigned keep_; \
        asm volatile("s_mov_b32 %0, m0\n\ts_mov_b32 m0, %3\n\ts_nop 0\n\tglobal_load_lds_dwordx4 %1, %2\n\ts_mov_b32 m0, %0" : "=&s"(keep_) \
                     : "v"((voff)[_i]), "s"((unsigned long long)(uintptr_t)(gbase)), "s"((unsigned)(uintptr_t)(lds + (bufoff) + ldsw + _i * 8192)) : "memory"); } } while (0)
#define PG8_LDA(dst, b, h) do { _Pragma("unroll") for (int m = 0; m < 4; ++m) _Pragma("unroll") for (int k = 0; k < 2; ++k) dst[m][k] = *(const LAS bf16x8*)(lds + PG8_SA(b, h) + aoff + m * 2048 + k * 1024); } while (0)
#define PG8_LDB(dst, b, h) do { _Pragma("unroll") for (int n = 0; n < 2; ++n) _Pragma("unroll") for (int k = 0; k < 2; ++k) dst[n][k] = *(const LAS bf16x8*)(lds + PG8_SB(b, h) + boff + n * 2048 + k * 1024); } while (0)
#define PG8_MMA(ai, bj, At, Bt) do { __builtin_amdgcn_s_setprio(1); _Pragma("unroll") for (int m = 0; m < 4; ++m) _Pragma("unroll") for (int n = 0; n < 2; ++n) _Pragma("unroll") for (int k = 0; k < 2; ++k) \
        acc[ai][bj][m][n] = __builtin_amdgcn_mfma_f32_16x16x32_bf16(Bt[n][k], At[m][k], acc[ai][bj][m][n], 0, 0, 0); __builtin_amdgcn_s_setprio(0); } while (0)
#define PG8_WAIT_V(n) asm volatile("s_waitcnt vmcnt(" #n ")" ::: "memory")
#define PG8_WAIT_L(n) asm volatile("s_waitcnt lgkmcnt(" #n ")" ::: "memory")
#define PG8_BAR __builtin_amdgcn_s_barrier()
#define PG8_SCHED __builtin_amdgcn_sched_barrier(0)
#define PG8_PTRS(u, pa, pb) do { const long oa_ = (long)((u).pm >> g.shAm) * g.sAm + (long)((u).pn >> g.shAn) * g.sAn, ob_ = (long)((u).pm >> g.shBm) * g.sBm + (long)((u).pn >> g.shBn) * g.sBn; \
        pa = (const char*)(g.A + oa_); pb = (const char*)(g.B + ob_); } while (0)
    const long dA2 = ((const char*)g.A2 - (const char*)g.A) - (long)nt1 * (long)kstep, dB2 = ((const char*)g.B2 - (const char*)g.B) - (long)nt1 * (long)kstep;
    Unit cur, nxt; int ui = 0;
    if (!S.next(0, cur)) return;
    f32x4 acc[2][2][4][2];
#pragma unroll
    for (int a = 0; a < 2; ++a)
#pragma unroll
        for (int b = 0; b < 2; ++b)
#pragma unroll
            for (int m = 0; m < 4; ++m)
#pragma unroll
                for (int n = 0; n < 2; ++n) acc[a][b][m][n] = (f32x4){0.f, 0.f, 0.f, 0.f};
    bf16x8 At[4][2], B0[2][2], B1[2][2];
    const char *cA, *cB;
    PG8_PTRS(cur, cA, cB);
    PG8_STAGE(PG8_SB(0, 0), cB, voffB); PG8_STAGE(PG8_SB(0, 1), cB + hstepB, voffB); PG8_STAGE(PG8_SA(0, 0), cA, voffA); PG8_STAGE(PG8_SA(0, 1), cA + hstepA, voffA);
    if (wr == 1) PG8_BAR;
    PG8_WAIT_V(2); PG8_BAR;
    PG8_STAGE(PG8_SB(1, 0), cB + kstep, voffB); PG8_STAGE(PG8_SA(1, 0), cA + kstep, voffA); PG8_STAGE(PG8_SB(1, 1), cB + hstepB + kstep, voffB);
    PG8_WAIT_V(6); PG8_BAR;
    for (;;) {
        const bool has_next = S.next(ui + 1, nxt);
        const char *nA = cA, *nB = cB;
        if (has_next) PG8_PTRS(nxt, nA, nB);
        for (int t = 0; t < nt; t += 2) {
            const bool last = (t == nt - 2);
            const char* a1 = cA + (size_t)(t + 1) * kstep + ((t + 1 < nt1) ? 0L : dA2);
            const char* a2 = last ? nA : cA + (size_t)(t + 2) * kstep + ((t + 2 < nt1) ? 0L : dA2);
            const char* b2 = last ? nB : cB + (size_t)(t + 2) * kstep + ((t + 2 < nt1) ? 0L : dB2);
            const char* a3 = a2 + kstep; const char* b3 = b2 + kstep;
            PG8_LDB(B0, 0, 0); PG8_LDB(B1, 0, 1); PG8_SCHED; PG8_LDA(At, 0, 0); PG8_STAGE(PG8_SA(1, 1), a1 + hstepA, voffA);
            PG8_WAIT_V(8); PG8_WAIT_L(0); PG8_BAR; PG8_MMA(0, 0, At, B0); PG8_MMA(0, 1, At, B1); PG8_BAR; PG8_SCHED;
            PG8_LDA(At, 0, 1); PG8_STAGE(PG8_SB(0, 0), b2, voffB); PG8_STAGE(PG8_SB(0, 1), b2 + hstepB, voffB); PG8_STAGE(PG8_SA(0, 0), a2, voffA);
            PG8_WAIT_V(8); PG8_WAIT_L(0); PG8_BAR; PG8_MMA(1, 0, At, B0); PG8_MMA(1, 1, At, B1); PG8_BAR; PG8_SCHED;
            PG8_LDB(B0, 1, 0); PG8_LDB(B1, 1, 1); PG8_SCHED; PG8_LDA(At, 1, 0); PG8_STAGE(PG8_SA(0, 1), a2 + hstepA, voffA);
            PG8_WAIT_V(8); PG8_WAIT_L(0); PG8_BAR; PG8_MMA(0, 0, At, B0); PG8_MMA(0, 1, At, B1); PG8_BAR; PG8_SCHED;
            PG8_LDA(At, 1, 1); PG8_STAGE(PG8_SB(1, 0), b3, voffB); PG8_STAGE(PG8_SB(1, 1), b3 + hstepB, voffB); PG8_STAGE(PG8_SA(1, 0), a3, voffA);
            PG8_WAIT_V(8); PG8_WAIT_L(0); PG8_BAR; PG8_MMA(1, 0, At, B0); PG8_MMA(1, 1, At, B1); PG8_BAR; PG8_SCHED;
        }
        if (wr == 0) PG8_BAR;
        { int lane_e, wr_ = wr, wc_ = wc; asm volatile("v_mbcnt_lo_u32_b32 %0, -1, 0\n\tv_mbcnt_hi_u32_b32 %0, -1, %0" : "=v"(lane_e)); asm volatile("" : "+s"(wr_), "+s"(wc_));
          E(acc, cur, wr_, wc_, lane_e & 15, lane_e >> 4); }
        if (!has_next) break;
#pragma unroll
        for (int a = 0; a < 2; ++a)
#pragma unroll
            for (int b = 0; b < 2; ++b)
#pragma unroll
                for (int m = 0; m < 4; ++m)
#pragma unroll
                    for (int n = 0; n < 2; ++n) acc[a][b][m][n] = (f32x4){0.f, 0.f, 0.f, 0.f};
        cur = nxt; cA = nA; cB = nB; ++ui;
        if (wr == 1) PG8_BAR;
    }
    PG8_WAIT_V(0);
    PG8_BAR;
#undef PG8_SA
#undef PG8_SB
#undef PG8_STAGE
#undef PG8_LDA
#undef PG8_LDB
#undef PG8_MMA
#undef PG8_WAIT_V
#undef PG8_WAIT_L
#undef PG8_BAR
#undef PG8_SCHED
#undef PG8_PTRS
}
}

constexpr size_t MiB = 1u << 20;
constexpr size_t WS_CTL = 0, CTL_ZERO_BYTES = 1 * MiB;
constexpr size_t WS_TABA = 2 * MiB;
constexpr size_t WS_TABR = 6 * MiB;
constexpr size_t WS_KMEAN = 14 * MiB;
constexpr size_t WS_W = 16 * MiB;
constexpr size_t W_MQKV = WS_W, W_MO = W_MQKV + 48 * MiB, W_RQ = W_MO + 16 * MiB, W_RK = W_RQ + 16 * MiB, W_RV = W_RK + 16 * MiB,
                 W_RG = W_RV + 32 * MiB, W_RO = W_RG + 32 * MiB, W_FI = W_RO + 32 * MiB, W_FO = W_FI + 176 * MiB, W_END = W_FO + 88 * MiB;
constexpr size_t WS_HN = W_END;
constexpr size_t WS_ACT = WS_HN + 64 * MiB;
constexpr size_t A_QKV = WS_ACT, A_MO = WS_ACT + 192 * MiB, A_MLIST = A_MO + 64 * MiB, A_MPO = A_MLIST + 32 * MiB, A_MPML = A_MPO + 192 * MiB;
constexpr size_t A_U = WS_ACT, A_FA = WS_ACT + 352 * MiB;
constexpr size_t A_RQ = WS_ACT, A_RK = A_RQ + 64 * MiB, A_RKT = A_RK + 64 * MiB, A_RVT = A_RKT + 64 * MiB, A_RG = A_RVT + 128 * MiB,
                 A_RP = A_RG + 128 * MiB, A_RU = A_RP + 64 * MiB, A_RRT = A_RU + 128 * MiB, A_REND = A_RRT + 128 * MiB;
constexpr size_t WS_TABRT = A_REND;
constexpr size_t WS_KMP = WS_TABRT + 8 * MiB;
constexpr size_t WS_STATS = WS_KMP + 3 * MiB;
constexpr size_t WS_FSTATS = WS_STATS + 1 * MiB;
constexpr int NCOLG = 75776;
constexpr int CO_M1 = 0, CO_R = 6144, CO_F = 30720, CO_ID = NCOLG, NCOLT = NCOLG + 6144;
constexpr size_t WS_GWP = WS_STATS + 2 * MiB;
constexpr size_t WS_GW = WS_GWP + 20 * MiB;
constexpr size_t WS_NEED = WS_GW + 1 * MiB;
static_assert(W_END == 472 * MiB && WS_ACT == 536 * MiB && WS_NEED == 1338 * MiB && 2 * 32 * NCOLG * 4 <= 20 * MiB, "ws map");

constexpr int RING_BYTES = 131072, LDSCTL_OFF = 144384, MISC_OFF = LDSCTL_OFF + 320, LDS_BYTES = 147456;
constexpr int NWAVES = 8;

#define XB_TMO      128
#define XB_XCNT(j)  (256  + 64 * (j))
#define XB_XSUB(j)  (1280 + 64 * (j))
#define XB_XGEN(j)  (2304 + 64 * (j))
#define XB_TOP      3328
#define XB_TOPGEN   3392
#define XCD_BAR_WORDS 3456
#define XB_SPIN_CAP (1u << 18)
constexpr int CW_BAR = 4096, CW_PANEL = 16384, CW_CNT = 8192;
__device__ __forceinline__ unsigned xb_ld(unsigned* p)              { return __hip_atomic_load(p, __ATOMIC_RELAXED, __HIP_MEMORY_SCOPE_AGENT); }
__device__ __forceinline__ unsigned xb_add(unsigned* p, unsigned v) { return __hip_atomic_fetch_add(p, v, __ATOMIC_RELAXED, __HIP_MEMORY_SCOPE_AGENT); }
__device__ __forceinline__ unsigned xb_xcc_id() { return (unsigned)__builtin_amdgcn_s_getreg((3 << 11) | 20) & 0xFu; }
#define XB_SPIN(cond, bar) do { unsigned _sp = 0; while (cond) { __builtin_amdgcn_s_sleep(1); \
    if ((++_sp & 255u) == 0u) { if (xb_ld(&(bar)[XB_TMO])) break; if (_sp > XB_SPIN_CAP) { atomicAdd(&(bar)[XB_TMO], 1u); break; } } } } while (0)
struct XcdBarrier { unsigned* bar; unsigned x; volatile LAS unsigned* st; };
__device__ __forceinline__ XcdBarrier xcd_barrier_post(unsigned* bar, volatile LAS unsigned* st) {
    XcdBarrier b; b.bar = bar; b.x = xb_xcc_id(); b.st = st;
    if (threadIdx.x == 0) (void)xb_add(&bar[XB_XCNT(b.x)], 1u);
    return b;
}
__device__ __forceinline__ void xcd_barrier_complete(unsigned* bar, unsigned x, unsigned& nloc, unsigned& nx) {
    const unsigned G = gridDim.x * gridDim.y * gridDim.z;
    unsigned sum, cnt, mine, sp = 0u;
    for (;;) {
        sum = 0u; cnt = 0u; mine = 0u;
#pragma unroll
        for (unsigned j = 0; j < 16; ++j) { const unsigned c = xb_ld(&bar[XB_XCNT(j)]); sum += c; cnt += (c > 0u) ? 1u : 0u; mine = (j == x) ? c : mine; }
        if (sum == G) break;
        __builtin_amdgcn_s_sleep(1);
        if ((++sp & 255u) == 0u) { if (xb_ld(&bar[XB_TMO])) break; if (sp > XB_SPIN_CAP) { atomicAdd(&bar[XB_TMO], 1u); break; } }
    }
    nloc = mine > 0u ? mine : 1u; nx = cnt > 0u ? cnt : 1u;
}
__device__ __forceinline__ void xcd_barrier(const XcdBarrier& b) {
    asm volatile("s_waitcnt vmcnt(0)" ::: "memory");
    __syncthreads();
    if (threadIdx.x == 0) {
        unsigned* bar = b.bar;
        __builtin_amdgcn_s_waitcnt(0);
        unsigned nloc = b.st[0], nx = b.st[1];
        if (nloc == 0u) { xcd_barrier_complete(bar, b.x, nloc, nx); b.st[0] = nloc; b.st[1] = nx; }
        const unsigned old = xb_add(&bar[XB_XSUB(b.x)], 1u);
        const unsigned gen = old / nloc;
        if (old + 1u == (gen + 1u) * nloc) {
            __builtin_amdgcn_fence(__ATOMIC_RELEASE, "agent");
            asm volatile("s_waitcnt vmcnt(0)" ::: "memory");
            const unsigned og = xb_add(&bar[XB_TOP], 1u);
            const unsigned tg = og / nx;
            if (og + 1u == (tg + 1u) * nx) xb_add(&bar[XB_TOPGEN], 1u);
            else XB_SPIN(xb_ld(&bar[XB_TOPGEN]) == tg, bar);
            __builtin_amdgcn_fence(__ATOMIC_ACQUIRE, "agent");
            xb_add(&bar[XB_XGEN(b.x)], 1u);
            asm volatile("s_waitcnt vmcnt(0)" ::: "memory");
        } else {
            XB_SPIN(xb_ld(&bar[XB_XGEN(b.x)]) == gen, bar);
            __builtin_amdgcn_fence(__ATOMIC_ACQUIRE, "agent");
            asm volatile("s_waitcnt vmcnt(0)" ::: "memory");
        }
    }
    __syncthreads();
}

struct Args {
    const float* in[14];
    float* out; unsigned char* ws;
    int ph_lo, ph_hi;
};
struct Ctx { int tid, lane, wave, bid, G, gw, NGW, gt, NGT; LAS unsigned char* lds; };

__device__ __forceinline__ void transpose_item(const int PERMODE, const float* W, int K, int N, bf16* WT, LAS float* scr, int item, int lane, const float* fg, const float* fb, float* pgw) {
    const int kblk = K / 64, nb = item / kblk, kb = item % kblk, k0 = 64 * kb, n0 = 64 * nb;
    const int fh = n0 >= FF ? 1 : 0, fw = n0 - fh * FF;
    const int r0 = PERMODE == 1 ? ((n0 >> 8) * 256 + ((n0 >> 6) & 1) * 128 + ((n0 >> 7) & 1) * 64) : PERMODE == 2 ? ((fw >> 7) * 256 + fh * 128 + (fw & 127)) : n0;
    f32x4 v[16];
    const float* src = W + (size_t)(k0 + (lane >> 4)) * N + n0 + 4 * (lane & 15);
#pragma unroll
    for (int i = 0; i < 16; ++i) v[i] = *(const f32x4*)(src + (size_t)(4 * i) * N);
#pragma unroll
    for (int i = 0; i < 16; ++i) { LAS float* d = scr + (4 * i + (lane >> 4)) * 65 + 4 * (lane & 15); d[0] = v[i][0]; d[1] = v[i][1]; d[2] = v[i][2]; d[3] = v[i][3]; }
    asm volatile("s_waitcnt lgkmcnt(0)" ::: "memory");
    const int c = lane & 7;
    float gk[8], bk[8];
#pragma unroll
    for (int t = 0; t < 8; ++t) { gk[t] = 1.f; bk[t] = 0.f; }
    if (fg) {
        const f32x4 g0 = *(const f32x4*)(fg + k0 + 8 * c), g1 = *(const f32x4*)(fg + k0 + 8 * c + 4), b0 = *(const f32x4*)(fb + k0 + 8 * c), b1 = *(const f32x4*)(fb + k0 + 8 * c + 4);
#pragma unroll
        for (int t = 0; t < 4; ++t) { gk[t] = g0[t]; gk[4 + t] = g1[t]; bk[t] = b0[t]; bk[4 + t] = b1[t]; } }
#pragma unroll
    for (int j = 0; j < 8; ++j) { const int n = (lane >> 3) + 8 * j; const LAS float* q = scr + (8 * c) * 65 + n;
        float w[8];
#pragma unroll
        for (int t = 0; t < 8; ++t) w[t] = q[t * 65];
        u32x4 o; o.x = cvt_pk_bf16(w[0] * gk[0], w[1] * gk[1]); o.y = cvt_pk_bf16(w[2] * gk[2], w[3] * gk[3]); o.z = cvt_pk_bf16(w[4] * gk[4], w[5] * gk[5]); o.w = cvt_pk_bf16(w[6] * gk[6], w[7] * gk[7]);
        *(u32x4*)(WT + (size_t)(r0 + n) * K + k0 + 8 * c) = o;
        if (fg) {
            float pg = ((bflo(o.x) + bfhi(o.x)) + (bflo(o.y) + bfhi(o.y))) + ((bflo(o.z) + bfhi(o.z)) + (bflo(o.w) + bfhi(o.w)));
            float pb = ((w[0] * bk[0] + w[1] * bk[1]) + (w[2] * bk[2] + w[3] * bk[3])) + ((w[4] * bk[4] + w[5] * bk[5]) + (w[6] * bk[6] + w[7] * bk[7]));
            pg += shx(pg, 1, lane); pg += shx(pg, 2, lane); pg += shx(pg, 4, lane); pb += shx(pb, 1, lane); pb += shx(pb, 2, lane); pb += shx(pb, 4, lane);
            if (c == 0) { pgw[(size_t)kb * NCOLG + r0 + n] = pg; pgw[(size_t)(32 + kb) * NCOLG + r0 + n] = pb; } } }
    asm volatile("s_waitcnt lgkmcnt(0)" ::: "memory");
}
__device__ __forceinline__ void ph_prologue(const Ctx& C, const Args& a) {
    unsigned char* ws = a.ws;
    {
        LAS float* scr = (LAS float*)(C.lds + C.wave * 16640);
        constexpr int PJ = 12288, PL = 8448, NJ = 2 * PJ, NIT = NJ + 4 * PL;
        for (int g = C.gw; g < NIT; g += C.NGW) {
            const float* W; bf16* WT; int K, N, item; int perm = 0; int lnidx = -1, cob = 0;
            if (g < NJ) { const int j = g / PJ, r = g % PJ;
                if (r < 3072)      { W = a.in[1] + (size_t)j * DM * 3 * DM; WT = (bf16*)(ws + W_MQKV) + (size_t)j * 3 * DM * DM; K = DM; N = 3 * DM; item = r; perm = 1; if (j == 1) { lnidx = 3; cob = CO_M1; } }
                else if (r < 4096) { W = a.in[2] + (size_t)j * DM * DM; WT = (bf16*)(ws + W_MO) + (size_t)j * DM * DM; K = DM; N = DM; item = r - 3072; }
                else if (r < 5120) { W = a.in[3] + (size_t)j * DM * DM; WT = (bf16*)(ws + W_RQ) + (size_t)j * DM * DM; K = DM; N = DM; item = r - 4096; lnidx = 4 * j + 1; cob = CO_R + j * 12288; }
                else if (r < 6144) { W = a.in[4] + (size_t)j * DM * DM; WT = (bf16*)(ws + W_RK) + (size_t)j * DM * DM; K = DM; N = DM; item = r - 5120; lnidx = 4 * j + 1; cob = CO_R + j * 12288 + 2048; }
                else if (r < 8192) { W = a.in[5] + (size_t)j * DM * 2 * DM; WT = (bf16*)(ws + W_RV) + (size_t)j * 2 * DM * DM; K = DM; N = 2 * DM; item = r - 6144; lnidx = 4 * j + 1; cob = CO_R + j * 12288 + 4096; }
                else if (r < 10240) { W = a.in[6] + (size_t)j * DM * 2 * DM; WT = (bf16*)(ws + W_RG) + (size_t)j * 2 * DM * DM; K = DM; N = 2 * DM; item = r - 8192; lnidx = 4 * j + 1; cob = CO_R + j * 12288 + 8192; }
                else               { W = a.in[7] + (size_t)j * 2 * DM * DM; WT = (bf16*)(ws + W_RO) + (size_t)j * 2 * DM * DM; K = 2 * DM; N = DM; item = r - 10240; }
            } else { const int l = (g - NJ) / PL, r = (g - NJ) % PL;
                if (r < 5632) { W = a.in[8] + (size_t)l * DM * FF2; WT = (bf16*)(ws + W_FI) + (size_t)l * FF2 * DM; K = DM; N = FF2; item = r; perm = 2; lnidx = 2 * l; cob = CO_F + l * 11264; }
                else          { W = a.in[11] + (size_t)l * FF * DM; WT = (bf16*)(ws + W_FO) + (size_t)l * FF * DM; K = FF; N = DM; item = r - 5632; }
            }
            const float* fg = lnidx >= 0 ? a.in[12] + (size_t)lnidx * DM : nullptr; const float* fb = lnidx >= 0 ? a.in[13] + (size_t)lnidx * DM : nullptr;
            transpose_item(perm, W, K, N, WT, scr, item, C.lane, fg, fb, (float*)(ws + WS_GWP) + cob);
        }
    }
    f32x2* ta = (f32x2*)(ws + WS_TABA); f32x2* tr = (f32x2*)(ws + WS_TABR);
    for (int i = C.gt; i < SEQ * 64; i += C.NGT) { const int pos = i >> 6, f = i & 63; float s, c; sincos_acc((float)pos * INV_A[f], s, c); ta[i] = (f32x2){c, s}; }
    for (int i = C.gt; i < SEQ * 128; i += C.NGT) { const int pos = i >> 7, f = i & 127; float s, c; sincos_acc((float)pos * INV_R[f], s, c); tr[i] = (f32x2){c, s}; }
    { f32x4* st = (f32x4*)(ws + WS_FSTATS);
      for (int i = C.gt; i < NTOK / 2; i += C.NGT) st[i] = (f32x4){1.f, 0.f, 1.f, 0.f}; }
    const f32x4* x4 = (const f32x4*)a.in[0]; u32x2* hn = (u32x2*)(ws + WS_HN);
    for (int i = C.gt; i < NTOK * DM / 4; i += 4 * C.NGT) { f32x4 v[4];
#pragma unroll
        for (int q = 0; q < 4; ++q) v[q] = x4[i + q * C.NGT];
#pragma unroll
        for (int q = 0; q < 4; ++q) hn[i + q * C.NGT] = (u32x2){cvt_pk_bf16(v[q][0], v[q][1]), cvt_pk_bf16(v[q][2], v[q][3])}; }
}
__device__ __forceinline__ void ph_stats_final(const Ctx& C, const f32x2* part, f32x2* FS) {
    for (int row = C.gt; row < NTOK; row += C.NGT) { const f32x4* p = (const f32x4*)(part + (size_t)row * 8); const f32x4 a = p[0], b = p[1], c = p[2], d = p[3];
        const float S = ((a[0] + a[2]) + (b[0] + b[2])) + ((c[0] + c[2]) + (d[0] + d[2])), Q = ((a[1] + a[3]) + (b[1] + b[3])) + ((c[1] + c[3]) + (d[1] + d[3]));
        const float mu = S * (1.0f / DM), var = Q * (1.0f / DM) - mu * mu, r = 1.0f / sqrtf(var + LN_EPS); FS[row] = (f32x2){r, r * mu}; }
}
__device__ __forceinline__ void ph_fold_reduce(const Ctx& C, const float* P, float* GWv) {
    for (int i = C.gt; i < 2 * NCOLT; i += C.NGT) { const int which = i / NCOLT, col = i % NCOLT; float s = 0.f;
        if (col < NCOLG) for (int kb = 0; kb < 32; ++kb) s += P[(size_t)(which * 32 + kb) * NCOLG + col];
        GWv[i] = s; }
}
__device__ __forceinline__ void ph_ln_final(const Ctx& C, const bf16* TNp, float* Out, const float* g, const float* bta) {
    f32x4 gq[8], bq[8];
#pragma unroll
    for (int j = 0; j < 4; ++j) { const int c0 = 512 * j + 8 * C.lane; gq[2 * j] = *(const f32x4*)(g + c0); gq[2 * j + 1] = *(const f32x4*)(g + c0 + 4); bq[2 * j] = *(const f32x4*)(bta + c0); bq[2 * j + 1] = *(const f32x4*)(bta + c0 + 4); }
    int row = C.gw; u32x4 w4[4];
    if (row < NTOK) {
#pragma unroll
        for (int j = 0; j < 4; ++j) w4[j] = ((const u32x4*)(TNp + (size_t)row * DM) + C.lane)[64 * j]; }
#pragma unroll 1
    for (; row < NTOK; row += C.NGW) {
        u32x4 n4[4]; const int nr = row + C.NGW;
        if (nr < NTOK) {
#pragma unroll
            for (int j = 0; j < 4; ++j) n4[j] = ((const u32x4*)(TNp + (size_t)nr * DM) + C.lane)[64 * j]; }
        else {
#pragma unroll
            for (int j = 0; j < 4; ++j) n4[j] = (u32x4){0u, 0u, 0u, 0u}; }
        float v[32]; float s = 0.f;
#pragma unroll
        for (int j = 0; j < 4; ++j) {
#pragma unroll
            for (int q = 0; q < 4; ++q) { v[8 * j + 2 * q] = bflo(w4[j][q]); v[8 * j + 2 * q + 1] = bfhi(w4[j][q]); s += v[8 * j + 2 * q] + v[8 * j + 2 * q + 1]; } }
        const float mean = wave_sum(s, C.lane) * (1.f / DM); float s2 = 0.f;
#pragma unroll
        for (int j = 0; j < 32; ++j) { v[j] -= mean; s2 += v[j] * v[j]; }
        const float rstd = 1.f / sqrtf(wave_sum(s2, C.lane) * (1.f / DM) + LN_EPS);
#pragma unroll
        for (int j = 0; j < 4; ++j) { const int c0 = 512 * j + 8 * C.lane;
            f32x4 o0, o1;
#pragma unroll
            for (int e = 0; e < 4; ++e) { o0[e] = v[8 * j + e] * rstd * gq[2 * j][e] + bq[2 * j][e]; o1[e] = v[8 * j + 4 + e] * rstd * gq[2 * j + 1][e] + bq[2 * j + 1][e]; }
            *(f32x4*)(Out + (size_t)row * DM + c0) = o0; *(f32x4*)(Out + (size_t)row * DM + c0 + 4) = o1; }
#pragma unroll
        for (int j = 0; j < 4; ++j) w4[j] = n4[j];
    }
}
__device__ __forceinline__ void ph_kmean(const Ctx& C, const bf16* QKV, float* KMo) {
    for (int it = C.gw; it < 2 * MH * MNB; it += C.NGW) {
        const int b = it / (MH * MNB), h = (it / MNB) % MH, j = it % MNB, c = C.lane & 15, rs = C.lane >> 4;
        const bf16* kp = QKV + (size_t)(b * SEQ + j * MBLK + rs) * (3 * DM) + DM + h * MHD + 8 * c;
        float a[8];
#pragma unroll
        for (int e = 0; e < 8; ++e) a[e] = 0.f;
#pragma unroll 1
        for (int r0 = 0; r0 < MBLK / 4; r0 += 16) {
            u32x4 w[16];
#pragma unroll
            for (int r = 0; r < 16; ++r) w[r] = *(const u32x4*)(kp + (size_t)(4 * (r0 + r)) * (3 * DM));
#pragma unroll
            for (int r = 0; r < 16; ++r)
#pragma unroll
                for (int q = 0; q < 4; ++q) { a[2 * q] += bflo(w[r][q]); a[2 * q + 1] += bfhi(w[r][q]); } }
#pragma unroll
        for (int e = 0; e < 8; ++e) { a[e] += shx(a[e], 16, C.lane); a[e] += shx(a[e], 32, C.lane); a[e] *= (1.0f / MBLK); }
        if (rs == 0) { float* o = KMo + (size_t)((b * MH + h) * MNB + j) * MHD + 8 * c; *(f32x4*)o = (f32x4){a[0], a[1], a[2], a[3]}; *(f32x4*)(o + 4) = (f32x4){a[4], a[5], a[6], a[7]}; }
    }
}

namespace mattn {
constexpr int D = 128, KVBLK = 64, SHM_V = KVBLK * D * 2, SHM_K = KVBLK * D * 2;
constexpr int OFF_V = 0, OFF_K = 2 * SHM_V, OFF_WS = 2 * SHM_V + 2 * SHM_K, OFF_STG = OFF_WS + 8 * 1024, OFF_PRE = OFF_STG + 8 * 8192, OFF_WT = OFF_PRE + 1032 * 4;
constexpr long LDQ = 3 * DM;
constexpr int LIST_CAP = 8192;
constexpr float C2 = 1.4426950408889634f;
constexpr float THR = 8.f;
typedef float f32x16 __attribute__((ext_vector_type(16)));
typedef short s16x4 __attribute__((ext_vector_type(4)));
#define KSWZ(row, colB) ((row) * 256 + ((colB) ^ (((row) & 7) << 4)))
#define SBAR() __builtin_amdgcn_sched_barrier(0)
__device__ __forceinline__ int v_st(int k, int c) { const int kk = (k & ~0xC) | ((k & 4) << 1) | ((k & 8) >> 1); return ((kk >> 3) * 4 + (c >> 5)) * 512 + ((kk & 7) * 32 + (c & 31)) * 2; }
__device__ __forceinline__ int v_rd_base(int lane) { return ((lane & 3) << 3) | (((lane >> 2) & 3) << 6) | (((lane >> 4) & 1) << 5) | (((lane >> 5) & 1) << 8); }
constexpr int v_rd_off(int d0, int ks, int half) { return d0 * 512 + ks * 4096 + half * 2048; }
__device__ __forceinline__ int crow(int r, int hi) { return (r & 3) + 8 * (r >> 2) + 4 * hi; }
__device__ __forceinline__ void partialSM(f32x16& p0, f32x16& p1, float& m_reg, float& mn, float& alpha) {
    float pmax = p0[0];
#pragma unroll
    for (int r = 1; r < 16; ++r) pmax = fmaxf(pmax, p0[r]);
#pragma unroll
    for (int r = 0; r < 16; ++r) pmax = fmaxf(pmax, p1[r]);
    { auto rr = __builtin_amdgcn_permlane32_swap(__float_as_uint(pmax), __float_as_uint(pmax), false, false);
      pmax = fmaxf(__uint_as_float(rr[0]), __uint_as_float(rr[1])); }
    if (__builtin_expect(__all((pmax - m_reg) <= THR), 1)) { mn = m_reg; alpha = 1.f; }
    else { mn = fmaxf(m_reg, pmax); alpha = __builtin_amdgcn_exp2f((m_reg - mn) * C2); m_reg = mn; }
    const float mnL = -mn * C2;
#pragma unroll
    for (int r = 0; r < 16; ++r) p0[r] = fmaf(p0[r], C2, mnL);
#pragma unroll
    for (int r = 0; r < 16; ++r) p1[r] = fmaf(p1[r], C2, mnL);
#pragma unroll
    for (int r = 0; r < 16; ++r) p0[r] = __builtin_amdgcn_exp2f(p0[r]);
}
__device__ __forceinline__ void finishSM(f32x16& p0, f32x16& p1, float alpha, float& l_reg, bf16x8& pa0, bf16x8& pa1, bf16x8& pa2, bf16x8& pa3) {
#pragma unroll
    for (int r = 0; r < 16; ++r) p1[r] = __builtin_amdgcn_exp2f(p1[r]);
    float ps = 0;
#pragma unroll
    for (int r = 0; r < 16; ++r) ps += p0[r];
#pragma unroll
    for (int r = 0; r < 16; ++r) ps += p1[r];
    { auto rr = __builtin_amdgcn_permlane32_swap(__float_as_uint(ps), __float_as_uint(ps), false, false);
      ps = __uint_as_float(rr[0]) + __uint_as_float(rr[1]); }
    l_reg = l_reg * alpha + ps;
#define PK4(P, B_, OUT) do { unsigned a0 = cvt_pk_bf16(P[B_+0], P[B_+1]), a1 = cvt_pk_bf16(P[B_+2], P[B_+3]);                          \
        unsigned b0 = cvt_pk_bf16(P[B_+4], P[B_+5]), b1 = cvt_pk_bf16(P[B_+6], P[B_+7]);                                             \
        auto r0 = __builtin_amdgcn_permlane32_swap(a0, b0, false, false); auto r1 = __builtin_amdgcn_permlane32_swap(a1, b1, false, false); \
        u32x4 w = {r0[0], r1[0], r0[1], r1[1]}; OUT = __builtin_bit_cast(bf16x8, w); } while (0)
    PK4(p0, 0, pa0); PK4(p0, 8, pa1); PK4(p1, 0, pa2); PK4(p1, 8, pa3);
#undef PK4
}
template <int KB>
__device__ __forceinline__ void qkt(f32x16& p0, f32x16& p1, const LAS char* K_lds, int r32, int hi, const bf16x8* qr) {
    p0 = f32x16{}; p1 = f32x16{};
    const LAS char* kb[4];
#pragma unroll
    for (int dd = 0; dd < 4; ++dd) kb[dd] = K_lds + KB * SHM_K + KSWZ(r32, (dd * 16 + hi * 8) * 2);
#pragma unroll
    for (int d0 = 0; d0 < 8; ++d0) { const LAS char* a = kb[d0 & 3] + (d0 >> 2) * 128;
        const bf16x8 b0 = *(const LAS bf16x8*)a;
        const bf16x8 b1 = *(const LAS bf16x8*)(a + 32 * 256);
        p0 = __builtin_amdgcn_mfma_f32_32x32x16_bf16(b0, qr[d0], p0, 0, 0, 0);
        p1 = __builtin_amdgcn_mfma_f32_32x32x16_bf16(b1, qr[d0], p1, 0, 0, 0); }
}
template <int VB>
__device__ __forceinline__ void pv_tile(f32x16* o, int vb0, bf16x8 pa0, bf16x8 pa1, bf16x8 pa2, bf16x8 pa3) {
#define TRRD(dst, off) asm volatile("ds_read_b64_tr_b16 %0, %1 offset:%2" : "=&v"(dst) : "v"(vb0), "i"(off) : "memory")
#define PV_D0(d0) do { s16x4 l0, l1, l2, l3, h0, h1, h2, h3; constexpr int b_ = VB * SHM_V + v_rd_off(d0, 0, 0); \
        TRRD(l0, b_); TRRD(h0, b_ + 2048); TRRD(l1, b_ + 4096); TRRD(h1, b_ + 6144); TRRD(l2, b_ + 8192); TRRD(h2, b_ + 10240); TRRD(l3, b_ + 12288); TRRD(h3, b_ + 14336); \
        asm volatile("s_waitcnt lgkmcnt(0)" ::: "memory"); SBAR(); \
        o[d0] = __builtin_amdgcn_mfma_f32_32x32x16_bf16(pa0, (bf16x8){l0[0], l0[1], l0[2], l0[3], h0[0], h0[1], h0[2], h0[3]}, o[d0], 0, 0, 0);   \
        o[d0] = __builtin_amdgcn_mfma_f32_32x32x16_bf16(pa1, (bf16x8){l1[0], l1[1], l1[2], l1[3], h1[0], h1[1], h1[2], h1[3]}, o[d0], 0, 0, 0);   \
        o[d0] = __builtin_amdgcn_mfma_f32_32x32x16_bf16(pa2, (bf16x8){l2[0], l2[1], l2[2], l2[3], h2[0], h2[1], h2[2], h2[3]}, o[d0], 0, 0, 0);   \
        o[d0] = __builtin_amdgcn_mfma_f32_32x32x16_bf16(pa3, (bf16x8){l3[0], l3[1], l3[2], l3[3], h3[0], h3[1], h3[2], h3[3]}, o[d0], 0, 0, 0); } while (0)
    PV_D0(0); PV_D0(1); PV_D0(2); PV_D0(3);
#undef PV_D0
#undef TRRD
}
struct AttnItem { const bf16* qrow; const bf16* Kb; const bf16* Vb; };
__device__ __forceinline__ void attn_offs(int wid, int lane, unsigned (&koff)[2], unsigned (&voff)[2]) {
#pragma unroll
    for (int i = 0; i < 2; ++i) { const int pi = wid * 2 + i, row = 4 * pi + (lane >> 4), c = (lane & 15) ^ (row & 7); koff[i] = (unsigned)(row * (int)LDQ + c * 8) * 2u;
        const int st = pi * 2 + (lane >> 5), kk = ((st >> 2) << 3) | ((lane & 31) >> 2), k = (kk & ~0xC) | ((kk & 4) << 1) | ((kk & 8) >> 1), cc = (st & 3) * 32 + (lane & 3) * 8; voff[i] = (unsigned)(k * (int)LDQ + cc) * 2u; }
}
#define SDMA(KB_, VB_, t, bf) do { _Pragma("unroll") for (int i_ = 0; i_ < 2; ++i_) { \
        __builtin_amdgcn_global_load_lds((const unsigned*)((const char*)(KB_) + (size_t)(t) * 64 * LDQ * 2 + koff[i_]), (LAS unsigned*)(K_lds + (bf) * SHM_K + (wid * 2 + i_) * 1024), 16, 0, 0); \
        __builtin_amdgcn_global_load_lds((const unsigned*)((const char*)(VB_) + (size_t)(t) * 64 * LDQ * 2 + voff[i_]), (LAS unsigned*)(V_lds + (bf) * SHM_V + (wid * 2 + i_) * 1024), 16, 0, 0); } } while (0)
__device__ __forceinline__ void attn_prime(LAS char* lds, int tid, const AttnItem& it, bf16x8 (&qr)[8]) {
    const int wid = __builtin_amdgcn_readfirstlane(tid >> 6), lane = tid & 63, hi = lane >> 5;
    LAS char* V_lds = lds + OFF_V; LAS char* K_lds = lds + OFF_K; unsigned koff[2], voff[2]; attn_offs(wid, lane, koff, voff);
#pragma unroll
    for (int d0 = 0; d0 < 8; ++d0) qr[d0] = *(const bf16x8*)(it.qrow + d0 * 16 + hi * 8);
    SDMA(it.Kb, it.Vb, 0, 0);
}
template <bool CAUSAL, int NST, class Hook>
__device__ __forceinline__ void attn_core(LAS char* lds, int tid, const AttnItem& cur, const AttnItem& nxt, bool has_next, bool first, bf16x8 (&qr)[8], f32x16 (&o)[4], float& m_reg, float& l_reg, Hook hook) {
    const int wid = __builtin_amdgcn_readfirstlane(tid >> 6), lane = tid & 63, r32 = lane & 31, hi = lane >> 5;
    LAS char* V_lds = lds + OFF_V; LAS char* K_lds = lds + OFF_K;
    LAS float* al_l = (LAS float*)(lds + OFF_WS) + wid * 256;
    const int vb0 = (int)(unsigned)(uintptr_t)V_lds + v_rd_base(lane);
    unsigned koff[2], voff[2]; attn_offs(wid, lane, koff, voff);
    m_reg = -1e30f; l_reg = 0.f;
#pragma unroll
    for (int d = 0; d < 4; ++d) o[d] = f32x16{};
    const int qrel0 = wid * 32;
    if (first) asm volatile("s_waitcnt vmcnt(0)" ::: "memory"); else asm volatile("s_waitcnt vmcnt(%0)" :: "n"(NST) : "memory");
    __syncthreads();
    hook();
#define TILE(t, BUF) do { \
        if ((t) < 3) SDMA(cur.Kb, cur.Vb, (t) + 1, 1 - (BUF)); else if (has_next) SDMA(nxt.Kb, nxt.Vb, 0, 0); \
        if (!CAUSAL || (t) * 64 <= qrel0 + 31) { \
            f32x16 pA0, pA1; float mn, al; bf16x8 pa0, pa1, pa2, pa3; \
            qkt<BUF>(pA0, pA1, K_lds, r32, hi, qr); \
            if ((t) == 3 && has_next) { _Pragma("unroll") for (int d0 = 0; d0 < 8; ++d0) qr[d0] = *(const bf16x8*)(nxt.qrow + d0 * 16 + hi * 8); } \
            if (CAUSAL && (t) * 64 + 63 > qrel0) { const int dq = qrel0 + r32 - (t) * 64 - 4 * hi; const float NEG = -__builtin_inff(); \
                _Pragma("unroll") for (int r = 0; r < 16; ++r) { const int c = (r & 3) + 8 * (r >> 2); if (dq - c < 0) pA0[r] = NEG; if (dq - c - 32 < 0) pA1[r] = NEG; } } \
            partialSM(pA0, pA1, m_reg, mn, al); \
            if (__any(al < 1.f)) { if (hi == 0) al_l[r32] = al; asm volatile("s_waitcnt lgkmcnt(0)" ::: "memory"); \
                _Pragma("unroll") for (int d_ = 0; d_ < 4; ++d_) _Pragma("unroll") for (int r = 0; r < 16; ++r) o[d_][r] *= al_l[crow(r, hi)]; } \
            finishSM(pA0, pA1, al, l_reg, pa0, pa1, pa2, pa3); SBAR(); \
            pv_tile<BUF>(o, vb0, pa0, pa1, pa2, pa3); } \
        else if ((t) == 3 && has_next) { _Pragma("unroll") for (int d0 = 0; d0 < 8; ++d0) qr[d0] = *(const bf16x8*)(nxt.qrow + d0 * 16 + hi * 8); } \
        if ((t) < 3) asm volatile("s_waitcnt vmcnt(0)" ::: "memory"); \
        __syncthreads(); } while (0)
    TILE(0, 0); TILE(1, 1); TILE(2, 0); TILE(3, 1);
#undef TILE
}
#undef SDMA
#undef KSWZ
#undef SBAR
}

__device__ __forceinline__ void stage_o(LAS unsigned short* stg, const mattn::f32x16 (&o)[4], const LAS float* scale, int r32, int hi) {
#pragma unroll
    for (int r = 0; r < 16; ++r) { const int rr = mattn::crow(r, hi); const float f = scale ? scale[rr] : 1.f;
#pragma unroll
        for (int d0 = 0; d0 < 4; ++d0) stg[rr * 128 + d0 * 32 + r32] = (unsigned short)cvt_pk_bf16(o[d0][r] * f, 0.f); }
    asm volatile("s_waitcnt lgkmcnt(0)" ::: "memory");
}
__device__ __forceinline__ void ph_moba_route(const Ctx& C, const bf16* QKV, const float* KMp, unsigned* cnt, unsigned* list) {
    for (int it = C.gw; it < 2 * MH * 128; it += C.NGW) {
        const int b = it >> 11, qg = b ? 127 - (it & 127) : (it & 127), h = (it >> 7) & 15, blk = qg >> 2;
        if (blk == 0) continue;
        const int pos = qg * 64 + C.lane, tok = b * SEQ + pos;
        const bf16* qp = QKV + (size_t)tok * (3 * DM) + h * MHD;
        u32x4 qv[16];
#pragma unroll
        for (int i = 0; i < 16; ++i) qv[i] = *(const u32x4*)(qp + 8 * i);
        int s0 = 0, s1 = 0, s2 = 0; float v0 = -__builtin_inff(), v1 = v0, v2 = v0;
        const float* km = KMp + (size_t)((b * MH + h) * MNB) * MHD;
        for (int j = 0; j < blk; ++j) {
            const float* kj = km + j * MHD; float s = 0.f;
#pragma unroll
            for (int i = 0; i < 16; ++i) { const f32x4 ka = *(const f32x4*)(kj + 8 * i), kb = *(const f32x4*)(kj + 8 * i + 4);
                s += bflo(qv[i].x) * ka[0] + bfhi(qv[i].x) * ka[1] + bflo(qv[i].y) * ka[2] + bfhi(qv[i].y) * ka[3]
                   + bflo(qv[i].z) * kb[0] + bfhi(qv[i].z) * kb[1] + bflo(qv[i].w) * kb[2] + bfhi(qv[i].w) * kb[3]; }
            const bool g0 = s > v0, g1 = s > v1, g2 = s > v2;
            v2 = g1 ? v1 : (g2 ? s : v2); s2 = g1 ? s1 : (g2 ? j : s2);
            v1 = g0 ? v0 : (g1 ? s : v1); s1 = g0 ? s0 : (g1 ? j : s1);
            v0 = g0 ? s : v0;             s0 = g0 ? j : s0;
        }
        const int nsel = blk < 3 ? blk : 3; const int base = (b * MH + h) * MNB;
        if (nsel > 0) { const unsigned idx = atomicAdd(cnt + base + s0, 1u); list[(size_t)(base + s0) * mattn::LIST_CAP + idx] = (unsigned)pos; }
        if (nsel > 1) { const unsigned idx = atomicAdd(cnt + base + s1, 1u); list[(size_t)(base + s1) * mattn::LIST_CAP + idx] = (unsigned)pos | (1u << 13); }
        if (nsel > 2) { const unsigned idx = atomicAdd(cnt + base + s2, 1u); list[(size_t)(base + s2) * mattn::LIST_CAP + idx] = (unsigned)pos | (2u << 13); }
    }
}
__device__ __forceinline__ void ph_moba_sel(const Ctx& C, const bf16* QKV, const unsigned* cnt, const unsigned* list, bf16* PO, f32x2* PML) {
    using namespace mattn;
    LAS char* lds = (LAS char*)C.lds;
    LAS int* pre = (LAS int*)(lds + OFF_PRE); LAS int* wtot = (LAS int*)(lds + OFF_WT);
    const int tid = C.tid, wid = C.wave, lane = C.lane, r32 = lane & 31, hi = lane >> 5;
    {
        const int c0 = (int)cnt[2 * tid], c1 = (int)cnt[2 * tid + 1], n0 = (c0 + 255) >> 8, n1 = (c1 + 255) >> 8, x = n0 + n1; int incl = x;
#pragma unroll
        for (int o = 1; o < 64; o <<= 1) { const int y = __builtin_amdgcn_ds_bpermute((lane - o) << 2, incl); if (lane >= o) incl += y; }
        if (lane == 63) wtot[wid] = incl;
        __syncthreads();
        int woff = 0;
        for (int w = 0; w < wid; ++w) woff += wtot[w];
        const int excl = woff + incl - x;
        pre[2 * tid] = excl | (((c0 - 1) & 255) << 16); pre[2 * tid + 1] = (excl + n0) | (((c1 - 1) & 255) << 16); if (tid == 511) pre[1024] = excl + x;
        __syncthreads();
    }
    const int T = pre[1024];
#define SEL_DECODE(item_, bhj_, n_, ent_, valid_, AI_) do { int lo_ = 0, hi_ = 1024; \
        while (hi_ - lo_ > 1) { const int mid = (lo_ + hi_) >> 1; if ((pre[mid] & 0xffff) <= (item_)) lo_ = mid; else hi_ = mid; } \
        bhj_ = lo_; const int pw_ = pre[bhj_], chunk_ = (item_) - (pw_ & 0xffff), nch_ = (pre[bhj_ + 1] & 0xffff) - (pw_ & 0xffff); n_ = (chunk_ == nch_ - 1) ? ((pw_ >> 16) & 255) + 1 : 256; \
        valid_ = (wid * 32 + r32) < n_; ent_ = list[(size_t)bhj_ * LIST_CAP + chunk_ * 256 + (valid_ ? (wid * 32 + r32) : 0)]; \
        { const int j_ = bhj_ & 31, h_ = (bhj_ >> 5) & 15, b_ = bhj_ >> 9; AI_.qrow = QKV + (size_t)(b_ * SEQ + (int)(ent_ & 8191u)) * LDQ + h_ * MHD; \
          AI_.Kb = QKV + (size_t)(b_ * SEQ + j_ * MBLK) * LDQ + DM + h_ * MHD; AI_.Vb = AI_.Kb + DM; } } while (0)
    int item = (C.G & 7) == 0 ? (C.bid & 7) * (C.G >> 3) + (C.bid >> 3) : C.bid; if (item >= T) return;
    int bhj, n; unsigned ent; bool valid; AttnItem cur; bf16x8 qr[8];
    SEL_DECODE(item, bhj, n, ent, valid, cur);
    attn_prime(lds, tid, cur, qr);
    bool first = true;
    const unsigned dummy_po = (unsigned)(WS_TABRT - A_MPO) + (unsigned)((C.bid * NWAVES + wid) * 4096);
    const size_t dummy_ml = (WS_KMP - A_MPML) / sizeof(f32x2) + (size_t)C.gt;
    for (;;) {
        const int nitem = item + C.G; const bool has_next = nitem < T;
        int bhj2 = bhj, n2 = n; unsigned ent2 = ent; bool valid2 = valid; AttnItem nxt = cur;
        const int h = (bhj >> 5) & 15, b = bhj >> 9, pos = ent & 8191, slot = ent >> 13;
        f32x16 o[4]; float m_reg, l_reg;
        attn_core<false, 9>(lds, tid, cur, nxt, has_next, first, qr, o, m_reg, l_reg, [&]() { if (has_next) SEL_DECODE(nitem, bhj2, n2, ent2, valid2, nxt); });
        first = false;
        const size_t trow = (size_t)slot * NTOK + (size_t)(b * SEQ + pos);
        PML[(valid && hi == 0) ? trow * MH + h : dummy_ml] = (f32x2){m_reg, l_reg};
        LAS unsigned* dtab = (LAS unsigned*)((LAS float*)(lds + OFF_WS) + wid * 256 + 64);
        if (hi == 0) dtab[r32] = valid ? (unsigned)((trow * DM + h * MHD) * 2) : dummy_po + (unsigned)(r32 & 15) * 256u;
        LAS unsigned short* stg = (LAS unsigned short*)(lds + OFF_STG) + wid * 4096;
        stage_o(stg, o, nullptr, r32, hi);
#pragma unroll
        for (int i = 0; i < 8; ++i) { const int rw = (lane >> 4) + 4 * i, c = lane & 15; const unsigned d = dtab[rw];
            const u32x4 v = *(const LAS u32x4*)(stg + rw * 128 + c * 8);
            *(u32x4*)((char*)PO + d + c * 16) = v; }
        asm volatile("s_waitcnt lgkmcnt(0)" ::: "memory");
        if (!has_next) break;
        item = nitem; bhj = bhj2; n = n2; ent = ent2; valid = valid2; cur = nxt;
    }
#undef SEL_DECODE
}
__device__ __forceinline__ void ph_moba_own(const Ctx& C, const bf16* QKV, const bf16* PO, const f32x2* PML, bf16* O) {
    using namespace mattn;
    LAS char* lds = (LAS char*)C.lds;
    const int tid = C.tid, wid = C.wave, lane = C.lane, r32 = lane & 31, hi = lane >> 5;
    LAS float* tb = (LAS float*)(lds + OFF_WS) + wid * 256 + 64;
#define OWN_DECODE(item_, AI_) do { const int qb_ = (item_) & 31, h_ = ((item_) >> 5) & 15, b_ = (item_) >> 9; \
        AI_.qrow = QKV + (size_t)(b_ * SEQ + qb_ * MBLK + wid * 32 + r32) * LDQ + h_ * MHD; AI_.Kb = QKV + (size_t)(b_ * SEQ + qb_ * MBLK) * LDQ + DM + h_ * MHD; AI_.Vb = AI_.Kb + DM; } while (0)
    if (C.bid >= 2 * MH * MNB) return;
    AttnItem cur; bf16x8 qr[8]; OWN_DECODE(C.bid, cur);
    attn_prime(lds, tid, cur, qr);
    for (int item = C.bid; item < 2 * MH * MNB; item += C.G) {
        const int qb = item & 31, h = (item >> 5) & 15, b = item >> 9;
        const int tok = b * SEQ + qb * MBLK + wid * 32 + r32;
        const bool has_next = item + C.G < 2 * MH * MNB; AttnItem nxt = cur; if (has_next) OWN_DECODE(item + C.G, nxt);
        const int nsel = qb < 3 ? qb : 3;
        f32x16 o[4]; float m_reg, l_reg;
        attn_core<true, 8>(lds, tid, cur, nxt, has_next, item == C.bid, qr, o, m_reg, l_reg, []() {});
        LAS unsigned short* stg = (LAS unsigned short*)(lds + OFF_STG) + wid * 4096;
        stage_o(stg, o, nullptr, r32, hi);
        const int tok0 = b * SEQ + qb * MBLK + wid * 32;
        f32x2 ml[3];
#pragma unroll
        for (int sl = 0; sl < 3; ++sl) ml[sl] = (sl < nsel) ? PML[((size_t)sl * NTOK + tok) * MH + h] : (f32x2){-1e30f, 0.f};
        u32x4 pv[3][8];
#pragma unroll
        for (int sl = 0; sl < 3; ++sl)
#pragma unroll
            for (int i = 0; i < 8; ++i) { const int rw = (lane >> 4) + 4 * i, c = lane & 15;
                pv[sl][i] = (sl < nsel) ? *(const u32x4*)(PO + (size_t)sl * NTOK * DM + (size_t)(tok0 + rw) * DM + h * MHD + c * 8) : (u32x4){0u, 0u, 0u, 0u}; }
        {
            float M = m_reg;
#pragma unroll
            for (int sl = 0; sl < 3; ++sl) M = fmaxf(M, ml[sl].x);
            const float fo = __builtin_amdgcn_exp2f((m_reg - M) * C2); float L = l_reg * fo; float fs[3];
#pragma unroll
            for (int sl = 0; sl < 3; ++sl) { fs[sl] = (sl < nsel) ? __builtin_amdgcn_exp2f((ml[sl].x - M) * C2) : 0.f; L += ml[sl].y * fs[sl]; }
            const float inv = 1.0f / L;
            if (hi == 0) { tb[r32] = fo * inv; tb[32 + r32] = fs[0] * inv; tb[64 + r32] = fs[1] * inv; tb[96 + r32] = fs[2] * inv; }
            asm volatile("s_waitcnt lgkmcnt(0)" ::: "memory");
        }
#pragma unroll
        for (int i = 0; i < 8; ++i) { const int rw = (lane >> 4) + 4 * i, c = lane & 15;
            const u32x4 ov = *(const LAS u32x4*)(stg + rw * 128 + c * 8); const float f0 = tb[rw];
            float x[8];
#pragma unroll
            for (int q = 0; q < 4; ++q) { x[2 * q] = f0 * bflo(ov[q]); x[2 * q + 1] = f0 * bfhi(ov[q]); }
#pragma unroll
            for (int sl = 0; sl < 3; ++sl) { const float f = tb[32 * (sl + 1) + rw];
#pragma unroll
                for (int q = 0; q < 4; ++q) { x[2 * q] += f * bflo(pv[sl][i][q]); x[2 * q + 1] += f * bfhi(pv[sl][i][q]); } }
            u32x4 w; w.x = cvt_pk_bf16(x[0], x[1]); w.y = cvt_pk_bf16(x[2], x[3]); w.z = cvt_pk_bf16(x[4], x[5]); w.w = cvt_pk_bf16(x[6], x[7]);
            *(u32x4*)(O + (size_t)(tok0 + rw) * DM + h * MHD + c * 8) = w; }
        asm volatile("s_waitcnt lgkmcnt(0)" ::: "memory");
        cur = nxt;
    }
#undef OWN_DECODE
}
__device__ __forceinline__ void ph_conv_fix(const Ctx& C, const bf16* UH, bf16* A, const float* cw, const float* cb) {
    constexpr int FG = FF / 8;
    for (int it = C.gt; it < (NTOK / 64) * 2 * FG; it += C.NGT) {
        const int fg = it % FG, rr = (it / FG) & 1, G = it / (2 * FG), f0 = fg * 8, t = G * 64 + rr; const bool seq0 = (t & (SEQ - 1)) < 2 && ((G * 64) & (SEQ - 1)) == 0;
        const bf16* up = UH + (size_t)(G - 1) * 4 * FF2; const bf16* uc = UH + (size_t)G * 4 * FF2;
        u32x4 g2, g1, g0, v2, v1, v0; const u32x4 z = {0, 0, 0, 0};
        if (rr == 0) { g2 = seq0 ? z : *(const u32x4*)(up + f0); g1 = seq0 ? z : *(const u32x4*)(up + FF2 + f0); g0 = *(const u32x4*)(uc + 2 * FF2 + f0);
                       v2 = seq0 ? z : *(const u32x4*)(up + FF + f0); v1 = seq0 ? z : *(const u32x4*)(up + FF2 + FF + f0); v0 = *(const u32x4*)(uc + 2 * FF2 + FF + f0); }
        else         { g2 = seq0 ? z : *(const u32x4*)(up + FF2 + f0); g1 = *(const u32x4*)(uc + 2 * FF2 + f0); g0 = *(const u32x4*)(uc + 3 * FF2 + f0);
                       v2 = seq0 ? z : *(const u32x4*)(up + FF2 + FF + f0); v1 = *(const u32x4*)(uc + 2 * FF2 + FF + f0); v0 = *(const u32x4*)(uc + 3 * FF2 + FF + f0); }
        u32x4 o;
#pragma unroll
        for (int j = 0; j < 4; ++j) { float r[2];
#pragma unroll
            for (int hl = 0; hl < 2; ++hl) { const int c = f0 + 2 * j + hl;
                const float ug2 = hl ? bfhi(g2[j]) : bflo(g2[j]), ug1 = hl ? bfhi(g1[j]) : bflo(g1[j]), ug0 = hl ? bfhi(g0[j]) : bflo(g0[j]);
                const float uv2 = hl ? bfhi(v2[j]) : bflo(v2[j]), uv1 = hl ? bfhi(v1[j]) : bflo(v1[j]), uv0 = hl ? bfhi(v0[j]) : bflo(v0[j]);
                const float cg = cb[c] + cw[c] * ug2 + cw[FF2 + c] * ug1 + cw[2 * FF2 + c] * ug0;
                const float cv = cb[FF + c] + cw[FF + c] * uv2 + cw[FF2 + FF + c] * uv1 + cw[2 * FF2 + FF + c] * uv0;
                r[hl] = gelu_tanh(cg) * cv; }
            o[j] = cvt_pk_bf16(r[0], r[1]); }
        *(u32x4*)(A + (size_t)t * FF + f0) = o;
    }
}
__device__ __forceinline__ void ph_scan(const Ctx& C, const bf16* U, bf16* RT) {
    for (long it = C.gt; it < (long)RH * RDV * 2 * 128; it += C.NGT) {
        const int row = (int)(it >> 8), b = (int)(it >> 7) & 1, d0 = (int)(it & 127) * 2, h = row / RDV; const float gl = fast_exp2((float)RL * log2g(h));
        unsigned off = ((unsigned)row * NTOK + (unsigned)b * SEQ + (unsigned)d0) * 2u; float r0 = 0.f, r1 = 0.f;
        unsigned w[8];
#pragma unroll
        for (int i = 0; i < 8; ++i) w[i] = pg8::ldo<unsigned>(U, off + (unsigned)i * (RL * 2));
#pragma unroll 1
        for (int g = 0; g < SEQ / RL / 8; ++g, off += 8 * RL * 2) {
            unsigned n[8];
            if (g + 1 < SEQ / RL / 8) {
#pragma unroll
                for (int i = 0; i < 8; ++i) n[i] = pg8::ldo<unsigned>(U, off + 8 * RL * 2 + (unsigned)i * (RL * 2)); }
            else {
#pragma unroll
                for (int i = 0; i < 8; ++i) n[i] = 0u; }
#pragma unroll
            for (int i = 0; i < 8; ++i) {
                pg8::sto<unsigned>(RT, off + (unsigned)i * (RL * 2), cvt_pk_bf16(r0, r1));
                r0 = gl * (r0 + bflo(w[i])); r1 = gl * (r1 + bfhi(w[i])); }
#pragma unroll
            for (int i = 0; i < 8; ++i) w[i] = n[i];
        }
    }
}
__device__ __forceinline__ void ph_groupnorm(const Ctx& C, const bf16* Y, bf16* G) {
    u32x4 yw[8], gw[8];
    const int step = C.NGW * 8; int it0 = C.gw * 8;
    if (it0 < NTOK * RH) {
#pragma unroll
        for (int k = 0; k < 8; ++k) { const unsigned off = ((unsigned)(it0 + k) * RDV + 8u * C.lane) * 2u; yw[k] = *(const u32x4*)((const char*)Y + off); gw[k] = *(const u32x4*)((const char*)G + off); } }
#pragma unroll 1
    for (; it0 < NTOK * RH; it0 += step) {
        u32x4 yn[8], gn[8]; const int nx = it0 + step;
        if (nx < NTOK * RH) {
#pragma unroll
            for (int k = 0; k < 8; ++k) { const unsigned off = ((unsigned)(nx + k) * RDV + 8u * C.lane) * 2u; yn[k] = *(const u32x4*)((const char*)Y + off); gn[k] = *(const u32x4*)((const char*)G + off); } }
        else {
#pragma unroll
            for (int k = 0; k < 8; ++k) { yn[k] = (u32x4){0u, 0u, 0u, 0u}; gn[k] = (u32x4){0u, 0u, 0u, 0u}; } }
#pragma unroll
        for (int k = 0; k < 8; ++k) { const int it = it0 + k, tok = it >> 3, h = it & 7, n = tok & (RL - 1); const float xi = fast_exp2((float)(n + 1) * log2g(h));
            float y[8]; float s = 0.f;
#pragma unroll
            for (int j = 0; j < 4; ++j) { y[2 * j] = bflo(yw[k][j]) * xi; y[2 * j + 1] = bfhi(yw[k][j]) * xi; s += y[2 * j] + y[2 * j + 1]; }
            const float mean = wave_sum(s, C.lane) * (1.f / RDV); float s2 = 0.f;
#pragma unroll
            for (int j = 0; j < 8; ++j) { y[j] -= mean; s2 += y[j] * y[j]; }
            const float rstd = 1.f / sqrtf(wave_sum(s2, C.lane) * (1.f / RDV) + GN_EPS);
            u32x4 o;
#pragma unroll
            for (int j = 0; j < 4; ++j) o[j] = cvt_pk_bf16(bflo(gw[k][j]) * y[2 * j] * rstd, bfhi(gw[k][j]) * y[2 * j + 1] * rstd);
            *(u32x4*)((char*)G + ((unsigned)it * RDV + 8u * C.lane) * 2u) = o; }
#pragma unroll
        for (int k = 0; k < 8; ++k) { yw[k] = yn[k]; gw[k] = gn[k]; }
    }
}

__global__ void __launch_bounds__(NWAVES * 64, 2) fwd(Args args) {
    extern __shared__ __attribute__((aligned(16))) unsigned char lds_raw[];
    LAS unsigned char* const lds0 = (LAS unsigned char*)lds_raw;
    volatile LAS unsigned* MISC = (volatile LAS unsigned*)(lds0 + MISC_OFF);
    for (int u = threadIdx.x; u < (LDS_BYTES - LDSCTL_OFF) / 4; u += NWAVES * 64) ((LAS unsigned*)(lds0 + LDSCTL_OFF))[u] = 0u;
    __syncthreads();
    XcdBarrier bar = xcd_barrier_post((unsigned*)(args.ws + WS_CTL) + CW_BAR, MISC + 8);
    const int lo = args.ph_lo, hi = args.ph_hi;
    const int wave0 = __builtin_amdgcn_readfirstlane(threadIdx.x >> 6);
    int pc = 0;
#define PH_BEGIN { const int pid_ = pc++; if (lo <= pid_ && pid_ < hi) { int lane_; asm volatile("v_mbcnt_lo_u32_b32 %0, -1, 0\n\tv_mbcnt_hi_u32_b32 %0, -1, %0" : "=v"(lane_)); \
        const __attribute__((address_space(4))) unsigned long long* ap_ = (const __attribute__((address_space(4))) unsigned long long*)__builtin_amdgcn_kernarg_segment_ptr(); asm volatile("" : "+s"(ap_)); \
        Args args;   \
        _Pragma("unroll") for (int i_ = 0; i_ < 14; ++i_) args.in[i_] = (const float*)(GAS const float*)ap_[i_]; args.out = (float*)(GAS float*)ap_[14]; args.ph_lo = 0; args.ph_hi = 0; \
        GAS unsigned char* wsg_ = (GAS unsigned char*)ap_[15]; asm volatile("" : "+s"(wsg_)); args.ws = (unsigned char*)wsg_; unsigned char* ws = args.ws;     \
        Ctx C; C.lds = lds0; C.tid = wave0 * 64 + lane_; C.lane = lane_; C.wave = wave0; { int b_ = blockIdx.x, g_ = gridDim.x; asm volatile("" : "+s"(b_), "+s"(g_)); C.bid = b_; C.G = g_; } \
        C.gw = C.bid * NWAVES + C.wave; C.NGW = C.G * NWAVES; C.gt = C.bid * (NWAVES * 64) + C.tid; C.NGT = C.G * NWAVES * 64; \
        float* Hb = args.out; bf16* HN = (bf16*)(ws + WS_HN); pg8::StaticOrder S; (void)Hb; (void)HN; (void)S;
#define PH_END   if (pid_ + 1 < hi) xcd_barrier(bar); } }
#define SUB(...) { GAS unsigned char* wsg2_ = (GAS unsigned char*)ws; asm volatile("" : "+s"(wsg2_), "+s"(C.bid), "+s"(C.G)); unsigned char* ws_ = (unsigned char*)wsg2_; int lane2_; asm volatile("v_mbcnt_lo_u32_b32 %0, -1, 0\n\tv_mbcnt_hi_u32_b32 %0, -1, %0" : "=v"(lane2_)); \
        C.tid = wave0 * 64 + lane2_; C.lane = lane2_; { unsigned char* ws = ws_; bf16* HN = (bf16*)(ws + WS_HN); (void)HN; __VA_ARGS__ } }

#define SPART ((f32x2*)(ws + WS_STATS))
#define FSTATS ((f32x2*)(ws + WS_FSTATS))
#define GWV ((const float*)(ws + WS_GW))
#define BWV ((const float*)(ws + WS_GW) + NCOLT)
#define RED ((LAS f32x2*)(C.lds + RING_BYTES))
#define LNG(i) (args.in[12] + (size_t)(i) * DM)
#define LNB(i) (args.in[13] + (size_t)(i) * DM)
#define TABA ((const f32x2*)(ws + WS_TABA))
#define TABR ((const f32x2*)(ws + WS_TABR))
#define KM ((float*)(ws + WS_KMEAN))

    PH_BEGIN ph_prologue(C, args); PH_END
    PH_BEGIN ph_fold_reduce(C, (const float*)(ws + WS_GWP), (float*)(ws + WS_GW)); PH_END

    for (int l = 0; l < 4; ++l) {
        const int j = l >> 1;
        if ((l & 1) == 0) {
#define QKV ((bf16*)(ws + A_QKV))
#define MO ((bf16*)(ws + A_MO))
            PH_BEGIN { const pg8::Desc g = pg8::plain_desc(HN, (const bf16*)(ws + W_MQKV) + (size_t)j * 3 * DM * DM, NTOK, 3 * DM, DM);
                S.init(g.nM, g.nN, C.G, C.bid); pg8::EpiMobaQKV E{QKV, TABA, {FSTATS, GWV + (l == 0 ? CO_ID : CO_M1), BWV + (l == 0 ? CO_ID : CO_M1)}}; pg8::gemm_phase(C.lds, C.tid, g, S, E); } PH_END
            PH_BEGIN ph_kmean(C, QKV, KM); PH_END
            PH_BEGIN ph_moba_route(C, QKV, KM, (unsigned*)(ws + WS_CTL) + CW_CNT + j * 1024, (unsigned*)(ws + A_MLIST)); PH_END
            PH_BEGIN ph_moba_sel(C, QKV, (const unsigned*)(ws + WS_CTL) + CW_CNT + j * 1024, (const unsigned*)(ws + A_MLIST), (bf16*)(ws + A_MPO), (f32x2*)(ws + A_MPML)); PH_END
            PH_BEGIN ph_moba_own(C, QKV, (const bf16*)(ws + A_MPO), (const f32x2*)(ws + A_MPML), MO); PH_END
            PH_BEGIN { const pg8::Desc g = pg8::plain_desc(MO, (const bf16*)(ws + W_MO) + (size_t)j * DM * DM, NTOK, DM, DM);
                S.init(g.nM, g.nN, C.G, C.bid); pg8::EpiResLN E{args.in[0], HN, l == 0 ? nullptr : FSTATS, SPART, LNG(l == 0 ? 0 : 2 * l - 1), LNB(l == 0 ? 0 : 2 * l - 1), ALPHA, RED, C.tid, (unsigned*)(ws + WS_CTL) + CW_PANEL + (2 * l) * 4096, FSTATS};
                pg8::gemm_phase(C.lds, C.tid, g, S, E); } PH_END
        } else {
#define RQ ((bf16*)(ws + A_RQ))
#define RK ((bf16*)(ws + A_RK))
#define RKT ((bf16*)(ws + A_RKT))
#define RVT ((bf16*)(ws + A_RVT))
#define RG ((bf16*)(ws + A_RG))
#define RP ((bf16*)(ws + A_RP))
#define RU ((bf16*)(ws + A_RU))
#define RRT ((bf16*)(ws + A_RRT))
#define Wq ((const bf16*)(ws + W_RQ) + (size_t)j * DM * DM)
#define Wk ((const bf16*)(ws + W_RK) + (size_t)j * DM * DM)
#define Wv ((const bf16*)(ws + W_RV) + (size_t)j * 2 * DM * DM)
#define Wg ((const bf16*)(ws + W_RG) + (size_t)j * 2 * DM * DM)
            PH_BEGIN {
                SUB({ const pg8::Desc g = pg8::plain_desc(HN, Wq, NTOK, DM, DM); S.init(g.nM, g.nN, C.G, C.bid); pg8::EpiRopeNat256<false> E{RQ, DM, TABR, 1.0f, {FSTATS, GWV + CO_R + j * 12288, BWV + CO_R + j * 12288}, nullptr}; pg8::gemm_phase(C.lds, C.tid, g, S, E); })
                SUB({ const pg8::Desc g = pg8::plain_desc(HN, Wk, NTOK, DM, DM); S.init(g.nM, g.nN, C.G, C.bid); pg8::EpiRopeNat256<true> E{RK, DM, TABR, 0.0625f, {FSTATS, GWV + CO_R + j * 12288 + 2048, BWV + CO_R + j * 12288 + 2048}, RKT}; pg8::gemm_phase(C.lds, C.tid, g, S, E); })
                SUB({ const pg8::Desc g = pg8::plain_desc(HN, Wg, NTOK, 2 * DM, DM); S.init(g.nM, g.nN, C.G, C.bid); pg8::EpiAct<1, true> E{RG, 2 * DM, {FSTATS, GWV + CO_R + j * 12288 + 8192, BWV + CO_R + j * 12288 + 8192}}; pg8::gemm_phase(C.lds, C.tid, g, S, E); })
                SUB({ const pg8::Desc g = pg8::plain_desc(Wv, HN, 2 * DM, NTOK, DM); S.init(g.nM, g.nN, C.G, C.bid); pg8::EpiVT E{RVT, NTOK, {FSTATS, GWV + CO_R + j * 12288 + 4096, BWV + CO_R + j * 12288 + 4096}}; pg8::gemm_phase(C.lds, C.tid, g, S, E); })
            } PH_END
            PH_BEGIN {
                SUB({
                    pg8::Desc g; g.A = RQ; g.B = RK; g.A2 = RQ; g.B2 = RK; g.lda = DM; g.ldb = DM; g.sAm = 256L * DM; g.sAn = 256; g.sBm = 256L * DM; g.sBn = 256;
                    g.shAm = 0; g.shAn = 0; g.shBm = 0; g.shBn = 0; g.nM = NTOK / 256; g.nN = RH; g.nt = RDK / 64; g.nt1 = g.nt;
                    S.init(g.nM, g.nN, C.G, C.bid); pg8::EpiAct<2, false> E{RP, DM, {nullptr, nullptr, nullptr}}; pg8::gemm_phase(C.lds, C.tid, g, S, E); })
                SUB({
                    pg8::Desc g; g.A = RVT; g.B = RKT; g.A2 = RVT; g.B2 = RKT; g.lda = NTOK; g.ldb = NTOK; g.sAm = 256L * NTOK; g.sAn = 256; g.sBm = 256L * NTOK; g.sBn = 256;
                    g.shAm = 0; g.shAn = 0; g.shBm = 1; g.shBn = 0; g.nM = RH * RDV / 256; g.nN = NTOK / 256; g.nt = RL / 64; g.nt1 = g.nt;
                    S.init(g.nM, g.nN, C.G, C.bid); pg8::EpiBf16 E{RU, NTOK}; pg8::gemm_phase(C.lds, C.tid, g, S, E); })
            } PH_END
            PH_BEGIN ph_scan(C, RU, RRT); PH_END
            PH_BEGIN {
                pg8::Desc g; g.A = RP; g.A2 = RQ; g.B = RVT; g.B2 = RRT; g.lda = DM; g.ldb = NTOK; g.sAm = 256L * DM; g.sAn = 256; g.sBm = 256; g.sBn = 256L * NTOK;
                g.shAm = 0; g.shAn = 1; g.shBm = 0; g.shBn = 0; g.nM = NTOK / 256; g.nN = RH * RDV / 256; g.nt = 8; g.nt1 = 4;
                S.init(g.nM, g.nN, C.G, C.bid); pg8::EpiBf16 E{RU, 2 * DM}; pg8::gemm_phase(C.lds, C.tid, g, S, E); } PH_END
            PH_BEGIN ph_groupnorm(C, RU, RG); PH_END
            PH_BEGIN { const pg8::Desc g = pg8::plain_desc(RG, (const bf16*)(ws + W_RO) + (size_t)j * 2 * DM * DM, NTOK, DM, 2 * DM);
                S.init(g.nM, g.nN, C.G, C.bid); pg8::EpiResLN E{args.in[0], HN, FSTATS, SPART, LNG(2 * l - 1), LNB(2 * l - 1), ALPHA, RED, C.tid, (unsigned*)(ws + WS_CTL) + CW_PANEL + (2 * l) * 4096, FSTATS}; pg8::gemm_phase(C.lds, C.tid, g, S, E); } PH_END
        }
#define FU ((bf16*)(ws + A_U))
#define FA ((bf16*)(ws + A_FA))
        PH_BEGIN { const pg8::Desc g = pg8::plain_desc(HN, (const bf16*)(ws + W_FI) + (size_t)l * FF2 * DM, NTOK, FF2, DM);
            S.init(g.nM, g.nN, C.G, C.bid); pg8::EpiConv E{FA, FU, args.in[9] + (size_t)l * 3 * FF2, args.in[10] + (size_t)l * FF2, {FSTATS, GWV + CO_F + l * 11264, BWV + CO_F + l * 11264}};
            pg8::gemm_phase(C.lds, C.tid, g, S, E); } PH_END
        PH_BEGIN ph_conv_fix(C, FU, FA, args.in[9] + (size_t)l * 3 * FF2, args.in[10] + (size_t)l * FF2); PH_END
        PH_BEGIN { const pg8::Desc g = pg8::plain_desc(FA, (const bf16*)(ws + W_FO) + (size_t)l * FF * DM, NTOK, DM, FF);
            S.init(g.nM, g.nN, C.G, C.bid); pg8::EpiResLN E{args.in[0], HN, FSTATS, SPART, LNG(2 * l), LNB(2 * l), ALPHA, RED, C.tid, (unsigned*)(ws + WS_CTL) + CW_PANEL + (2 * l + 1) * 4096, FSTATS}; pg8::gemm_phase(C.lds, C.tid, g, S, E); } PH_END
    }
    PH_BEGIN ph_ln_final(C, HN, Hb, LNG(7), LNB(7)); PH_END
#undef PH_BEGIN
#undef PH_END
}
constexpr int N_PHASES = 2 + 2 * (6 + 3) + 2 * (6 + 3) + 1;

extern "C" void kernel_launch(void* const* d_in, const int* in_sizes, int n_in, void* d_out, int out_size, void* d_ws, size_t ws_size, hipStream_t stream) {
    static int grid = 0;
    if (grid == 0) {
        if (n_in != 14 || out_size != NTOK * DM || ws_size < WS_NEED) { fprintf(stderr, "kernel_launch: unexpected shapes (n_in %d out %d ws %zu)\n", n_in, out_size, ws_size); grid = -1; return; }
        int dev = 0, cus = 0, per_cu = 0;
        if (hipGetDevice(&dev) != hipSuccess || hipDeviceGetAttribute(&cus, hipDeviceAttributeMultiprocessorCount, dev) != hipSuccess) { grid = -1; return; }
        if (hipFuncSetAttribute((const void*)fwd, hipFuncAttributeMaxDynamicSharedMemorySize, LDS_BYTES) != hipSuccess) { fprintf(stderr, "kernel_launch: hipFuncSetAttribute failed\n"); grid = -1; return; }
        if (hipOccupancyMaxActiveBlocksPerMultiprocessor(&per_cu, (const void*)fwd, NWAVES * 64, LDS_BYTES) != hipSuccess || per_cu < 1)
            fprintf(stderr, "kernel_launch: occupancy query reports %d workgroups per CU\n", per_cu);
        (void)hipGetLastError();
        grid = cus;
    }
    if (grid < 0) return;
    (void)hipMemsetAsync((char*)d_ws + WS_CTL, 0, CTL_ZERO_BYTES, stream);
    Args a{};
    for (int i = 0; i < 14; ++i) a.in[i] = (const float*)d_in[i];
    a.out = (float*)d_out; a.ws = (unsigned char*)d_ws;
#if MK_ONE_LAUNCH
    a.ph_lo = 0; a.ph_hi = N_PHASES;
    hipLaunchKernelGGL(fwd, dim3(grid), dim3(NWAVES * 64), LDS_BYTES, stream, a);
#else
    for (int p = 0; p < N_PHASES; ++p) { a.ph_lo = p; a.ph_hi = p + 1; hipLaunchKernelGGL(fwd, dim3(grid), dim3(NWAVES * 64), LDS_BYTES, stream, a); }
#endif
}
```

```cpp
#include <hip/hip_runtime.h>
#include <cstdio>
#include <cstdint>

#ifndef MK_ONE_LAUNCH
#define MK_ONE_LAUNCH 1
#endif

#define GAS __attribute__((address_space(1)))
#define LAS __attribute__((address_space(3)))
typedef unsigned short bf16;
typedef float f32x4 __attribute__((ext_vector_type(4)));
typedef float f32x2 __attribute__((ext_vector_type(2)));
typedef unsigned u32x4 __attribute__((ext_vector_type(4)));
typedef unsigned u32x2 __attribute__((ext_vector_type(2)));
typedef short bf16x8 __attribute__((ext_vector_type(8)));

constexpr int NTOK = 16384, SEQ = 8192, DM = 2048;
constexpr int MH = 16, MHD = 128, MBLK = 256, MNB = 32;
constexpr int RH = 8, RDK = 256, RDV = 512, RL = 256;
constexpr int FF = 5632, FF2 = 11264;
constexpr float ALPHA = 1.681792830507429f;
constexpr float LN_EPS = 1e-5f, GN_EPS = 1e-5f;

__device__ const float INV_A[64] = {1.000000000e+00f, 8.659643531e-01f, 7.498942018e-01f, 6.493816376e-01f, 5.623413324e-01f, 4.869675338e-01f, 4.216965139e-01f, 3.651741147e-01f, 3.162277639e-01f, 2.738419771e-01f, 2.371373773e-01f, 2.053525001e-01f, 1.778279394e-01f, 1.539926529e-01f, 1.333521456e-01f, 1.154781953e-01f, 1.000000015e-01f, 8.659642935e-02f, 7.498942316e-02f, 6.493816525e-02f, 5.623413250e-02f, 4.869675264e-02f, 4.216964915e-02f, 3.651741147e-02f, 3.162277490e-02f, 2.738419548e-02f, 2.371373773e-02f, 2.053525113e-02f, 1.778279431e-02f, 1.539926510e-02f, 1.333521400e-02f, 1.154781971e-02f, 9.999999776e-03f, 8.659643121e-03f, 7.498942316e-03f, 6.493816152e-03f, 5.623413250e-03f, 4.869675264e-03f, 4.216964822e-03f, 3.651741194e-03f, 3.162277630e-03f, 2.738419687e-03f, 2.371373819e-03f, 2.053525066e-03f, 1.778279431e-03f, 1.539926510e-03f, 1.333521446e-03f, 1.154782018e-03f, 1.000000047e-03f, 8.659643354e-04f, 7.498941850e-04f, 6.493816036e-04f, 5.623413017e-04f, 4.869675322e-04f, 4.216965172e-04f, 3.651741135e-04f, 3.162277571e-04f, 2.738419571e-04f, 2.371373703e-04f, 2.053525095e-04f, 1.778279402e-04f, 1.539926598e-04f, 1.333521504e-04f, 1.154782003e-04f};
__device__ const float INV_R[128] = {1.000000000e+00f, 9.305720329e-01f, 8.659643531e-01f, 8.058421612e-01f, 7.498942018e-01f, 6.978305578e-01f, 6.493816376e-01f, 6.042963862e-01f, 5.623413324e-01f, 5.232990980e-01f, 4.869675338e-01f, 4.531583786e-01f, 4.216965139e-01f, 3.924189806e-01f, 3.651741147e-01f, 3.398208320e-01f, 3.162277639e-01f, 2.942727208e-01f, 2.738419771e-01f, 2.548296750e-01f, 2.371373773e-01f, 2.206734121e-01f, 2.053525001e-01f, 1.910952926e-01f, 1.778279394e-01f, 1.654817164e-01f, 1.539926529e-01f, 1.433012635e-01f, 1.333521456e-01f, 1.240937784e-01f, 1.154781953e-01f, 1.074607819e-01f, 1.000000015e-01f, 9.305720776e-02f, 8.659642935e-02f, 8.058422059e-02f, 7.498942316e-02f, 6.978306174e-02f, 6.493816525e-02f, 6.042964011e-02f, 5.623413250e-02f, 5.232991278e-02f, 4.869675264e-02f, 4.531583562e-02f, 4.216964915e-02f, 3.924189880e-02f, 3.651741147e-02f, 3.398208320e-02f, 3.162277490e-02f, 2.942727134e-02f, 2.738419548e-02f, 2.548296750e-02f, 2.371373773e-02f, 2.206734009e-02f, 2.053525113e-02f, 1.910953037e-02f, 1.778279431e-02f, 1.654817164e-02f, 1.539926510e-02f, 1.433012541e-02f, 1.333521400e-02f, 1.240937784e-02f, 1.154781971e-02f, 1.074607857e-02f, 9.999999776e-03f, 9.305720218e-03f, 8.659643121e-03f, 8.058422245e-03f, 7.498942316e-03f, 6.978305988e-03f, 6.493816152e-03f, 6.042963825e-03f, 5.623413250e-03f, 5.232991185e-03f, 4.869675264e-03f, 4.531583749e-03f, 4.216964822e-03f, 3.924189601e-03f, 3.651741194e-03f, 3.398208413e-03f, 3.162277630e-03f, 2.942727180e-03f, 2.738419687e-03f, 2.548296703e-03f, 2.371373819e-03f, 2.206734149e-03f, 2.053525066e-03f, 1.910952968e-03f, 1.778279431e-03f, 1.654817141e-03f, 1.539926510e-03f, 1.433012541e-03f, 1.333521446e-03f, 1.240937738e-03f, 1.154782018e-03f, 1.074607833e-03f, 1.000000047e-03f, 9.305720450e-04f, 8.659643354e-04f, 8.058421663e-04f, 7.498941850e-04f, 6.978305755e-04f, 6.493816036e-04f, 6.042963942e-04f, 5.623413017e-04f, 5.232990952e-04f, 4.869675322e-04f, 4.531583691e-04f, 4.216965172e-04f, 3.924189659e-04f, 3.651741135e-04f, 3.398208355e-04f, 3.162277571e-04f, 2.942727297e-04f, 2.738419571e-04f, 2.548296761e-04f, 2.371373703e-04f, 2.206734061e-04f, 2.053525095e-04f, 1.910952997e-04f, 1.778279402e-04f, 1.654817170e-04f, 1.539926598e-04f, 1.433012512e-04f, 1.333521504e-04f, 1.240937709e-04f, 1.154782003e-04f, 1.074607862e-04f};
__device__ __forceinline__ float log2g(int h) {
    const float t[8] = {-4.58036896131247886e-02f, -2.27200765000835289e-02f, -1.13153132278341461e-02f, -5.64656314114206186e-03f,
                        -2.82051906237866306e-03f, -1.40957025467135363e-03f, -7.04612976589372815e-04f, -3.52263471629021439e-04f};
    float r = t[0];
#pragma unroll
    for (int i = 1; i < 8; ++i) r = (h == i) ? t[i] : r;
    return r;
}

__device__ __forceinline__ float bflo(unsigned w) { return __uint_as_float(w << 16); }
__device__ __forceinline__ float bfhi(unsigned w) { return __uint_as_float(w & 0xffff0000u); }
__device__ __forceinline__ unsigned cvt_pk_bf16(float lo, float hi) { unsigned r; asm volatile("v_cvt_pk_bf16_f32 %0, %1, %2" : "=v"(r) : "v"(lo), "v"(hi)); return r; }
__device__ __forceinline__ float shx(float v, int mask, int lane) { return __builtin_bit_cast(float, __builtin_amdgcn_ds_bpermute((lane ^ mask) << 2, __builtin_bit_cast(int, v))); }
__device__ __forceinline__ float wave_sum(float v, int lane) {
#pragma unroll
    for (int o = 1; o < 64; o <<= 1) v += shx(v, o, lane);
    return v;
}
__device__ __forceinline__ float fast_exp2(float x) { return __builtin_amdgcn_exp2f(x); }
__device__ __forceinline__ float gelu_tanh(float x) {
    const float t = x * (-2.302208198f - 0.1029432397f * x * x);
    return x * __builtin_amdgcn_rcpf(1.0f + fast_exp2(t));
}
__device__ __forceinline__ float silu(float x) { return x * __builtin_amdgcn_rcpf(1.0f + fast_exp2(-x * 1.4426950408889634f)); }
__device__ __forceinline__ void sincos_acc(float angf, float& s, float& c) {
    const double a = (double)angf;
    const double k = __builtin_rint(a * 0.63661977236758134308);
    double r = __builtin_fma(-k, 1.57079632679489655800e+00, a);
    r = __builtin_fma(-k, 6.12323399573676603587e-17, r);
    const double r2 = r * r;
    double sp = 1.0 / 6227020800.0;
    sp = sp * r2 - 1.0 / 39916800.0; sp = sp * r2 + 1.0 / 362880.0; sp = sp * r2 - 1.0 / 5040.0; sp = sp * r2 + 1.0 / 120.0; sp = sp * r2 - 1.0 / 6.0; sp = sp * r2 + 1.0;
    const double sn = sp * r;
    double cp = -1.0 / 87178291200.0;
    cp = cp * r2 + 1.0 / 479001600.0; cp = cp * r2 - 1.0 / 3628800.0; cp = cp * r2 + 1.0 / 40320.0; cp = cp * r2 - 1.0 / 720.0; cp = cp * r2 + 1.0 / 24.0; cp = cp * r2 - 0.5; cp = cp * r2 + 1.0;
    const int q = ((int)k) & 3;
    const double ss = (q & 1) ? cp : sn, cc = (q & 1) ? sn : cp;
    s = (float)((q & 2) ? -ss : ss);
    c = (float)(((q + 1) & 2) ? -cc : cc);
}

namespace pg8 {
constexpr int BM = 256, BK = 64, HALF = 128, HTB = HALF * BK * 2, STAGE_BYTES = 8 * HTB, NXCD = 8, WGM = 8;
__host__ __device__ __forceinline__ int lds_byte(int r, int c) { const int st = (r >> 4) * 2 + (c >> 5), rr = r & 15, cc = c & 31, ob = rr * 64 + cc * 2; return st * 1024 + (ob ^ (((ob >> 9) & 1) << 5)); }
__host__ __device__ __forceinline__ void stage_rc(int b, int& R, int& C) { const int st = b / 1024, sb = b % 1024, swz = sb ^ (((sb >> 9) & 1) << 5); R = (st >> 1) * 16 + swz / 64; C = (st & 1) * 32 + (swz % 64) / 2; }
__host__ __device__ __forceinline__ int perm32(int rho) { const int n = rho >> 4, i = rho & 15; return 8 * (i >> 2) + 4 * n + (i & 3); }

struct Unit { int pm, pn; };
struct Desc {
    const bf16* A; const bf16* B; const bf16* A2; const bf16* B2;
    long lda, ldb, sAm, sAn, sBm, sBn;
    int shAm, shAn, shBm, shBn;
    int nM, nN, nt, nt1;
};
__host__ __device__ inline Desc plain_desc(const bf16* A, const bf16* Bt, int M, int N, int K) {
    Desc d; d.A = A; d.B = Bt; d.A2 = A; d.B2 = Bt; d.lda = K; d.ldb = K; d.sAm = 256L * K; d.sAn = 0; d.sBm = 0; d.sBn = 256L * K;
    d.shAm = 0; d.shAn = 0; d.shBm = 0; d.shBn = 0; d.nM = M / 256; d.nN = N / 256; d.nt = K / 64; d.nt1 = K / 64; return d;
}
struct StaticOrder {
    int nM, nN, nwg, G, c;
    __device__ void init(int nM_, int nN_, int G_, int c_) { nM = nM_; nN = nN_; nwg = nM * nN; G = G_; c = c_; }
    __device__ bool next(int i, Unit& u) const {
        const int L = i * G + c; if (L >= nwg) return false;
        const int wgid = (L & (NXCD - 1)) * (nwg >> 3) + (L >> 3);
        const int nig = WGM * nN, gid = wgid / nig, rem = wgid - gid * nig;
        u.pm = gid * WGM + (rem & (WGM - 1)); u.pn = rem >> 3; return true;
    }
};

__device__ __forceinline__ float row16_sum(float v) {
    v += __builtin_bit_cast(float, __builtin_amdgcn_update_dpp(0, __builtin_bit_cast(int, v), 0xB1, 0xf, 0xf, true));
    v += __builtin_bit_cast(float, __builtin_amdgcn_update_dpp(0, __builtin_bit_cast(int, v), 0x4E, 0xf, 0xf, true));
    v += __builtin_bit_cast(float, __builtin_amdgcn_update_dpp(0, __builtin_bit_cast(int, v), 0x141, 0xf, 0xf, true));
    v += __builtin_bit_cast(float, __builtin_amdgcn_update_dpp(0, __builtin_bit_cast(int, v), 0x140, 0xf, 0xf, true));
    return v;
}
template <class T> __device__ __forceinline__ T ldo(const void* b, unsigned off) { return *(const T*)((const char*)b + off); }
template <class T> __device__ __forceinline__ void sto(void* b, unsigned off, T v) { *(T*)((char*)b + off) = v; }
#define ACC8(ai, bj, m, e) acc[ai][bj][m][(e) >> 2][(e) & 3]
__device__ __forceinline__ u32x4 pack8(const float (&x)[8]) { u32x4 w; w.x = cvt_pk_bf16(x[0], x[1]); w.y = cvt_pk_bf16(x[2], x[3]); w.z = cvt_pk_bf16(x[4], x[5]); w.w = cvt_pk_bf16(x[6], x[7]); return w; }
struct EpiBf16 {
    static constexpr bool PERM = true;
    bf16* O; unsigned ldc;
    __device__ __forceinline__ void operator()(f32x4 (&acc)[2][2][4][2], const Unit& u, int wr, int wc, int fr, int fq) const {
        const unsigned o0 = ((unsigned)(u.pm * BM + wr * 64 + fr) * ldc + (unsigned)(u.pn * BM + wc * 32 + 8 * fq)) * 2u;
#pragma unroll
        for (int ai = 0; ai < 2; ++ai)
#pragma unroll
            for (int m = 0; m < 4; ++m) { const unsigned o = o0 + (unsigned)(ai * HALF + m * 16) * ldc * 2u;
#pragma unroll
                for (int bj = 0; bj < 2; ++bj) { float x[8];
#pragma unroll
                    for (int e = 0; e < 8; ++e) x[e] = ACC8(ai, bj, m, e);
                    sto<u32x4>(O, o + bj * HALF * 2, pack8(x)); } }
    }
};

struct LnFold { const f32x2* stats; const float* gw; const float* bw; };
__device__ __forceinline__ void ln_row_stats(const f32x2* fstats, unsigned off  , float& r, float& rmu) { const f32x2 v = ldo<f32x2>(fstats, off); r = v.x; rmu = v.y; }
__device__ __forceinline__ void ln_correct_nat(f32x4 (&acc)[2][2][4][2], const LnFold& ln, const Unit& u, int wr, int wc, int fr, int fq) {
    __builtin_amdgcn_sched_barrier(0);
    const unsigned so0 = (unsigned)(u.pm * BM + wr * 64 + fr) * 8u, co0 = (unsigned)(u.pn * BM + wc * 32 + 8 * fq) * 4u;
    f32x2 st[8]; f32x4 gb[2][4];
#pragma unroll
    for (int i = 0; i < 8; ++i) st[i] = ldo<f32x2>(ln.stats, so0 + ((i >> 2) * HALF + (i & 3) * 16) * 8);
#pragma unroll
    for (int bj = 0; bj < 2; ++bj) { gb[bj][0] = ldo<f32x4>(ln.gw, co0 + bj * HALF * 4); gb[bj][1] = ldo<f32x4>(ln.gw, co0 + bj * HALF * 4 + 16); gb[bj][2] = ldo<f32x4>(ln.bw, co0 + bj * HALF * 4); gb[bj][3] = ldo<f32x4>(ln.bw, co0 + bj * HALF * 4 + 16); }
    __builtin_amdgcn_sched_barrier(0);
#pragma unroll
    for (int bj = 0; bj < 2; ++bj) {
        float gw[8], bw[8];
#pragma unroll
        for (int e = 0; e < 4; ++e) { gw[e] = gb[bj][0][e]; gw[4 + e] = gb[bj][1][e]; bw[e] = gb[bj][2][e]; bw[4 + e] = gb[bj][3][e]; }
#pragma unroll
        for (int ai = 0; ai < 2; ++ai)
#pragma unroll
            for (int m = 0; m < 4; ++m) { const float r = st[ai * 4 + m].x, rmu = st[ai * 4 + m].y;
#pragma unroll
                for (int e = 0; e < 8; ++e) ACC8(ai, bj, m, e) = ACC8(ai, bj, m, e) * r - rmu * gw[e] + bw[e]; }
        __builtin_amdgcn_sched_barrier(0);
    }
}
__device__ __forceinline__ void ln_correct_swp(f32x4 (&acc)[2][2][4][2], const LnFold& ln, const Unit& u, int wr, int wc, int fr, int fq) {
    __builtin_amdgcn_sched_barrier(0);
    const unsigned ro0 = (unsigned)(u.pm * BM + wr * 64 + fr) * 4u, so0 = (unsigned)(u.pn * BM + wc * 32 + 8 * fq) * 8u;
    float r[2][8], rmu[2][8];
#pragma unroll
    for (int bj = 0; bj < 2; ++bj)
#pragma unroll
        for (int q = 0; q < 4; ++q) { const f32x4 v = ldo<f32x4>(ln.stats, so0 + bj * HALF * 8 + q * 16); r[bj][2 * q] = v[0]; rmu[bj][2 * q] = v[1]; r[bj][2 * q + 1] = v[2]; rmu[bj][2 * q + 1] = v[3]; }
    float g8[8], b8[8];
#pragma unroll
    for (int i = 0; i < 8; ++i) { g8[i] = ldo<float>(ln.gw, ro0 + ((i >> 2) * HALF + (i & 3) * 16) * 4); b8[i] = ldo<float>(ln.bw, ro0 + ((i >> 2) * HALF + (i & 3) * 16) * 4); }
#pragma unroll
    for (int ai = 0; ai < 2; ++ai)
#pragma unroll
        for (int m = 0; m < 4; ++m) { const float g = g8[ai * 4 + m], b = b8[ai * 4 + m];
#pragma unroll
            for (int bj = 0; bj < 2; ++bj)
#pragma unroll
                for (int e = 0; e < 8; ++e) ACC8(ai, bj, m, e) = ACC8(ai, bj, m, e) * r[bj][e] - rmu[bj][e] * g + b; }
    __builtin_amdgcn_sched_barrier(0);
}
struct EpiResLN {
    static constexpr bool PERM = true;
    const float* Xin; bf16* TN; const f32x2* stats_in; f32x2* stats_out; const float* g; const float* b; float alpha; LAS f32x2* red; int tid; unsigned* pcnt; f32x2* fs_out; bool ident;
    __device__ __forceinline__ void operator()(f32x4 (&acc)[2][2][4][2], const Unit& u, int wr, int wc, int fr, int fq) const {
        const unsigned row0 = (unsigned)(u.pm * BM + wr * 64 + fr), col0 = (unsigned)(u.pn * BM + wc * 32 + 8 * fq); const bool first = ident;
        float gv[2][8], bv[2][8];
#pragma unroll
        for (int bj = 0; bj < 2; ++bj)
#pragma unroll
            for (int e = 0; e < 8; ++e) { gv[bj][e] = 1.f; bv[bj][e] = 0.f; }
        if (!first) {
#pragma unroll
            for (int bj = 0; bj < 2; ++bj) { const unsigned co = (col0 + bj * HALF) * 4u; const f32x4 g0 = ldo<f32x4>(g, co), g1 = ldo<f32x4>(g, co + 16), b0 = ldo<f32x4>(b, co), b1 = ldo<f32x4>(b, co + 16);
#pragma unroll
                for (int e = 0; e < 4; ++e) { gv[bj][e] = g0[e]; gv[bj][4 + e] = g1[e]; bv[bj][e] = b0[e]; bv[bj][4 + e] = b1[e]; } } }
        u32x4 q0[8], q1[8]; f32x2 qs[8];
#define RL_LOAD(i) do { const unsigned row_ = row0 + (unsigned)(((i) >> 2) * HALF + ((i) & 3) * 16); const unsigned eo_ = row_ * DM + col0; \
            q0[i] = ldo<u32x4>(TN, eo_ * 2u); q1[i] = ldo<u32x4>(TN, (eo_ + HALF) * 2u); qs[i] = ldo<f32x2>(stats_in, row_ * 8u); } while (0)
        RL_LOAD(0); RL_LOAD(1);
#pragma unroll
        for (int i = 0; i < 8; ++i) { const int ai = i >> 2, m = i & 3; const unsigned row = row0 + ai * HALF + m * 16; float r = 1.f, rmu = 0.f;
                if (i + 2 < 8) RL_LOAD(i + 2); r = qs[i].x; rmu = qs[i].y;
                float sm = 0.f, sq = 0.f;
#pragma unroll
                for (int bj = 0; bj < 2; ++bj) { const unsigned eo = row * DM + col0 + bj * HALF; float to[8];
                    { const u32x4 tw = bj ? q1[i] : q0[i];
#pragma unroll
                        for (int q = 0; q < 4; ++q) { to[2 * q] = bflo(tw[q]); to[2 * q + 1] = bfhi(tw[q]); } }
                    float tn[8];
#pragma unroll
                    for (int e = 0; e < 8; ++e) { const float h = (to[e] * r - rmu) * gv[bj][e] + bv[bj][e];
                        const float v = alpha * h + ACC8(ai, bj, m, e); tn[e] = v; sm += v; sq += v * v; }
                    sto<u32x4>(TN, eo * 2u, pack8(tn)); }
                { const int ln_ = fq * 16 + fr; sm += shx(sm, 16, ln_); sm += shx(sm, 32, ln_); sq += shx(sq, 16, ln_); sq += shx(sq, 32, ln_); }
                if (fq == 0) red[(ai * HALF + wr * 64 + m * 16 + fr) * 4 + wc] = (f32x2){sm, sq}; asm volatile("" ::: "memory"); }
#undef RL_LOAD
        asm volatile("s_waitcnt lgkmcnt(0)" ::: "memory"); __builtin_amdgcn_s_barrier(); asm volatile("" ::: "memory");
        if (tid < 256) { const f32x2 a = red[tid * 4 + 0], b2 = red[tid * 4 + 1], c = red[tid * 4 + 2], d = red[tid * 4 + 3];
            const float S = (a.x + b2.x) + (c.x + d.x), Q = (a.y + b2.y) + (c.y + d.y);
            __hip_atomic_store((unsigned long long*)(stats_out + (size_t)(u.pm * BM + tid) * 8 + u.pn), ((unsigned long long)__float_as_uint(Q) << 32) | __float_as_uint(S), __ATOMIC_RELAXED, __HIP_MEMORY_SCOPE_AGENT); }
        asm volatile("s_waitcnt vmcnt(0)" ::: "memory"); __builtin_amdgcn_s_barrier(); asm volatile("" ::: "memory");
        LAS unsigned* flag = (LAS unsigned*)(red + 1024);
        if (tid == 0) { const unsigned old = __hip_atomic_fetch_add(pcnt + 64 * u.pm, 1u, __ATOMIC_RELAXED, __HIP_MEMORY_SCOPE_AGENT); flag[0] = (old == 7u) ? 1u : 0u; }
        asm volatile("s_waitcnt vmcnt(0) lgkmcnt(0)" ::: "memory"); __builtin_amdgcn_s_barrier(); asm volatile("" ::: "memory");
        if (flag[0] != 0u) {
            __builtin_amdgcn_fence(__ATOMIC_ACQUIRE, "agent"); asm volatile("s_waitcnt vmcnt(0)" ::: "memory");
            if (tid < 256) { const unsigned long long* p = (const unsigned long long*)(stats_out + (size_t)(u.pm * BM + tid) * 8); float S = 0.f, Q = 0.f;
                u32x4 w4[4];
                asm volatile("global_load_dwordx4 %0, %4, off sc1\n\tglobal_load_dwordx4 %1, %4, off offset:16 sc1\n\tglobal_load_dwordx4 %2, %4, off offset:32 sc1\n\tglobal_load_dwordx4 %3, %4, off offset:48 sc1\n\ts_waitcnt vmcnt(0)"
                             : "=&v"(w4[0]), "=&v"(w4[1]), "=&v"(w4[2]), "=&v"(w4[3]) : "v"(p) : "memory");
#pragma unroll
                for (int t = 0; t < 4; ++t) { S += __uint_as_float(w4[t].x) + __uint_as_float(w4[t].z); Q += __uint_as_float(w4[t].y) + __uint_as_float(w4[t].w); }
                const float mu = S * (1.0f / DM), var = Q * (1.0f / DM) - mu * mu, r = 1.0f / sqrtf(var + LN_EPS); fs_out[u.pm * BM + tid] = (f32x2){r, r * mu}; }
        }
    }
};
struct EpiMobaQKV {
    static constexpr bool PERM = true;
    bf16* O; const f32x2* tab; LnFold ln;
    __device__ __forceinline__ void operator()(f32x4 (&acc)[2][2][4][2], const Unit& u, int wr, int wc, int fr, int fq) const {
        ln_correct_nat(acc, ln, u, wr, wc, fr, fq);
        const int which = u.pn >> 3, hh = wc >> 1, i0 = 32 * (wc & 1) + 8 * fq;
        const unsigned row0 = (unsigned)(u.pm * BM + wr * 64 + fr);
        const unsigned o0 = (row0 * (3 * DM) + (unsigned)(u.pn * BM + hh * 128 + i0)) * 2u, t0 = ((row0 & (SEQ - 1)) * 64 + i0) * 8u;
        const float scale = which == 0 ? 0.08838834764831845f : 1.0f; const bool rope = which < 2;
#pragma unroll
        for (int ai = 0; ai < 2; ++ai)
#pragma unroll
            for (int m = 0; m < 4; ++m) { const unsigned to = t0 + (ai * HALF + m * 16) * (64 * 8);
#pragma unroll
                for (int q = 0; q < 4; ++q) { f32x4 t = ldo<f32x4>(tab, to + q * 16);
                    t[0] = rope ? t[0] : 1.f; t[1] = rope ? t[1] : 0.f; t[2] = rope ? t[2] : 1.f; t[3] = rope ? t[3] : 0.f;
                    const float a0 = ACC8(ai, 0, m, 2 * q), b0 = ACC8(ai, 1, m, 2 * q), a1 = ACC8(ai, 0, m, 2 * q + 1), b1 = ACC8(ai, 1, m, 2 * q + 1);
                    ACC8(ai, 0, m, 2 * q) = (a0 * t[0] - b0 * t[1]) * scale; ACC8(ai, 1, m, 2 * q) = (a0 * t[1] + b0 * t[0]) * scale;
                    ACC8(ai, 0, m, 2 * q + 1) = (a1 * t[2] - b1 * t[3]) * scale; ACC8(ai, 1, m, 2 * q + 1) = (a1 * t[3] + b1 * t[2]) * scale; }
                if (m & 1) asm volatile("" ::: "memory"); }
        __builtin_amdgcn_sched_barrier(0);
#pragma unroll
        for (int ai = 0; ai < 2; ++ai)
#pragma unroll
            for (int m = 0; m < 4; ++m) { const unsigned o = o0 + (ai * HALF + m * 16) * (3 * DM * 2); float x1[8], x2[8];
#pragma unroll
                for (int e = 0; e < 8; ++e) { x1[e] = ACC8(ai, 0, m, e); x2[e] = ACC8(ai, 1, m, e); }
                sto<u32x4>(O, o, pack8(x1)); sto<u32x4>(O, o + 128, pack8(x2)); }
    }
};
template <bool DUALT> struct EpiRopeNat256 {
    static constexpr bool PERM = true;
    bf16* O; unsigned ldc; const f32x2* tab; float scale; LnFold ln; bf16* OT;
    __device__ __forceinline__ void operator()(f32x4 (&acc)[2][2][4][2], const Unit& u, int wr, int wc, int fr, int fq) const {
        ln_correct_nat(acc, ln, u, wr, wc, fr, fq);
        const int i0 = 32 * wc + 8 * fq; const unsigned row0 = (unsigned)(u.pm * BM + wr * 64 + fr);
        const unsigned o0 = (row0 * ldc + (unsigned)(u.pn * BM + i0)) * 2u, t0 = ((row0 & (SEQ - 1)) * 128 + i0) * 8u;
        f32x4 tb[8][4];
#define RT_LOAD(i) do { const unsigned to_ = t0 + (unsigned)(((i) >> 2) * HALF + ((i) & 3) * 16) * (128 * 8); _Pragma("unroll") for (int q_ = 0; q_ < 4; ++q_) tb[i][q_] = ldo<f32x4>(tab, to_ + q_ * 16); } while (0)
        RT_LOAD(0); RT_LOAD(1);
#pragma unroll
        for (int i = 0; i < 8; ++i) { const int ai = i >> 2, m = i & 3; if (i + 2 < 8) RT_LOAD(i + 2);
            { const unsigned o = o0 + (ai * HALF + m * 16) * ldc * 2u; float x1[8], x2[8];
#pragma unroll
                for (int q = 0; q < 4; ++q) { const f32x4 t = tb[i][q];
                    const float a0 = ACC8(ai, 0, m, 2 * q), b0 = ACC8(ai, 1, m, 2 * q), a1 = ACC8(ai, 0, m, 2 * q + 1), b1 = ACC8(ai, 1, m, 2 * q + 1);
                    x1[2 * q] = (a0 * t[0] - b0 * t[1]) * scale; x2[2 * q] = (a0 * t[1] + b0 * t[0]) * scale; x1[2 * q + 1] = (a1 * t[2] - b1 * t[3]) * scale; x2[2 * q + 1] = (a1 * t[3] + b1 * t[2]) * scale; }
                const u32x4 p1 = pack8(x1), p2 = pack8(x2);
                sto<u32x4>(O, o, p1); sto<u32x4>(O, o + HALF * 2, p2);
                if (DUALT) { const unsigned t0o = (((unsigned)(u.pn * BM + i0)) * NTOK + row0 + ai * HALF + m * 16) * 2u;
#pragma unroll
                    for (int q = 0; q < 4; ++q) { sto<unsigned short>(OT, t0o + (2 * q) * (NTOK * 2), (unsigned short)(p1[q] & 0xffffu)); sto<unsigned short>(OT, t0o + (2 * q + 1) * (NTOK * 2), (unsigned short)(p1[q] >> 16));
                        sto<unsigned short>(OT, t0o + (HALF + 2 * q) * (NTOK * 2), (unsigned short)(p2[q] & 0xffffu)); sto<unsigned short>(OT, t0o + (HALF + 2 * q + 1) * (NTOK * 2), (unsigned short)(p2[q] >> 16)); } }
                if (m & 1) asm volatile("" ::: "memory"); } }
#undef RT_LOAD
    }
};
struct EpiVT {
    static constexpr bool PERM = true;
    bf16* O; unsigned ldc; LnFold ln;
    __device__ __forceinline__ void operator()(f32x4 (&acc)[2][2][4][2], const Unit& u, int wr, int wc, int fr, int fq) const {
        ln_correct_swp(acc, ln, u, wr, wc, fr, fq);
        const unsigned o0 = ((unsigned)(u.pm * BM + wr * 64 + fr) * ldc + (unsigned)(u.pn * BM + wc * 32 + 8 * fq)) * 2u; const float l2 = log2g(u.pm >> 1);
        float sc[2][8];
#pragma unroll
        for (int bj = 0; bj < 2; ++bj)
#pragma unroll
            for (int e = 0; e < 8; ++e) sc[bj][e] = fast_exp2(-(float)(bj * HALF + wc * 32 + 8 * fq + e + 1) * l2);
#pragma unroll
        for (int ai = 0; ai < 2; ++ai)
#pragma unroll
            for (int m = 0; m < 4; ++m) { const unsigned o = o0 + (unsigned)(ai * HALF + m * 16) * ldc * 2u;
#pragma unroll
                for (int bj = 0; bj < 2; ++bj) { float x[8];
#pragma unroll
                    for (int e = 0; e < 8; ++e) x[e] = ACC8(ai, bj, m, e) * sc[bj][e];
                    sto<u32x4>(O, o + bj * HALF * 2, pack8(x)); } }
    }
};
template <int ACT, bool LN> struct EpiAct {
    static constexpr bool PERM = true;
    bf16* O; unsigned ldc; LnFold ln;
    __device__ __forceinline__ void operator()(f32x4 (&acc)[2][2][4][2], const Unit& u, int wr, int wc, int fr, int fq) const {
        if (LN) ln_correct_nat(acc, ln, u, wr, wc, fr, fq);
        const unsigned o0 = ((unsigned)(u.pm * BM + wr * 64 + fr) * ldc + (unsigned)(u.pn * BM + wc * 32 + 8 * fq)) * 2u;
#pragma unroll
        for (int ai = 0; ai < 2; ++ai)
#pragma unroll
            for (int m = 0; m < 4; ++m) { const unsigned o = o0 + (unsigned)(ai * HALF + m * 16) * ldc * 2u; const int rl = ai * HALF + wr * 64 + m * 16 + fr;
#pragma unroll
                for (int bj = 0; bj < 2; ++bj) { float x[8];
#pragma unroll
                    for (int e = 0; e < 8; ++e) { float v = ACC8(ai, bj, m, e);
                        if (ACT == 1) v = silu(v);
                        if (ACT == 2) v = (bj * HALF + wc * 32 + 8 * fq + e <= rl) ? v : 0.f;
                        x[e] = v; }
                    sto<u32x4>(O, o + bj * HALF * 2, pack8(x)); } }
    }
};
struct EpiConv {
    static constexpr bool PERM = true;
    bf16* A; bf16* UH; const float* cw; const float* cb; LnFold ln;
    static __device__ __forceinline__ float conv1(float curf, float prvf, bool has_prev, int fr, float b, float w0, float w1, float w2) {
        const int cur = __builtin_bit_cast(int, curf), prv = __builtin_bit_cast(int, prvf); int r1 = 0, r2 = 0;
        if (has_prev) { r1 = __builtin_amdgcn_update_dpp(0, prv, 0x121, 0xf, 0xf, false); r2 = __builtin_amdgcn_update_dpp(0, prv, 0x122, 0xf, 0xf, false); }
        const int p1 = __builtin_amdgcn_update_dpp(r1, cur, 0x111, 0xf, 0xf, false), p2 = __builtin_amdgcn_update_dpp(r2, cur, 0x112, 0xf, 0xf, false);
        (void)fr;
        return b + w0 * __builtin_bit_cast(float, p2) + w1 * __builtin_bit_cast(float, p1) + w2 * curf;
    }
    __device__ __forceinline__ void operator()(f32x4 (&acc)[2][2][4][2], const Unit& u, int wr, int wc, int fr, int fq) const {
        ln_correct_nat(acc, ln, u, wr, wc, fr, fq);
        const unsigned cn = (unsigned)(u.pn * 128 + wc * 32 + 8 * fq);
#pragma unroll
        for (int ai = 0; ai < 2; ++ai) { const unsigned g4 = ((unsigned)u.pm * 4 + ai * 2 + wr) * 4u;
#pragma unroll
            for (int bj = 0; bj < 2; ++bj) { float x0[8], x3[8];
#pragma unroll
                for (int e = 0; e < 8; ++e) { x0[e] = ACC8(ai, bj, 0, e); x3[e] = ACC8(ai, bj, 3, e); }
                if (fr >= 14) sto<u32x4>(UH, ((g4 + (fr - 14)) * FF2 + bj * FF + cn) * 2u, pack8(x3));
                if (fr < 2) sto<u32x4>(UH, ((g4 + 2 + fr) * FF2 + bj * FF + cn) * 2u, pack8(x0)); } }
        __builtin_amdgcn_sched_barrier(0);
        unsigned ow[2][4][4];
        f32x2 cg0[4], cg1[4], cg2[4], cgb[4], cv0[4], cv1[4], cv2[4], cvb[4];
#pragma unroll
        for (int ep = 0; ep < 4; ++ep) { const unsigned co = (cn + 2 * ep) * 4u;
            cg0[ep] = ldo<f32x2>(cw, co); cg1[ep] = ldo<f32x2>(cw, co + FF2 * 4); cg2[ep] = ldo<f32x2>(cw, co + 2 * FF2 * 4); cgb[ep] = ldo<f32x2>(cb, co);
            cv0[ep] = ldo<f32x2>(cw, co + FF * 4); cv1[ep] = ldo<f32x2>(cw, co + (FF2 + FF) * 4); cv2[ep] = ldo<f32x2>(cw, co + (2 * FF2 + FF) * 4); cvb[ep] = ldo<f32x2>(cb, co + FF * 4); }
        __builtin_amdgcn_sched_barrier(0);
#pragma unroll
        for (int ep = 0; ep < 4; ++ep) {
#pragma unroll
            for (int ai = 0; ai < 2; ++ai)
#pragma unroll
                for (int m = 3; m >= 0; --m) { float r[2];
#pragma unroll
                    for (int hl = 0; hl < 2; ++hl) { const int e = 2 * ep + hl;
                        const float cg = conv1(ACC8(ai, 0, m, e), m > 0 ? ACC8(ai, 0, m > 0 ? m - 1 : 0, e) : 0.f, m > 0, fr, cgb[ep][hl], cg0[ep][hl], cg1[ep][hl], cg2[ep][hl]);
                        const float cv = conv1(ACC8(ai, 1, m, e), m > 0 ? ACC8(ai, 1, m > 0 ? m - 1 : 0, e) : 0.f, m > 0, fr, cvb[ep][hl], cv0[ep][hl], cv1[ep][hl], cv2[ep][hl]);
                        r[hl] = gelu_tanh(cg) * cv; }
                    ow[ai][m][ep] = cvt_pk_bf16(r[0], r[1]); }
            __builtin_amdgcn_sched_barrier(0);
        }
        const unsigned o0 = ((unsigned)(u.pm * BM + wr * 64 + fr) * FF + cn) * 2u;
#pragma unroll
        for (int ai = 0; ai < 2; ++ai)
#pragma unroll
            for (int m = 0; m < 4; ++m)
                if (m > 0 || fr >= 2) sto<u32x4>(A, o0 + (unsigned)(ai * HALF + m * 16) * (FF * 2), (u32x4){ow[ai][m][0], ow[ai][m][1], ow[ai][m][2], ow[ai][m][3]});
    }
};
#undef ACC8
template <class Epi>
__device__ __forceinline__ void gemm_phase(LAS unsigned char* lds, const int tid, const Desc g, const StaticOrder& S, const Epi& E) {
    const int wid = __builtin_amdgcn_readfirstlane(tid >> 6), lane = tid & 63, wr = wid >> 2, wc = wid & 3, fr = lane & 15, fq = lane >> 4;
    const int nt = g.nt, nt1 = g.nt1;
    unsigned voffA[2], voffB[2];
#pragma unroll
    for (int i = 0; i < 2; ++i) { int R, C; stage_rc(tid * 16 + i * 8192, R, C); const int Rb = Epi::PERM ? ((R & ~31) + perm32(R & 31)) : R;
        voffA[i] = (unsigned)(R * g.lda + C) * 2u; voffB[i] = (unsigned)(Rb * g.ldb + C) * 2u; }
    const size_t kstep = (size_t)(BK * 2);
    const size_t hstepA = (size_t)HALF * g.lda * 2, hstepB = (size_t)HALF * g.ldb * 2;
    const unsigned ldsw = (unsigned)wid * 1024u;
    const int aoff = lds_byte(wr * 64 + fr, fq * 8), boff = lds_byte(wc * 32 + fr, fq * 8);
#define PG8_SA(b, h) (((b) * 2 + (h)) * HTB)
#define PG8_SB(b, h) ((4 + (b) * 2 + (h)) * HTB)
#define PG8_STAGE(bufoff, gbase, voff) do { _Pragma("unroll") for (int _i = 0; _i < 2; ++_i) { unsigned keep_; \
        asm volatile("s_mov_b32 %0, m0\n\ts_mov_b32 m0, %3\n\ts_nop 0\n\tglobal_load_lds_dwordx4 %1, %2\n\ts_mov_b32 m0, %0" : "=&s"(keep_) \
                     : "v"((voff)[_i]), "s"((unsigned long long)(uintptr_t)(gbase)), "s"((unsigned)(uintptr_t)(lds + (bufoff) + ldsw + _i * 8192)) : "memory"); } } while (0)
#define PG8_LDA(dst, b, h) do { _Pragma("unroll") for (int m = 0; m < 4; ++m) _Pragma("unroll") for (int k = 0; k < 2; ++k) dst[m][k] = *(const LAS bf16x8*)(lds + PG8_SA(b, h) + aoff + m * 2048 + k * 1024); } while (0)
#define PG8_LDB(dst, b, h) do { _Pragma("unroll") for (int n = 0; n < 2; ++n) _Pragma("unroll") for (int k = 0; k < 2; ++k) dst[n][k] = *(const LAS bf16x8*)(lds + PG8_SB(b, h) + boff + n * 2048 + k * 1024); } while (0)
#define PG8_MMA(ai, bj, At, Bt) do { __builtin_amdgcn_s_setprio(1); _Pragma("unroll") for (int m = 0; m < 4; ++m) _Pragma("unroll") for (int n = 0; n < 2; ++n) _Pragma("unroll") for (int k = 0; k < 2; ++k) \
        acc[ai][bj][m][n] = __builtin_amdgcn_mfma_f32_16x16x32_bf16(Bt[n][k], At[m][k], acc[ai][bj][m][n], 0, 0, 0); __builtin_amdgcn_s_setprio(0); } while (0)
#define PG8_WAIT_V(n) asm volatile("s_waitcnt vmcnt(" #n ")" ::: "memory")
#define PG8_WAIT_L(n) asm volatile("s_waitcnt lgkmcnt(" #n ")" ::: "memory")
#define PG8_BAR __builtin_amdgcn_s_barrier()
#define PG8_SCHED __builtin_amdgcn_sched_barrier(0)
#define PG8_PTRS(u, pa, pb) do { const long oa_ = (long)((u).pm >> g.shAm) * g.sAm + (long)((u).pn >> g.shAn) * g.sAn, ob_ = (long)((u).pm >> g.shBm) * g.sBm + (long)((u).pn >> g.shBn) * g.sBn; \
        pa = (const char*)(g.A + oa_); pb = (const char*)(g.B + ob_); } while (0)
    const long dA2 = ((const char*)g.A2 - (const char*)g.A) - (long)nt1 * (long)kstep, dB2 = ((const char*)g.B2 - (const char*)g.B) - (long)nt1 * (long)kstep;
    Unit cur, nxt; int ui = 0;
    if (!S.next(0, cur)) return;
    f32x4 acc[2][2][4][2];
#pragma unroll
    for (int a = 0; a < 2; ++a)
#pragma unroll
        for (int b = 0; b < 2; ++b)
#pragma unroll
            for (int m = 0; m < 4; ++m)
#pragma unroll
                for (int n = 0; n < 2; ++n) acc[a][b][m][n] = (f32x4){0.f, 0.f, 0.f, 0.f};
    bf16x8 At[4][2], B0[2][2], B1[2][2];
    const char *cA, *cB;
    PG8_PTRS(cur, cA, cB);
    PG8_STAGE(PG8_SB(0, 0), cB, voffB); PG8_STAGE(PG8_SB(0, 1), cB + hstepB, voffB); PG8_STAGE(PG8_SA(0, 0), cA, voffA); PG8_STAGE(PG8_SA(0, 1), cA + hstepA, voffA);
    if (wr == 1) PG8_BAR;
    PG8_WAIT_V(2); PG8_BAR;
    PG8_STAGE(PG8_SB(1, 0), cB + kstep, voffB); PG8_STAGE(PG8_SA(1, 0), cA + kstep, voffA); PG8_STAGE(PG8_SB(1, 1), cB + hstepB + kstep, voffB);
    PG8_WAIT_V(6); PG8_BAR;
    for (;;) {
        const bool has_next = S.next(ui + 1, nxt);
        const char *nA = cA, *nB = cB;
        if (has_next) PG8_PTRS(nxt, nA, nB);
        for (int t = 0; t < nt; t += 2) {
            const bool last = (t == nt - 2);
            const char* a1 = cA + (size_t)(t + 1) * kstep + ((t + 1 < nt1) ? 0L : dA2);
            const char* a2 = last ? nA : cA + (size_t)(t + 2) * kstep + ((t + 2 < nt1) ? 0L : dA2);
            const char* b2 = last ? nB : cB + (size_t)(t + 2) * kstep + ((t + 2 < nt1) ? 0L : dB2);
            const char* a3 = a2 + kstep; const char* b3 = b2 + kstep;
            PG8_LDB(B0, 0, 0); PG8_LDB(B1, 0, 1); PG8_SCHED; PG8_LDA(At, 0, 0); PG8_STAGE(PG8_SA(1, 1), a1 + hstepA, voffA);
            PG8_WAIT_V(8); PG8_WAIT_L(0); PG8_BAR; PG8_MMA(0, 0, At, B0); PG8_MMA(0, 1, At, B1); PG8_BAR; PG8_SCHED;
            PG8_LDA(At, 0, 1); PG8_STAGE(PG8_SB(0, 0), b2, voffB); PG8_STAGE(PG8_SB(0, 1), b2 + hstepB, voffB); PG8_STAGE(PG8_SA(0, 0), a2, voffA);
            PG8_WAIT_V(8); PG8_WAIT_L(0); PG8_BAR; PG8_MMA(1, 0, At, B0); PG8_MMA(1, 1, At, B1); PG8_BAR; PG8_SCHED;
            PG8_LDB(B0, 1, 0); PG8_LDB(B1, 1, 1); PG8_SCHED; PG8_LDA(At, 1, 0); PG8_STAGE(PG8_SA(0, 1), a2 + hstepA, voffA);
            PG8_WAIT_V(8); PG8_WAIT_L(0); PG8_BAR; PG8_MMA(0, 0, At, B0); PG8_MMA(0, 1, At, B1); PG8_BAR; PG8_SCHED;
            PG8_LDA(At, 1, 1); PG8_STAGE(PG8_SB(1, 0), b3, voffB); PG8_STAGE(PG8_SB(1, 1), b3 + hstepB, voffB); PG8_STAGE(PG8_SA(1, 0), a3, voffA);
            PG8_WAIT_V(8); PG8_WAIT_L(0); PG8_BAR; PG8_MMA(1, 0, At, B0); PG8_MMA(1, 1, At, B1); PG8_BAR; PG8_SCHED;
        }
        if (wr == 0) PG8_BAR;
        { int lane_e, wr_ = wr, wc_ = wc; asm volatile("v_mbcnt_lo_u32_b32 %0, -1, 0\n\tv_mbcnt_hi_u32_b32 %0, -1, %0" : "=v"(lane_e)); asm volatile("" : "+s"(wr_), "+s"(wc_));
          E(acc, cur, wr_, wc_, lane_e & 15, lane_e >> 4); }
        if (!has_next) break;
#pragma unroll
        for (int a = 0; a < 2; ++a)
#pragma unroll
            for (int b = 0; b < 2; ++b)
#pragma unroll
                for (int m = 0; m < 4; ++m)
#pragma unroll
                    for (int n = 0; n < 2; ++n) acc[a][b][m][n] = (f32x4){0.f, 0.f, 0.f, 0.f};
        cur = nxt; cA = nA; cB = nB; ++ui;
        if (wr == 1) PG8_BAR;
    }
    PG8_WAIT_V(0);
    PG8_BAR;
#undef PG8_SA
#undef PG8_SB
#undef PG8_STAGE
#undef PG8_LDA
#undef PG8_LDB
#undef PG8_MMA
#undef PG8_WAIT_V
#undef PG8_WAIT_L
#undef PG8_BAR
#undef PG8_SCHED
#undef PG8_PTRS
}
}

constexpr size_t MiB = 1u << 20;
constexpr size_t WS_CTL = 0, CTL_ZERO_BYTES = 1 * MiB;
constexpr size_t WS_TABA = 2 * MiB;
constexpr size_t WS_TABR = 6 * MiB;
constexpr size_t WS_KMEAN = 14 * MiB;
constexpr size_t WS_W = 16 * MiB;
constexpr size_t W_MQKV = WS_W, W_MO = W_MQKV + 48 * MiB, W_RQ = W_MO + 16 * MiB, W_RK = W_RQ + 16 * MiB, W_RV = W_RK + 16 * MiB,
                 W_RG = W_RV + 32 * MiB, W_RO = W_RG + 32 * MiB, W_FI = W_RO + 32 * MiB, W_FO = W_FI + 176 * MiB, W_END = W_FO + 88 * MiB;
constexpr size_t WS_HN = W_END;
constexpr size_t WS_ACT = WS_HN + 64 * MiB;
constexpr size_t A_QKV = WS_ACT, A_MO = WS_ACT + 192 * MiB, A_MLIST = A_MO + 64 * MiB, A_MPO = A_MLIST + 32 * MiB, A_MPML = A_MPO + 192 * MiB;
constexpr size_t A_U = WS_ACT, A_FA = WS_ACT + 352 * MiB;
constexpr size_t A_RQ = WS_ACT, A_RK = A_RQ + 64 * MiB, A_RKT = A_RK + 64 * MiB, A_RVT = A_RKT + 64 * MiB, A_RG = A_RVT + 128 * MiB,
                 A_RP = A_RG + 128 * MiB, A_RU = A_RP + 64 * MiB, A_RRT = A_RU + 128 * MiB, A_REND = A_RRT + 128 * MiB;
constexpr size_t WS_TABRT = A_REND;
constexpr size_t WS_KMP = WS_TABRT + 8 * MiB;
constexpr size_t WS_STATS = WS_KMP + 3 * MiB;
constexpr size_t WS_FSTATS = WS_STATS + 1 * MiB;
constexpr int NCOLG = 75776;
constexpr int CO_M1 = 0, CO_R = 6144, CO_F = 30720, CO_ID = NCOLG, NCOLT = NCOLG + 6144;
constexpr size_t WS_GWP = WS_STATS + 2 * MiB;
constexpr size_t WS_GW = WS_GWP + 20 * MiB;
constexpr size_t WS_NEED = WS_GW + 1 * MiB;
static_assert(W_END == 472 * MiB && WS_ACT == 536 * MiB && WS_NEED == 1338 * MiB && 2 * 32 * NCOLG * 4 <= 20 * MiB, "ws map");

constexpr int RING_BYTES = 131072, LDSCTL_OFF = 144384, MISC_OFF = LDSCTL_OFF + 320, LDS_BYTES = 147456;
constexpr int NWAVES = 8;

#define XB_TMO      128
#define XB_XCNT(j)  (256  + 64 * (j))
#define XB_XSUB(j)  (1280 + 64 * (j))
#define XB_XGEN(j)  (2304 + 64 * (j))
#define XB_TOP      3328
#define XB_TOPGEN   3392
#define XCD_BAR_WORDS 3456
#define XB_SPIN_CAP (1u << 18)
constexpr int CW_BAR = 4096, CW_PANEL = 16384, CW_CNT = 8192;
__device__ __forceinline__ unsigned xb_ld(unsigned* p)              { return __hip_atomic_load(p, __ATOMIC_RELAXED, __HIP_MEMORY_SCOPE_AGENT); }
__device__ __forceinline__ unsigned xb_add(unsigned* p, unsigned v) { return __hip_atomic_fetch_add(p, v, __ATOMIC_RELAXED, __HIP_MEMORY_SCOPE_AGENT); }
__device__ __forceinline__ unsigned xb_xcc_id() { return (unsigned)__builtin_amdgcn_s_getreg((3 << 11) | 20) & 0xFu; }
#define XB_SPIN(cond, bar) do { unsigned _sp = 0; while (cond) { __builtin_amdgcn_s_sleep(1); \
    if ((++_sp & 255u) == 0u) { if (xb_ld(&(bar)[XB_TMO])) break; if (_sp > XB_SPIN_CAP) { atomicAdd(&(bar)[XB_TMO], 1u); break; } } } } while (0)
struct XcdBarrier { unsigned* bar; unsigned x; volatile LAS unsigned* st; };
__device__ __forceinline__ XcdBarrier xcd_barrier_post(unsigned* bar, volatile LAS unsigned* st) {
    XcdBarrier b; b.bar = bar; b.x = xb_xcc_id(); b.st = st;
    if (threadIdx.x == 0) (void)xb_add(&bar[XB_XCNT(b.x)], 1u);
    return b;
}
__device__ __forceinline__ void xcd_barrier_complete(unsigned* bar, unsigned x, unsigned& nloc, unsigned& nx) {
    const unsigned G = gridDim.x * gridDim.y * gridDim.z;
    unsigned sum, cnt, mine, sp = 0u;
    for (;;) {
        sum = 0u; cnt = 0u; mine = 0u;
#pragma unroll
        for (unsigned j = 0; j < 16; ++j) { const unsigned c = xb_ld(&bar[XB_XCNT(j)]); sum += c; cnt += (c > 0u) ? 1u : 0u; mine = (j == x) ? c : mine; }
        if (sum == G) break;
        __builtin_amdgcn_s_sleep(1);
        if ((++sp & 255u) == 0u) { if (xb_ld(&bar[XB_TMO])) break; if (sp > XB_SPIN_CAP) { atomicAdd(&bar[XB_TMO], 1u); break; } }
    }
    nloc = mine > 0u ? mine : 1u; nx = cnt > 0u ? cnt : 1u;
}
__device__ __forceinline__ void xcd_barrier(const XcdBarrier& b) {
    asm volatile("s_waitcnt vmcnt(0)" ::: "memory");
    __syncthreads();
    if (threadIdx.x == 0) {
        unsigned* bar = b.bar;
        __builtin_amdgcn_s_waitcnt(0);
        unsigned nloc = b.st[0], nx = b.st[1];
        if (nloc == 0u) { xcd_barrier_complete(bar, b.x, nloc, nx); b.st[0] = nloc; b.st[1] = nx; }
        const unsigned old = xb_add(&bar[XB_XSUB(b.x)], 1u);
        const unsigned gen = old / nloc;
        if (old + 1u == (gen + 1u) * nloc) {
            __builtin_amdgcn_fence(__ATOMIC_RELEASE, "agent");
            asm volatile("s_waitcnt vmcnt(0)" ::: "memory");
            const unsigned og = xb_add(&bar[XB_TOP], 1u);
            const unsigned tg = og / nx;
            if (og + 1u == (tg + 1u) * nx) xb_add(&bar[XB_TOPGEN], 1u);
            else XB_SPIN(xb_ld(&bar[XB_TOPGEN]) == tg, bar);
            __builtin_amdgcn_fence(__ATOMIC_ACQUIRE, "agent");
            xb_add(&bar[XB_XGEN(b.x)], 1u);
            asm volatile("s_waitcnt vmcnt(0)" ::: "memory");
        } else {
            XB_SPIN(xb_ld(&bar[XB_XGEN(b.x)]) == gen, bar);
            __builtin_amdgcn_fence(__ATOMIC_ACQUIRE, "agent");
            asm volatile("s_waitcnt vmcnt(0)" ::: "memory");
        }
    }
    __syncthreads();
}

struct Args {
    const float* in[14];
    float* out; unsigned char* ws;
    int ph_lo, ph_hi;
};
struct Ctx { int tid, lane, wave, bid, G, gw, NGW, gt, NGT; LAS unsigned char* lds; };

__device__ __forceinline__ void transpose_item(const int PERMODE, const float* W, int K, int N, bf16* WT, LAS float* scr, int item, int lane, const float* fg, const float* fb, float* pgw) {
    const int kblk = K / 64, nb = item / kblk, kb = item % kblk, k0 = 64 * kb, n0 = 64 * nb;
    const int fh = n0 >= FF ? 1 : 0, fw = n0 - fh * FF;
    const int r0 = PERMODE == 1 ? ((n0 >> 8) * 256 + ((n0 >> 6) & 1) * 128 + ((n0 >> 7) & 1) * 64) : PERMODE == 2 ? ((fw >> 7) * 256 + fh * 128 + (fw & 127)) : n0;
    f32x4 v[16];
    const float* src = W + (size_t)(k0 + (lane >> 4)) * N + n0 + 4 * (lane & 15);
#pragma unroll
    for (int i = 0; i < 16; ++i) v[i] = *(const f32x4*)(src + (size_t)(4 * i) * N);
#pragma unroll
    for (int i = 0; i < 16; ++i) { LAS float* d = scr + (4 * i + (lane >> 4)) * 65 + 4 * (lane & 15); d[0] = v[i][0]; d[1] = v[i][1]; d[2] = v[i][2]; d[3] = v[i][3]; }
    asm volatile("s_waitcnt lgkmcnt(0)" ::: "memory");
    const int c = lane & 7;
    float gk[8], bk[8];
#pragma unroll
    for (int t = 0; t < 8; ++t) { gk[t] = 1.f; bk[t] = 0.f; }
    if (fg) {
        const f32x4 g0 = *(const f32x4*)(fg + k0 + 8 * c), g1 = *(const f32x4*)(fg + k0 + 8 * c + 4), b0 = *(const f32x4*)(fb + k0 + 8 * c), b1 = *(const f32x4*)(fb + k0 + 8 * c + 4);
#pragma unroll
        for (int t = 0; t < 4; ++t) { gk[t] = g0[t]; gk[4 + t] = g1[t]; bk[t] = b0[t]; bk[4 + t] = b1[t]; } }
#pragma unroll
    for (int j = 0; j < 8; ++j) { const int n = (lane >> 3) + 8 * j; const LAS float* q = scr + (8 * c) * 65 + n;
        float w[8];
#pragma unroll
        for (int t = 0; t < 8; ++t) w[t] = q[t * 65];
        u32x4 o; o.x = cvt_pk_bf16(w[0] * gk[0], w[1] * gk[1]); o.y = cvt_pk_bf16(w[2] * gk[2], w[3] * gk[3]); o.z = cvt_pk_bf16(w[4] * gk[4], w[5] * gk[5]); o.w = cvt_pk_bf16(w[6] * gk[6], w[7] * gk[7]);
        *(u32x4*)(WT + (size_t)(r0 + n) * K + k0 + 8 * c) = o;
        if (fg) {
            float pg = ((bflo(o.x) + bfhi(o.x)) + (bflo(o.y) + bfhi(o.y))) + ((bflo(o.z) + bfhi(o.z)) + (bflo(o.w) + bfhi(o.w)));
            float pb = ((w[0] * bk[0] + w[1] * bk[1]) + (w[2] * bk[2] + w[3] * bk[3])) + ((w[4] * bk[4] + w[5] * bk[5]) + (w[6] * bk[6] + w[7] * bk[7]));
            pg += shx(pg, 1, lane); pg += shx(pg, 2, lane); pg += shx(pg, 4, lane); pb += shx(pb, 1, lane); pb += shx(pb, 2, lane); pb += shx(pb, 4, lane);
            if (c == 0) { pgw[(size_t)kb * NCOLG + r0 + n] = pg; pgw[(size_t)(32 + kb) * NCOLG + r0 + n] = pb; } } }
    asm volatile("s_waitcnt lgkmcnt(0)" ::: "memory");
}
__device__ __forceinline__ void ph_prologue(const Ctx& C, const Args& a) {
    unsigned char* ws = a.ws;
    {
        LAS float* scr = (LAS float*)(C.lds + C.wave * 16640);
        constexpr int PJ = 12288, PL = 8448, NJ = 2 * PJ, NIT = NJ + 4 * PL;
        for (int g = C.gw; g < NIT; g += C.NGW) {
            const float* W; bf16* WT; int K, N, item; int perm = 0; int lnidx = -1, cob = 0;
            if (g < NJ) { const int j = g / PJ, r = g % PJ;
                if (r < 3072)      { W = a.in[1] + (size_t)j * DM * 3 * DM; WT = (bf16*)(ws + W_MQKV) + (size_t)j * 3 * DM * DM; K = DM; N = 3 * DM; item = r; perm = 1; if (j == 1) { lnidx = 3; cob = CO_M1; } }
                else if (r < 4096) { W = a.in[2] + (size_t)j * DM * DM; WT = (bf16*)(ws + W_MO) + (size_t)j * DM * DM; K = DM; N = DM; item = r - 3072; }
                else if (r < 5120) { W = a.in[3] + (size_t)j * DM * DM; WT = (bf16*)(ws + W_RQ) + (size_t)j * DM * DM; K = DM; N = DM; item = r - 4096; lnidx = 4 * j + 1; cob = CO_R + j * 12288; }
                else if (r < 6144) { W = a.in[4] + (size_t)j * DM * DM; WT = (bf16*)(ws + W_RK) + (size_t)j * DM * DM; K = DM; N = DM; item = r - 5120; lnidx = 4 * j + 1; cob = CO_R + j * 12288 + 2048; }
                else if (r < 8192) { W = a.in[5] + (size_t)j * DM * 2 * DM; WT = (bf16*)(ws + W_RV) + (size_t)j * 2 * DM * DM; K = DM; N = 2 * DM; item = r - 6144; lnidx = 4 * j + 1; cob = CO_R + j * 12288 + 4096; }
                else if (r < 10240) { W = a.in[6] + (size_t)j * DM * 2 * DM; WT = (bf16*)(ws + W_RG) + (size_t)j * 2 * DM * DM; K = DM; N = 2 * DM; item = r - 8192; lnidx = 4 * j + 1; cob = CO_R + j * 12288 + 8192; }
                else               { W = a.in[7] + (size_t)j * 2 * DM * DM; WT = (bf16*)(ws + W_RO) + (size_t)j * 2 * DM * DM; K = 2 * DM; N = DM; item = r - 10240; }
            } else { const int l = (g - NJ) / PL, r = (g - NJ) % PL;
                if (r < 5632) { W = a.in[8] + (size_t)l * DM * FF2; WT = (bf16*)(ws + W_FI) + (size_t)l * FF2 * DM; K = DM; N = FF2; item = r; perm = 2; lnidx = 2 * l; cob = CO_F + l * 11264; }
                else          { W = a.in[11] + (size_t)l * FF * DM; WT = (bf16*)(ws + W_FO) + (size_t)l * FF * DM; K = FF; N = DM; item = r - 5632; }
            }
            const float* fg = lnidx >= 0 ? a.in[12] + (size_t)lnidx * DM : nullptr; const float* fb = lnidx >= 0 ? a.in[13] + (size_t)lnidx * DM : nullptr;
            transpose_item(perm, W, K, N, WT, scr, item, C.lane, fg, fb, (float*)(ws + WS_GWP) + cob);
        }
    }
    f32x2* ta = (f32x2*)(ws + WS_TABA); f32x2* tr = (f32x2*)(ws + WS_TABR);
    for (int i = C.gt; i < SEQ * 64; i += C.NGT) { const int pos = i >> 6, f = i & 63; float s, c; sincos_acc((float)pos * INV_A[f], s, c); ta[i] = (f32x2){c, s}; }
    for (int i = C.gt; i < SEQ * 128; i += C.NGT) { const int pos = i >> 7, f = i & 127; float s, c; sincos_acc((float)pos * INV_R[f], s, c); tr[i] = (f32x2){c, s}; }
    { f32x4* st = (f32x4*)(ws + WS_FSTATS);
      for (int i = C.gt; i < NTOK / 2; i += C.NGT) st[i] = (f32x4){1.f, 0.f, 1.f, 0.f}; }
    const f32x4* x4 = (const f32x4*)a.in[0]; u32x2* hn = (u32x2*)(ws + WS_HN);
    for (int i = C.gt; i < NTOK * DM / 4; i += 4 * C.NGT) { f32x4 v[4];
#pragma unroll
        for (int q = 0; q < 4; ++q) v[q] = x4[i + q * C.NGT];
#pragma unroll
        for (int q = 0; q < 4; ++q) hn[i + q * C.NGT] = (u32x2){cvt_pk_bf16(v[q][0], v[q][1]), cvt_pk_bf16(v[q][2], v[q][3])}; }
}
__device__ __forceinline__ void ph_stats_final(const Ctx& C, const f32x2* part, f32x2* FS) {
    for (int row = C.gt; row < NTOK; row += C.NGT) { const f32x4* p = (const f32x4*)(part + (size_t)row * 8); const f32x4 a = p[0], b = p[1], c = p[2], d = p[3];
        const float S = ((a[0] + a[2]) + (b[0] + b[2])) + ((c[0] + c[2]) + (d[0] + d[2])), Q = ((a[1] + a[3]) + (b[1] + b[3])) + ((c[1] + c[3]) + (d[1] + d[3]));
        const float mu = S * (1.0f / DM), var = Q * (1.0f / DM) - mu * mu, r = 1.0f / sqrtf(var + LN_EPS); FS[row] = (f32x2){r, r * mu}; }
}
__device__ __forceinline__ void ph_fold_reduce(const Ctx& C, const float* P, float* GWv) {
    for (int i = C.gt; i < 2 * NCOLT; i += C.NGT) { const int which = i / NCOLT, col = i % NCOLT; float s = 0.f;
        if (col < NCOLG) for (int kb = 0; kb < 32; ++kb) s += P[(size_t)(which * 32 + kb) * NCOLG + col];
        GWv[i] = s; }
}
__device__ __forceinline__ void ph_ln_final(const Ctx& C, const bf16* TNp, float* Out, const float* g, const float* bta) {
    f32x4 gq[8], bq[8];
#pragma unroll
    for (int j = 0; j < 4; ++j) { const int c0 = 512 * j + 8 * C.lane; gq[2 * j] = *(const f32x4*)(g + c0); gq[2 * j + 1] = *(const f32x4*)(g + c0 + 4); bq[2 * j] = *(const f32x4*)(bta + c0); bq[2 * j + 1] = *(const f32x4*)(bta + c0 + 4); }
    int row = C.gw; u32x4 w4[4];
    if (row < NTOK) {
#pragma unroll
        for (int j = 0; j < 4; ++j) w4[j] = ((const u32x4*)(TNp + (size_t)row * DM) + C.lane)[64 * j]; }
#pragma unroll 1
    for (; row < NTOK; row += C.NGW) {
        u32x4 n4[4]; const int nr = row + C.NGW;
        if (nr < NTOK) {
#pragma unroll
            for (int j = 0; j < 4; ++j) n4[j] = ((const u32x4*)(TNp + (size_t)nr * DM) + C.lane)[64 * j]; }
        else {
#pragma unroll
            for (int j = 0; j < 4; ++j) n4[j] = (u32x4){0u, 0u, 0u, 0u}; }
        float v[32]; float s = 0.f;
#pragma unroll
        for (int j = 0; j < 4; ++j) {
#pragma unroll
            for (int q = 0; q < 4; ++q) { v[8 * j + 2 * q] = bflo(w4[j][q]); v[8 * j + 2 * q + 1] = bfhi(w4[j][q]); s += v[8 * j + 2 * q] + v[8 * j + 2 * q + 1]; } }
        const float mean = wave_sum(s, C.lane) * (1.f / DM); float s2 = 0.f;
#pragma unroll
        for (int j = 0; j < 32; ++j) { v[j] -= mean; s2 += v[j] * v[j]; }
        const float rstd = 1.f / sqrtf(wave_sum(s2, C.lane) * (1.f / DM) + LN_EPS);
#pragma unroll
        for (int j = 0; j < 4; ++j) { const int c0 = 512 * j + 8 * C.lane;
            f32x4 o0, o1;
#pragma unroll
            for (int e = 0; e < 4; ++e) { o0[e] = v[8 * j + e] * rstd * gq[2 * j][e] + bq[2 * j][e]; o1[e] = v[8 * j + 4 + e] * rstd * gq[2 * j + 1][e] + bq[2 * j + 1][e]; }
            *(f32x4*)(Out + (size_t)row * DM + c0) = o0; *(f32x4*)(Out + (size_t)row * DM + c0 + 4) = o1; }
#pragma unroll
        for (int j = 0; j < 4; ++j) w4[j] = n4[j];
    }
}
__device__ __forceinline__ void ph_kmean(const Ctx& C, const bf16* QKV, float* KMo) {
    for (int it = C.gw; it < 2 * MH * MNB; it += C.NGW) {
        const int b = it / (MH * MNB), h = (it / MNB) % MH, j = it % MNB, c = C.lane & 15, rs = C.lane >> 4;
        const bf16* kp = QKV + (size_t)(b * SEQ + j * MBLK + rs) * (3 * DM) + DM + h * MHD + 8 * c;
        float a[8];
#pragma unroll
        for (int e = 0; e < 8; ++e) a[e] = 0.f;
#pragma unroll 1
        for (int r0 = 0; r0 < MBLK / 4; r0 += 16) {
            u32x4 w[16];
#pragma unroll
            for (int r = 0; r < 16; ++r) w[r] = *(const u32x4*)(kp + (size_t)(4 * (r0 + r)) * (3 * DM));
#pragma unroll
            for (int r = 0; r < 16; ++r)
#pragma unroll
                for (int q = 0; q < 4; ++q) { a[2 * q] += bflo(w[r][q]); a[2 * q + 1] += bfhi(w[r][q]); } }
#pragma unroll
        for (int e = 0; e < 8; ++e) { a[e] += shx(a[e], 16, C.lane); a[e] += shx(a[e], 32, C.lane); a[e] *= (1.0f / MBLK); }
        if (rs == 0) { float* o = KMo + (size_t)((b * MH + h) * MNB + j) * MHD + 8 * c; *(f32x4*)o = (f32x4){a[0], a[1], a[2], a[3]}; *(f32x4*)(o + 4) = (f32x4){a[4], a[5], a[6], a[7]}; }
    }
}

namespace mattn {
constexpr int D = 128, KVBLK = 64, SHM_V = KVBLK * D * 2, SHM_K = KVBLK * D * 2;
constexpr int OFF_V = 0, OFF_K = 2 * SHM_V, OFF_WS = 2 * SHM_V + 2 * SHM_K, OFF_STG = OFF_WS + 8 * 1024, OFF_PRE = OFF_STG + 8 * 8192, OFF_WT = OFF_PRE + 1032 * 4;
constexpr long LDQ = 3 * DM;
constexpr int LIST_CAP = 8192;
constexpr float C2 = 1.4426950408889634f;
constexpr float THR = 8.f;
typedef float f32x16 __attribute__((ext_vector_type(16)));
typedef short s16x4 __attribute__((ext_vector_type(4)));
#define KSWZ(row, colB) ((row) * 256 + ((colB) ^ (((row) & 7) << 4)))
#define SBAR() __builtin_amdgcn_sched_barrier(0)
__device__ __forceinline__ int v_st(int k, int c) { const int kk = (k & ~0xC) | ((k & 4) << 1) | ((k & 8) >> 1); return ((kk >> 3) * 4 + (c >> 5)) * 512 + ((kk & 7) * 32 + (c & 31)) * 2; }
__device__ __forceinline__ int v_rd_base(int lane) { return ((lane & 3) << 3) | (((lane >> 2) & 3) << 6) | (((lane >> 4) & 1) << 5) | (((lane >> 5) & 1) << 8); }
constexpr int v_rd_off(int d0, int ks, int half) { return d0 * 512 + ks * 4096 + half * 2048; }
__device__ __forceinline__ int crow(int r, int hi) { return (r & 3) + 8 * (r >> 2) + 4 * hi; }
__device__ __forceinline__ void partialSM(f32x16& p0, f32x16& p1, float& m_reg, float& mn, float& alpha) {
    float pmax = p0[0];
#pragma unroll
    for (int r = 1; r < 16; ++r) pmax = fmaxf(pmax, p0[r]);
#pragma unroll
    for (int r = 0; r < 16; ++r) pmax = fmaxf(pmax, p1[r]);
    { auto rr = __builtin_amdgcn_permlane32_swap(__float_as_uint(pmax), __float_as_uint(pmax), false, false);
      pmax = fmaxf(__uint_as_float(rr[0]), __uint_as_float(rr[1])); }
    if (__builtin_expect(__all((pmax - m_reg) <= THR), 1)) { mn = m_reg; alpha = 1.f; }
    else { mn = fmaxf(m_reg, pmax); alpha = __builtin_amdgcn_exp2f((m_reg - mn) * C2); m_reg = mn; }
    const float mnL = -mn * C2;
#pragma unroll
    for (int r = 0; r < 16; ++r) p0[r] = fmaf(p0[r], C2, mnL);
#pragma unroll
    for (int r = 0; r < 16; ++r) p1[r] = fmaf(p1[r], C2, mnL);
#pragma unroll
    for (int r = 0; r < 16; ++r) p0[r] = __builtin_amdgcn_exp2f(p0[r]);
}
__device__ __forceinline__ void finishSM(f32x16& p0, f32x16& p1, float alpha, float& l_reg, bf16x8& pa0, bf16x8& pa1, bf16x8& pa2, bf16x8& pa3) {
#pragma unroll
    for (int r = 0; r < 16; ++r) p1[r] = __builtin_amdgcn_exp2f(p1[r]);
    float ps = 0;
#pragma unroll
    for (int r = 0; r < 16; ++r) ps += p0[r];
#pragma unroll
    for (int r = 0; r < 16; ++r) ps += p1[r];
    { auto rr = __builtin_amdgcn_permlane32_swap(__float_as_uint(ps), __float_as_uint(ps), false, false);
      ps = __uint_as_float(rr[0]) + __uint_as_float(rr[1]); }
    l_reg = l_reg * alpha + ps;
#define PK4(P, B_, OUT) do { unsigned a0 = cvt_pk_bf16(P[B_+0], P[B_+1]), a1 = cvt_pk_bf16(P[B_+2], P[B_+3]);                          \
        unsigned b0 = cvt_pk_bf16(P[B_+4], P[B_+5]), b1 = cvt_pk_bf16(P[B_+6], P[B_+7]);                                             \
        auto r0 = __builtin_amdgcn_permlane32_swap(a0, b0, false, false); auto r1 = __builtin_amdgcn_permlane32_swap(a1, b1, false, false); \
        u32x4 w = {r0[0], r1[0], r0[1], r1[1]}; OUT = __builtin_bit_cast(bf16x8, w); } while (0)
    PK4(p0, 0, pa0); PK4(p0, 8, pa1); PK4(p1, 0, pa2); PK4(p1, 8, pa3);
#undef PK4
}
template <int KB>
__device__ __forceinline__ void qkt(f32x16& p0, f32x16& p1, const LAS char* K_lds, int r32, int hi, const bf16x8* qr) {
    p0 = f32x16{}; p1 = f32x16{};
    const LAS char* kb[4];
#pragma unroll
    for (int dd = 0; dd < 4; ++dd) kb[dd] = K_lds + KB * SHM_K + KSWZ(r32, (dd * 16 + hi * 8) * 2);
#pragma unroll
    for (int d0 = 0; d0 < 8; ++d0) { const LAS char* a = kb[d0 & 3] + (d0 >> 2) * 128;
        const bf16x8 b0 = *(const LAS bf16x8*)a;
        const bf16x8 b1 = *(const LAS bf16x8*)(a + 32 * 256);
        p0 = __builtin_amdgcn_mfma_f32_32x32x16_bf16(b0, qr[d0], p0, 0, 0, 0);
        p1 = __builtin_amdgcn_mfma_f32_32x32x16_bf16(b1, qr[d0], p1, 0, 0, 0); }
}
template <int VB>
__device__ __forceinline__ void pv_tile(f32x16* o, int vb0, bf16x8 pa0, bf16x8 pa1, bf16x8 pa2, bf16x8 pa3) {
#define TRRD(dst, off) asm volatile("ds_read_b64_tr_b16 %0, %1 offset:%2" : "=&v"(dst) : "v"(vb0), "i"(off) : "memory")
#define PV_D0(d0) do { s16x4 l0, l1, l2, l3, h0, h1, h2, h3; constexpr int b_ = VB * SHM_V + v_rd_off(d0, 0, 0); \
        TRRD(l0, b_); TRRD(h0, b_ + 2048); TRRD(l1, b_ + 4096); TRRD(h1, b_ + 6144); TRRD(l2, b_ + 8192); TRRD(h2, b_ + 10240); TRRD(l3, b_ + 12288); TRRD(h3, b_ + 14336); \
        asm volatile("s_waitcnt lgkmcnt(0)" ::: "memory"); SBAR(); \
        o[d0] = __builtin_amdgcn_mfma_f32_32x32x16_bf16(pa0, (bf16x8){l0[0], l0[1], l0[2], l0[3], h0[0], h0[1], h0[2], h0[3]}, o[d0], 0, 0, 0);   \
        o[d0] = __builtin_amdgcn_mfma_f32_32x32x16_bf16(pa1, (bf16x8){l1[0], l1[1], l1[2], l1[3], h1[0], h1[1], h1[2], h1[3]}, o[d0], 0, 0, 0);   \
        o[d0] = __builtin_amdgcn_mfma_f32_32x32x16_bf16(pa2, (bf16x8){l2[0], l2[1], l2[2], l2[3], h2[0], h2[1], h2[2], h2[3]}, o[d0], 0, 0, 0);   \
        o[d0] = __builtin_amdgcn_mfma_f32_32x32x16_bf16(pa3, (bf16x8){l3[0], l3[1], l3[2], l3[3], h3[0], h3[1], h3[2], h3[3]}, o[d0], 0, 0, 0); } while (0)
    PV_D0(0); PV_D0(1); PV_D0(2); PV_D0(3);
#undef PV_D0
#undef TRRD
}
struct AttnItem { const bf16* qrow; const bf16* Kb; const bf16* Vb; };
__device__ __forceinline__ void attn_offs(int wid, int lane, unsigned (&koff)[2], unsigned (&voff)[2]) {
#pragma unroll
    for (int i = 0; i < 2; ++i) { const int pi = wid * 2 + i, row = 4 * pi + (lane >> 4), c = (lane & 15) ^ (row & 7); koff[i] = (unsigned)(row * (int)LDQ + c * 8) * 2u;
        const int st = pi * 2 + (lane >> 5), kk = ((st >> 2) << 3) | ((lane & 31) >> 2), k = (kk & ~0xC) | ((kk & 4) << 1) | ((kk & 8) >> 1), cc = (st & 3) * 32 + (lane & 3) * 8; voff[i] = (unsigned)(k * (int)LDQ + cc) * 2u; }
}
#define SDMA(KB_, VB_, t, bf) do { _Pragma("unroll") for (int i_ = 0; i_ < 2; ++i_) { \
        __builtin_amdgcn_global_load_lds((const unsigned*)((const char*)(KB_) + (size_t)(t) * 64 * LDQ * 2 + koff[i_]), (LAS unsigned*)(K_lds + (bf) * SHM_K + (wid * 2 + i_) * 1024), 16, 0, 0); \
        __builtin_amdgcn_global_load_lds((const unsigned*)((const char*)(VB_) + (size_t)(t) * 64 * LDQ * 2 + voff[i_]), (LAS unsigned*)(V_lds + (bf) * SHM_V + (wid * 2 + i_) * 1024), 16, 0, 0); } } while (0)
__device__ __forceinline__ void attn_prime(LAS char* lds, int tid, const AttnItem& it, bf16x8 (&qr)[8]) {
    const int wid = __builtin_amdgcn_readfirstlane(tid >> 6), lane = tid & 63, hi = lane >> 5;
    LAS char* V_lds = lds + OFF_V; LAS char* K_lds = lds + OFF_K; unsigned koff[2], voff[2]; attn_offs(wid, lane, koff, voff);
#pragma unroll
    for (int d0 = 0; d0 < 8; ++d0) qr[d0] = *(const bf16x8*)(it.qrow + d0 * 16 + hi * 8);
    SDMA(it.Kb, it.Vb, 0, 0);
}
template <bool CAUSAL>
__device__ __forceinline__ void attn_core(LAS char* lds, int tid, const AttnItem& cur, const AttnItem& nxt, bool has_next, bf16x8 (&qr)[8], f32x16 (&o)[4], float& m_reg, float& l_reg) {
    const int wid = __builtin_amdgcn_readfirstlane(tid >> 6), lane = tid & 63, r32 = lane & 31, hi = lane >> 5;
    LAS char* V_lds = lds + OFF_V; LAS char* K_lds = lds + OFF_K;
    LAS float* al_l = (LAS float*)(lds + OFF_WS) + wid * 256;
    const int vb0 = (int)(unsigned)(uintptr_t)V_lds + v_rd_base(lane);
    unsigned koff[2], voff[2]; attn_offs(wid, lane, koff, voff);
    m_reg = -1e30f; l_reg = 0.f;
#pragma unroll
    for (int d = 0; d < 4; ++d) o[d] = f32x16{};
    const int qrel0 = wid * 32;
    asm volatile("s_waitcnt vmcnt(0)" ::: "memory"); __syncthreads();
#define TILE(t, BUF) do { \
        if ((t) < 3) SDMA(cur.Kb, cur.Vb, (t) + 1, 1 - (BUF)); else if (has_next) SDMA(nxt.Kb, nxt.Vb, 0, 0); \
        if (!CAUSAL || (t) * 64 <= qrel0 + 31) { \
            f32x16 pA0, pA1; float mn, al; bf16x8 pa0, pa1, pa2, pa3; \
            qkt<BUF>(pA0, pA1, K_lds, r32, hi, qr); \
            if ((t) == 3 && has_next) { _Pragma("unroll") for (int d0 = 0; d0 < 8; ++d0) qr[d0] = *(const bf16x8*)(nxt.qrow + d0 * 16 + hi * 8); } \
            if (CAUSAL && (t) * 64 + 63 > qrel0) { const int dq = qrel0 + r32 - (t) * 64 - 4 * hi; const float NEG = -__builtin_inff(); \
                _Pragma("unroll") for (int r = 0; r < 16; ++r) { const int c = (r & 3) + 8 * (r >> 2); if (dq - c < 0) pA0[r] = NEG; if (dq - c - 32 < 0) pA1[r] = NEG; } } \
            partialSM(pA0, pA1, m_reg, mn, al); \
            if (__any(al < 1.f)) { if (hi == 0) al_l[r32] = al; asm volatile("s_waitcnt lgkmcnt(0)" ::: "memory"); \
                _Pragma("unroll") for (int d_ = 0; d_ < 4; ++d_) _Pragma("unroll") for (int r = 0; r < 16; ++r) o[d_][r] *= al_l[crow(r, hi)]; } \
            finishSM(pA0, pA1, al, l_reg, pa0, pa1, pa2, pa3); SBAR(); \
            pv_tile<BUF>(o, vb0, pa0, pa1, pa2, pa3); } \
        else if ((t) == 3 && has_next) { _Pragma("unroll") for (int d0 = 0; d0 < 8; ++d0) qr[d0] = *(const bf16x8*)(nxt.qrow + d0 * 16 + hi * 8); } \
        if ((t) < 3) asm volatile("s_waitcnt vmcnt(0)" ::: "memory"); \
        __syncthreads(); } while (0)
    TILE(0, 0); TILE(1, 1); TILE(2, 0); TILE(3, 1);
#undef TILE
}
#undef SDMA
#undef KSWZ
#undef SBAR
}

__device__ __forceinline__ void stage_o(LAS unsigned short* stg, const mattn::f32x16 (&o)[4], const LAS float* scale, int r32, int hi) {
#pragma unroll
    for (int r = 0; r < 16; ++r) { const int rr = mattn::crow(r, hi); const float f = scale ? scale[rr] : 1.f;
#pragma unroll
        for (int d0 = 0; d0 < 4; ++d0) stg[rr * 128 + d0 * 32 + r32] = (unsigned short)cvt_pk_bf16(o[d0][r] * f, 0.f); }
    asm volatile("s_waitcnt lgkmcnt(0)" ::: "memory");
}
__device__ __forceinline__ void ph_moba_route(const Ctx& C, const bf16* QKV, const float* KMp, unsigned* cnt, unsigned* list) {
    for (int it = C.gw; it < 2 * MH * 128; it += C.NGW) {
        const int b = it >> 11, qg = b ? 127 - (it & 127) : (it & 127), h = (it >> 7) & 15, blk = qg >> 2;
        if (blk == 0) continue;
        const int pos = qg * 64 + C.lane, tok = b * SEQ + pos;
        const bf16* qp = QKV + (size_t)tok * (3 * DM) + h * MHD;
        u32x4 qv[16];
#pragma unroll
        for (int i = 0; i < 16; ++i) qv[i] = *(const u32x4*)(qp + 8 * i);
        int s0 = 0, s1 = 0, s2 = 0; float v0 = -__builtin_inff(), v1 = v0, v2 = v0;
        const float* km = KMp + (size_t)((b * MH + h) * MNB) * MHD;
        for (int j = 0; j < blk; ++j) {
            const float* kj = km + j * MHD; float s = 0.f;
#pragma unroll
            for (int i = 0; i < 16; ++i) { const f32x4 ka = *(const f32x4*)(kj + 8 * i), kb = *(const f32x4*)(kj + 8 * i + 4);
                s += bflo(qv[i].x) * ka[0] + bfhi(qv[i].x) * ka[1] + bflo(qv[i].y) * ka[2] + bfhi(qv[i].y) * ka[3]
                   + bflo(qv[i].z) * kb[0] + bfhi(qv[i].z) * kb[1] + bflo(qv[i].w) * kb[2] + bfhi(qv[i].w) * kb[3]; }
            const bool g0 = s > v0, g1 = s > v1, g2 = s > v2;
            v2 = g1 ? v1 : (g2 ? s : v2); s2 = g1 ? s1 : (g2 ? j : s2);
            v1 = g0 ? v0 : (g1 ? s : v1); s1 = g0 ? s0 : (g1 ? j : s1);
            v0 = g0 ? s : v0;             s0 = g0 ? j : s0;
        }
        const int nsel = blk < 3 ? blk : 3; const int base = (b * MH + h) * MNB;
        if (nsel > 0) { const unsigned idx = atomicAdd(cnt + base + s0, 1u); list[(size_t)(base + s0) * mattn::LIST_CAP + idx] = (unsigned)pos; }
        if (nsel > 1) { const unsigned idx = atomicAdd(cnt + base + s1, 1u); list[(size_t)(base + s1) * mattn::LIST_CAP + idx] = (unsigned)pos | (1u << 13); }
        if (nsel > 2) { const unsigned idx = atomicAdd(cnt + base + s2, 1u); list[(size_t)(base + s2) * mattn::LIST_CAP + idx] = (unsigned)pos | (2u << 13); }
    }
}
__device__ __forceinline__ void ph_moba_sel(const Ctx& C, const bf16* QKV, const unsigned* cnt, const unsigned* list, bf16* PO, f32x2* PML) {
    using namespace mattn;
    LAS char* lds = (LAS char*)C.lds;
    LAS int* pre = (LAS int*)(lds + OFF_PRE); LAS int* wtot = (LAS int*)(lds + OFF_WT);
    const int tid = C.tid, wid = C.wave, lane = C.lane, r32 = lane & 31, hi = lane >> 5;
    {
        const int c0 = (int)cnt[2 * tid], c1 = (int)cnt[2 * tid + 1], n0 = (c0 + 255) >> 8, n1 = (c1 + 255) >> 8, x = n0 + n1; int incl = x;
#pragma unroll
        for (int o = 1; o < 64; o <<= 1) { const int y = __builtin_amdgcn_ds_bpermute((lane - o) << 2, incl); if (lane >= o) incl += y; }
        if (lane == 63) wtot[wid] = incl;
        __syncthreads();
        int woff = 0;
        for (int w = 0; w < wid; ++w) woff += wtot[w];
        const int excl = woff + incl - x;
        pre[2 * tid] = excl; pre[2 * tid + 1] = excl + n0; if (tid == 511) pre[1024] = excl + x;
        __syncthreads();
    }
    const int T = pre[1024];
#define SEL_DECODE(item_, bhj_, n_, ent_, valid_, AI_) do { int lo_ = 0, hi_ = 1024; \
        while (hi_ - lo_ > 1) { const int mid = (lo_ + hi_) >> 1; if (pre[mid] <= (item_)) lo_ = mid; else hi_ = mid; } \
        bhj_ = lo_; const int chunk_ = (item_) - pre[bhj_]; n_ = (int)cnt[bhj_] - chunk_ * 256; n_ = n_ > 256 ? 256 : n_; \
        valid_ = (wid * 32 + r32) < n_; ent_ = list[(size_t)bhj_ * LIST_CAP + chunk_ * 256 + (valid_ ? (wid * 32 + r32) : 0)]; \
        { const int j_ = bhj_ & 31, h_ = (bhj_ >> 5) & 15, b_ = bhj_ >> 9; AI_.qrow = QKV + (size_t)(b_ * SEQ + (int)(ent_ & 8191u)) * LDQ + h_ * MHD; \
          AI_.Kb = QKV + (size_t)(b_ * SEQ + j_ * MBLK) * LDQ + DM + h_ * MHD; AI_.Vb = AI_.Kb + DM; } } while (0)
    int item = (C.G & 7) == 0 ? (C.bid & 7) * (C.G >> 3) + (C.bid >> 3) : C.bid; if (item >= T) return;
    int bhj, n; unsigned ent; bool valid; AttnItem cur; bf16x8 qr[8];
    SEL_DECODE(item, bhj, n, ent, valid, cur);
    attn_prime(lds, tid, cur, qr);
    for (;;) {
        const int nitem = item + C.G; const bool has_next = nitem < T;
        int bhj2 = bhj, n2 = n; unsigned ent2 = ent; bool valid2 = valid; AttnItem nxt = cur;
        if (has_next) SEL_DECODE(nitem, bhj2, n2, ent2, valid2, nxt);
        const int h = (bhj >> 5) & 15, b = bhj >> 9, pos = ent & 8191, slot = ent >> 13;
        f32x16 o[4]; float m_reg, l_reg;
        attn_core<false>(lds, tid, cur, nxt, has_next, qr, o, m_reg, l_reg);
        const size_t trow = (size_t)slot * NTOK + (size_t)(b * SEQ + pos);
        if (valid && hi == 0) PML[trow * MH + h] = (f32x2){m_reg, l_reg};
        LAS unsigned* dtab = (LAS unsigned*)((LAS float*)(lds + OFF_WS) + wid * 256 + 64);
        if (hi == 0) dtab[r32] = valid ? (unsigned)((trow * DM + h * MHD) * 2) : 0xffffffffu;
        LAS unsigned short* stg = (LAS unsigned short*)(lds + OFF_STG) + wid * 4096;
        stage_o(stg, o, nullptr, r32, hi);
#pragma unroll
        for (int i = 0; i < 8; ++i) { const int rw = (lane >> 4) + 4 * i, c = lane & 15; const unsigned d = dtab[rw];
            const u32x4 v = *(const LAS u32x4*)(stg + rw * 128 + c * 8);
            if (d != 0xffffffffu) *(u32x4*)((char*)PO + d + c * 16) = v; }
        asm volatile("s_waitcnt lgkmcnt(0)" ::: "memory");
        if (!has_next) break;
        item = nitem; bhj = bhj2; n = n2; ent = ent2; valid = valid2; cur = nxt;
    }
#undef SEL_DECODE
}
__device__ __forceinline__ void ph_moba_own(const Ctx& C, const bf16* QKV, const bf16* PO, const f32x2* PML, bf16* O) {
    using namespace mattn;
    LAS char* lds = (LAS char*)C.lds;
    const int tid = C.tid, wid = C.wave, lane = C.lane, r32 = lane & 31, hi = lane >> 5;
    LAS float* tb = (LAS float*)(lds + OFF_WS) + wid * 256 + 64;
#define OWN_DECODE(item_, AI_) do { const int qb_ = (item_) & 31, h_ = ((item_) >> 5) & 15, b_ = (item_) >> 9; \
        AI_.qrow = QKV + (size_t)(b_ * SEQ + qb_ * MBLK + wid * 32 + r32) * LDQ + h_ * MHD; AI_.Kb = QKV + (size_t)(b_ * SEQ + qb_ * MBLK) * LDQ + DM + h_ * MHD; AI_.Vb = AI_.Kb + DM; } while (0)
    if (C.bid >= 2 * MH * MNB) return;
    AttnItem cur; bf16x8 qr[8]; OWN_DECODE(C.bid, cur);
    attn_prime(lds, tid, cur, qr);
    for (int item = C.bid; item < 2 * MH * MNB; item += C.G) {
        const int qb = item & 31, h = (item >> 5) & 15, b = item >> 9;
        const int tok = b * SEQ + qb * MBLK + wid * 32 + r32;
        const bool has_next = item + C.G < 2 * MH * MNB; AttnItem nxt = cur; if (has_next) OWN_DECODE(item + C.G, nxt);
        const int nsel = qb < 3 ? qb : 3;
        f32x16 o[4]; float m_reg, l_reg;
        attn_core<true>(lds, tid, cur, nxt, has_next, qr, o, m_reg, l_reg);
        LAS unsigned short* stg = (LAS unsigned short*)(lds + OFF_STG) + wid * 4096;
        stage_o(stg, o, nullptr, r32, hi);
        const int tok0 = b * SEQ + qb * MBLK + wid * 32;
        f32x2 ml[3];
#pragma unroll
        for (int sl = 0; sl < 3; ++sl) ml[sl] = (sl < nsel) ? PML[((size_t)sl * NTOK + tok) * MH + h] : (f32x2){-1e30f, 0.f};
        u32x4 pv[3][8];
#pragma unroll
        for (int sl = 0; sl < 3; ++sl)
#pragma unroll
            for (int i = 0; i < 8; ++i) { const int rw = (lane >> 4) + 4 * i, c = lane & 15;
                pv[sl][i] = (sl < nsel) ? *(const u32x4*)(PO + (size_t)sl * NTOK * DM + (size_t)(tok0 + rw) * DM + h * MHD + c * 8) : (u32x4){0u, 0u, 0u, 0u}; }
        {
            float M = m_reg;
#pragma unroll
            for (int sl = 0; sl < 3; ++sl) M = fmaxf(M, ml[sl].x);
            const float fo = __builtin_amdgcn_exp2f((m_reg - M) * C2); float L = l_reg * fo; float fs[3];
#pragma unroll
            for (int sl = 0; sl < 3; ++sl) { fs[sl] = (sl < nsel) ? __builtin_amdgcn_exp2f((ml[sl].x - M) * C2) : 0.f; L += ml[sl].y * fs[sl]; }
            const float inv = 1.0f / L;
            if (hi == 0) { tb[r32] = fo * inv; tb[32 + r32] = fs[0] * inv; tb[64 + r32] = fs[1] * inv; tb[96 + r32] = fs[2] * inv; }
            asm volatile("s_waitcnt lgkmcnt(0)" ::: "memory");
        }
#pragma unroll
        for (int i = 0; i < 8; ++i) { const int rw = (lane >> 4) + 4 * i, c = lane & 15;
            const u32x4 ov = *(const LAS u32x4*)(stg + rw * 128 + c * 8); const float f0 = tb[rw];
            float x[8];
#pragma unroll
            for (int q = 0; q < 4; ++q) { x[2 * q] = f0 * bflo(ov[q]); x[2 * q + 1] = f0 * bfhi(ov[q]); }
#pragma unroll
            for (int sl = 0; sl < 3; ++sl) { const float f = tb[32 * (sl + 1) + rw];
#pragma unroll
                for (int q = 0; q < 4; ++q) { x[2 * q] += f * bflo(pv[sl][i][q]); x[2 * q + 1] += f * bfhi(pv[sl][i][q]); } }
            u32x4 w; w.x = cvt_pk_bf16(x[0], x[1]); w.y = cvt_pk_bf16(x[2], x[3]); w.z = cvt_pk_bf16(x[4], x[5]); w.w = cvt_pk_bf16(x[6], x[7]);
            *(u32x4*)(O + (size_t)(tok0 + rw) * DM + h * MHD + c * 8) = w; }
        asm volatile("s_waitcnt lgkmcnt(0)" ::: "memory");
        cur = nxt;
    }
#undef OWN_DECODE
}
__device__ __forceinline__ void ph_conv_fix(const Ctx& C, const bf16* UH, bf16* A, const float* cw, const float* cb) {
    constexpr int FG = FF / 8;
    for (int it = C.gt; it < (NTOK / 64) * 2 * FG; it += C.NGT) {
        const int fg = it % FG, rr = (it / FG) & 1, G = it / (2 * FG), f0 = fg * 8, t = G * 64 + rr; const bool seq0 = (t & (SEQ - 1)) < 2 && ((G * 64) & (SEQ - 1)) == 0;
        const bf16* up = UH + (size_t)(G - 1) * 4 * FF2; const bf16* uc = UH + (size_t)G * 4 * FF2;
        u32x4 g2, g1, g0, v2, v1, v0; const u32x4 z = {0, 0, 0, 0};
        if (rr == 0) { g2 = seq0 ? z : *(const u32x4*)(up + f0); g1 = seq0 ? z : *(const u32x4*)(up + FF2 + f0); g0 = *(const u32x4*)(uc + 2 * FF2 + f0);
                       v2 = seq0 ? z : *(const u32x4*)(up + FF + f0); v1 = seq0 ? z : *(const u32x4*)(up + FF2 + FF + f0); v0 = *(const u32x4*)(uc + 2 * FF2 + FF + f0); }
        else         { g2 = seq0 ? z : *(const u32x4*)(up + FF2 + f0); g1 = *(const u32x4*)(uc + 2 * FF2 + f0); g0 = *(const u32x4*)(uc + 3 * FF2 + f0);
                       v2 = seq0 ? z : *(const u32x4*)(up + FF2 + FF + f0); v1 = *(const u32x4*)(uc + 2 * FF2 + FF + f0); v0 = *(const u32x4*)(uc + 3 * FF2 + FF + f0); }
        u32x4 o;
#pragma unroll
        for (int j = 0; j < 4; ++j) { float r[2];
#pragma unroll
            for (int hl = 0; hl < 2; ++hl) { const int c = f0 + 2 * j + hl;
                const float ug2 = hl ? bfhi(g2[j]) : bflo(g2[j]), ug1 = hl ? bfhi(g1[j]) : bflo(g1[j]), ug0 = hl ? bfhi(g0[j]) : bflo(g0[j]);
                const float uv2 = hl ? bfhi(v2[j]) : bflo(v2[j]), uv1 = hl ? bfhi(v1[j]) : bflo(v1[j]), uv0 = hl ? bfhi(v0[j]) : bflo(v0[j]);
                const float cg = cb[c] + cw[c] * ug2 + cw[FF2 + c] * ug1 + cw[2 * FF2 + c] * ug0;
                const float cv = cb[FF + c] + cw[FF + c] * uv2 + cw[FF2 + FF + c] * uv1 + cw[2 * FF2 + FF + c] * uv0;
                r[hl] = gelu_tanh(cg) * cv; }
            o[j] = cvt_pk_bf16(r[0], r[1]); }
        *(u32x4*)(A + (size_t)t * FF + f0) = o;
    }
}
__device__ __forceinline__ void ph_scan(const Ctx& C, const bf16* U, bf16* RT) {
    for (long it = C.gt; it < (long)RH * RDV * 2 * 128; it += C.NGT) {
        const int row = (int)(it >> 8), b = (int)(it >> 7) & 1, d0 = (int)(it & 127) * 2, h = row / RDV; const float gl = fast_exp2((float)RL * log2g(h));
        unsigned off = ((unsigned)row * NTOK + (unsigned)b * SEQ + (unsigned)d0) * 2u; float r0 = 0.f, r1 = 0.f;
        unsigned w[8];
#pragma unroll
        for (int i = 0; i < 8; ++i) w[i] = pg8::ldo<unsigned>(U, off + (unsigned)i * (RL * 2));
#pragma unroll 1
        for (int g = 0; g < SEQ / RL / 8; ++g, off += 8 * RL * 2) {
            unsigned n[8];
            if (g + 1 < SEQ / RL / 8) {
#pragma unroll
                for (int i = 0; i < 8; ++i) n[i] = pg8::ldo<unsigned>(U, off + 8 * RL * 2 + (unsigned)i * (RL * 2)); }
            else {
#pragma unroll
                for (int i = 0; i < 8; ++i) n[i] = 0u; }
#pragma unroll
            for (int i = 0; i < 8; ++i) {
                pg8::sto<unsigned>(RT, off + (unsigned)i * (RL * 2), cvt_pk_bf16(r0, r1));
                r0 = gl * (r0 + bflo(w[i])); r1 = gl * (r1 + bfhi(w[i])); }
#pragma unroll
            for (int i = 0; i < 8; ++i) w[i] = n[i];
        }
    }
}
__device__ __forceinline__ void ph_groupnorm(const Ctx& C, const bf16* Y, bf16* G) {
    u32x4 yw[8], gw[8];
    const int step = C.NGW * 8; int it0 = C.gw * 8;
    if (it0 < NTOK * RH) {
#pragma unroll
        for (int k = 0; k < 8; ++k) { const unsigned off = ((unsigned)(it0 + k) * RDV + 8u * C.lane) * 2u; yw[k] = *(const u32x4*)((const char*)Y + off); gw[k] = *(const u32x4*)((const char*)G + off); } }
#pragma unroll 1
    for (; it0 < NTOK * RH; it0 += step) {
        u32x4 yn[8], gn[8]; const int nx = it0 + step;
        if (nx < NTOK * RH) {
#pragma unroll
            for (int k = 0; k < 8; ++k) { const unsigned off = ((unsigned)(nx + k) * RDV + 8u * C.lane) * 2u; yn[k] = *(const u32x4*)((const char*)Y + off); gn[k] = *(const u32x4*)((const char*)G + off); } }
        else {
#pragma unroll
            for (int k = 0; k < 8; ++k) { yn[k] = (u32x4){0u, 0u, 0u, 0u}; gn[k] = (u32x4){0u, 0u, 0u, 0u}; } }
#pragma unroll
        for (int k = 0; k < 8; ++k) { const int it = it0 + k, tok = it >> 3, h = it & 7, n = tok & (RL - 1); const float xi = fast_exp2((float)(n + 1) * log2g(h));
            float y[8]; float s = 0.f;
#pragma unroll
            for (int j = 0; j < 4; ++j) { y[2 * j] = bflo(yw[k][j]) * xi; y[2 * j + 1] = bfhi(yw[k][j]) * xi; s += y[2 * j] + y[2 * j + 1]; }
            const float mean = wave_sum(s, C.lane) * (1.f / RDV); float s2 = 0.f;
#pragma unroll
            for (int j = 0; j < 8; ++j) { y[j] -= mean; s2 += y[j] * y[j]; }
            const float rstd = 1.f / sqrtf(wave_sum(s2, C.lane) * (1.f / RDV) + GN_EPS);
            u32x4 o;
#pragma unroll
            for (int j = 0; j < 4; ++j) o[j] = cvt_pk_bf16(bflo(gw[k][j]) * y[2 * j] * rstd, bfhi(gw[k][j]) * y[2 * j + 1] * rstd);
            *(u32x4*)((char*)G + ((unsigned)it * RDV + 8u * C.lane) * 2u) = o; }
#pragma unroll
        for (int k = 0; k < 8; ++k) { yw[k] = yn[k]; gw[k] = gn[k]; }
    }
}

__global__ void __launch_bounds__(NWAVES * 64, 2) fwd(Args args) {
    extern __shared__ __attribute__((aligned(16))) unsigned char lds_raw[];
    LAS unsigned char* const lds0 = (LAS unsigned char*)lds_raw;
    volatile LAS unsigned* MISC = (volatile LAS unsigned*)(lds0 + MISC_OFF);
    for (int u = threadIdx.x; u < (LDS_BYTES - LDSCTL_OFF) / 4; u += NWAVES * 64) ((LAS unsigned*)(lds0 + LDSCTL_OFF))[u] = 0u;
    __syncthreads();
    XcdBarrier bar = xcd_barrier_post((unsigned*)(args.ws + WS_CTL) + CW_BAR, MISC + 8);
    const int lo = args.ph_lo, hi = args.ph_hi;
    const int wave0 = __builtin_amdgcn_readfirstlane(threadIdx.x >> 6);
    int pc = 0;
#define PH_BEGIN { const int pid_ = pc++; if (lo <= pid_ && pid_ < hi) { int lane_; asm volatile("v_mbcnt_lo_u32_b32 %0, -1, 0\n\tv_mbcnt_hi_u32_b32 %0, -1, %0" : "=v"(lane_)); \
        const __attribute__((address_space(4))) unsigned long long* ap_ = (const __attribute__((address_space(4))) unsigned long long*)__builtin_amdgcn_kernarg_segment_ptr(); asm volatile("" : "+s"(ap_)); \
        Args args;   \
        _Pragma("unroll") for (int i_ = 0; i_ < 14; ++i_) args.in[i_] = (const float*)(GAS const float*)ap_[i_]; args.out = (float*)(GAS float*)ap_[14]; args.ph_lo = 0; args.ph_hi = 0; \
        GAS unsigned char* wsg_ = (GAS unsigned char*)ap_[15]; asm volatile("" : "+s"(wsg_)); args.ws = (unsigned char*)wsg_; unsigned char* ws = args.ws;     \
        Ctx C; C.lds = lds0; C.tid = wave0 * 64 + lane_; C.lane = lane_; C.wave = wave0; { int b_ = blockIdx.x, g_ = gridDim.x; asm volatile("" : "+s"(b_), "+s"(g_)); C.bid = b_; C.G = g_; } \
        C.gw = C.bid * NWAVES + C.wave; C.NGW = C.G * NWAVES; C.gt = C.bid * (NWAVES * 64) + C.tid; C.NGT = C.G * NWAVES * 64; \
        float* Hb = args.out; bf16* HN = (bf16*)(ws + WS_HN); pg8::StaticOrder S; (void)Hb; (void)HN; (void)S;
#define PH_END   if (pid_ + 1 < hi) xcd_barrier(bar); } }
#define SUB(...) { GAS unsigned char* wsg2_ = (GAS unsigned char*)ws; asm volatile("" : "+s"(wsg2_), "+s"(C.bid), "+s"(C.G)); unsigned char* ws_ = (unsigned char*)wsg2_; int lane2_; asm volatile("v_mbcnt_lo_u32_b32 %0, -1, 0\n\tv_mbcnt_hi_u32_b32 %0, -1, %0" : "=v"(lane2_)); \
        C.tid = wave0 * 64 + lane2_; C.lane = lane2_; { unsigned char* ws = ws_; bf16* HN = (bf16*)(ws + WS_HN); (void)HN; __VA_ARGS__ } }

#define SPART ((f32x2*)(ws + WS_STATS))
#define FSTATS ((f32x2*)(ws + WS_FSTATS))
#define GWV ((const float*)(ws + WS_GW))
#define BWV ((const float*)(ws + WS_GW) + NCOLT)
#define RED ((LAS f32x2*)(C.lds + RING_BYTES))
#define LNG(i) (args.in[12] + (size_t)(i) * DM)
#define LNB(i) (args.in[13] + (size_t)(i) * DM)
#define TABA ((const f32x2*)(ws + WS_TABA))
#define TABR ((const f32x2*)(ws + WS_TABR))
#define KM ((float*)(ws + WS_KMEAN))

    PH_BEGIN ph_prologue(C, args); PH_END
    PH_BEGIN ph_fold_reduce(C, (const float*)(ws + WS_GWP), (float*)(ws + WS_GW)); PH_END

    for (int l = 0; l < 4; ++l) {
        const int j = l >> 1;
        if ((l & 1) == 0) {
#define QKV ((bf16*)(ws + A_QKV))
#define MO ((bf16*)(ws + A_MO))
            PH_BEGIN { const pg8::Desc g = pg8::plain_desc(HN, (const bf16*)(ws + W_MQKV) + (size_t)j * 3 * DM * DM, NTOK, 3 * DM, DM);
                S.init(g.nM, g.nN, C.G, C.bid); pg8::EpiMobaQKV E{QKV, TABA, {FSTATS, GWV + (l == 0 ? CO_ID : CO_M1), BWV + (l == 0 ? CO_ID : CO_M1)}}; pg8::gemm_phase(C.lds, C.tid, g, S, E); } PH_END
            PH_BEGIN ph_kmean(C, QKV, KM); PH_END
            PH_BEGIN ph_moba_route(C, QKV, KM, (unsigned*)(ws + WS_CTL) + CW_CNT + j * 1024, (unsigned*)(ws + A_MLIST)); PH_END
            PH_BEGIN ph_moba_sel(C, QKV, (const unsigned*)(ws + WS_CTL) + CW_CNT + j * 1024, (const unsigned*)(ws + A_MLIST), (bf16*)(ws + A_MPO), (f32x2*)(ws + A_MPML)); PH_END
            PH_BEGIN ph_moba_own(C, QKV, (const bf16*)(ws + A_MPO), (const f32x2*)(ws + A_MPML), MO); PH_END
            PH_BEGIN { const pg8::Desc g = pg8::plain_desc(MO, (const bf16*)(ws + W_MO) + (size_t)j * DM * DM, NTOK, DM, DM);
                S.init(g.nM, g.nN, C.G, C.bid); pg8::EpiResLN E{args.in[0], HN, FSTATS, SPART, LNG(l == 0 ? 0 : 2 * l - 1), LNB(l == 0 ? 0 : 2 * l - 1), ALPHA, RED, C.tid, (unsigned*)(ws + WS_CTL) + CW_PANEL + (2 * l) * 4096, FSTATS, l == 0};
                pg8::gemm_phase(C.lds, C.tid, g, S, E); } PH_END
        } else {
#define RQ ((bf16*)(ws + A_RQ))
#define RK ((bf16*)(ws + A_RK))
#define RKT ((bf16*)(ws + A_RKT))
#define RVT ((bf16*)(ws + A_RVT))
#define RG ((bf16*)(ws + A_RG))
#define RP ((bf16*)(ws + A_RP))
#define RU ((bf16*)(ws + A_RU))
#define RRT ((bf16*)(ws + A_RRT))
#define Wq ((const bf16*)(ws + W_RQ) + (size_t)j * DM * DM)
#define Wk ((const bf16*)(ws + W_RK) + (size_t)j * DM * DM)
#define Wv ((const bf16*)(ws + W_RV) + (size_t)j * 2 * DM * DM)
#define Wg ((const bf16*)(ws + W_RG) + (size_t)j * 2 * DM * DM)
            PH_BEGIN {
                SUB({ const pg8::Desc g = pg8::plain_desc(HN, Wq, NTOK, DM, DM); S.init(g.nM, g.nN, C.G, C.bid); pg8::EpiRopeNat256<false> E{RQ, DM, TABR, 1.0f, {FSTATS, GWV + CO_R + j * 12288, BWV + CO_R + j * 12288}, nullptr}; pg8::gemm_phase(C.lds, C.tid, g, S, E); })
                SUB({ const pg8::Desc g = pg8::plain_desc(HN, Wk, NTOK, DM, DM); S.init(g.nM, g.nN, C.G, C.bid); pg8::EpiRopeNat256<true> E{RK, DM, TABR, 0.0625f, {FSTATS, GWV + CO_R + j * 12288 + 2048, BWV + CO_R + j * 12288 + 2048}, RKT}; pg8::gemm_phase(C.lds, C.tid, g, S, E); })
                SUB({ const pg8::Desc g = pg8::plain_desc(HN, Wg, NTOK, 2 * DM, DM); S.init(g.nM, g.nN, C.G, C.bid); pg8::EpiAct<1, true> E{RG, 2 * DM, {FSTATS, GWV + CO_R + j * 12288 + 8192, BWV + CO_R + j * 12288 + 8192}}; pg8::gemm_phase(C.lds, C.tid, g, S, E); })
                SUB({ const pg8::Desc g = pg8::plain_desc(Wv, HN, 2 * DM, NTOK, DM); S.init(g.nM, g.nN, C.G, C.bid); pg8::EpiVT E{RVT, NTOK, {FSTATS, GWV + CO_R + j * 12288 + 4096, BWV + CO_R + j * 12288 + 4096}}; pg8::gemm_phase(C.lds, C.tid, g, S, E); })
            } PH_END
            PH_BEGIN {
                SUB({
                    pg8::Desc g; g.A = RQ; g.B = RK; g.A2 = RQ; g.B2 = RK; g.lda = DM; g.ldb = DM; g.sAm = 256L * DM; g.sAn = 256; g.sBm = 256L * DM; g.sBn = 256;
                    g.shAm = 0; g.shAn = 0; g.shBm = 0; g.shBn = 0; g.nM = NTOK / 256; g.nN = RH; g.nt = RDK / 64; g.nt1 = g.nt;
                    S.init(g.nM, g.nN, C.G, C.bid); pg8::EpiAct<2, false> E{RP, DM, {nullptr, nullptr, nullptr}}; pg8::gemm_phase(C.lds, C.tid, g, S, E); })
                SUB({
                    pg8::Desc g; g.A = RVT; g.B = RKT; g.A2 = RVT; g.B2 = RKT; g.lda = NTOK; g.ldb = NTOK; g.sAm = 256L * NTOK; g.sAn = 256; g.sBm = 256L * NTOK; g.sBn = 256;
                    g.shAm = 0; g.shAn = 0; g.shBm = 1; g.shBn = 0; g.nM = RH * RDV / 256; g.nN = NTOK / 256; g.nt = RL / 64; g.nt1 = g.nt;
                    S.init(g.nM, g.nN, C.G, C.bid); pg8::EpiBf16 E{RU, NTOK}; pg8::gemm_phase(C.lds, C.tid, g, S, E); })
            } PH_END
            PH_BEGIN ph_scan(C, RU, RRT); PH_END
            PH_BEGIN {
                pg8::Desc g; g.A = RP; g.A2 = RQ; g.B = RVT; g.B2 = RRT; g.lda = DM; g.ldb = NTOK; g.sAm = 256L * DM; g.sAn = 256; g.sBm = 256; g.sBn = 256L * NTOK;
                g.shAm = 0; g.shAn = 1; g.shBm = 0; g.shBn = 0; g.nM = NTOK / 256; g.nN = RH * RDV / 256; g.nt = 8; g.nt1 = 4;
                S.init(g.nM, g.nN, C.G, C.bid); pg8::EpiBf16 E{RU, 2 * DM}; pg8::gemm_phase(C.lds, C.tid, g, S, E); } PH_END
            PH_BEGIN ph_groupnorm(C, RU, RG); PH_END
            PH_BEGIN { const pg8::Desc g = pg8::plain_desc(RG, (const bf16*)(ws + W_RO) + (size_t)j * 2 * DM * DM, NTOK, DM, 2 * DM);
                S.init(g.nM, g.nN, C.G, C.bid); pg8::EpiResLN E{args.in[0], HN, FSTATS, SPART, LNG(2 * l - 1), LNB(2 * l - 1), ALPHA, RED, C.tid, (unsigned*)(ws + WS_CTL) + CW_PANEL + (2 * l) * 4096, FSTATS, false}; pg8::gemm_phase(C.lds, C.tid, g, S, E); } PH_END
        }
#define FU ((bf16*)(ws + A_U))
#define FA ((bf16*)(ws + A_FA))
        PH_BEGIN { const pg8::Desc g = pg8::plain_desc(HN, (const bf16*)(ws + W_FI) + (size_t)l * FF2 * DM, NTOK, FF2, DM);
            S.init(g.nM, g.nN, C.G, C.bid); pg8::EpiConv E{FA, FU, args.in[9] + (size_t)l * 3 * FF2, args.in[10] + (size_t)l * FF2, {FSTATS, GWV + CO_F + l * 11264, BWV + CO_F + l * 11264}};
            pg8::gemm_phase(C.lds, C.tid, g, S, E); } PH_END
        PH_BEGIN ph_conv_fix(C, FU, FA, args.in[9] + (size_t)l * 3 * FF2, args.in[10] + (size_t)l * FF2); PH_END
        PH_BEGIN { const pg8::Desc g = pg8::plain_desc(FA, (const bf16*)(ws + W_FO) + (size_t)l * FF * DM, NTOK, DM, FF);
            S.init(g.nM, g.nN, C.G, C.bid); pg8::EpiResLN E{args.in[0], HN, FSTATS, SPART, LNG(2 * l), LNB(2 * l), ALPHA, RED, C.tid, (unsigned*)(ws + WS_CTL) + CW_PANEL + (2 * l + 1) * 4096, FSTATS, false}; pg8::gemm_phase(C.lds, C.tid, g, S, E); } PH_END
    }
    PH_BEGIN ph_ln_final(C, HN, Hb, LNG(7), LNB(7)); PH_END
#undef PH_BEGIN
#undef PH_END
}
constexpr int N_PHASES = 2 + 2 * (6 + 3) + 2 * (6 + 3) + 1;

extern "C" void kernel_launch(void* const* d_in, const int* in_sizes, int n_in, void* d_out, int out_size, void* d_ws, size_t ws_size, hipStream_t stream) {
    static int grid = 0;
    if (grid == 0) {
        if (n_in != 14 || out_size != NTOK * DM || ws_size < WS_NEED) { fprintf(stderr, "kernel_launch: unexpected shapes (n_in %d out %d ws %zu)\n", n_in, out_size, ws_size); grid = -1; return; }
        int dev = 0, cus = 0, per_cu = 0;
        if (hipGetDevice(&dev) != hipSuccess || hipDeviceGetAttribute(&cus, hipDeviceAttributeMultiprocessorCount, dev) != hipSuccess) { grid = -1; return; }
        if (hipFuncSetAttribute((const void*)fwd, hipFuncAttributeMaxDynamicSharedMemorySize, LDS_BYTES) != hipSuccess) { fprintf(stderr, "kernel_launch: hipFuncSetAttribute failed\n"); grid = -1; return; }
        if (hipOccupancyMaxActiveBlocksPerMultiprocessor(&per_cu, (const void*)fwd, NWAVES * 64, LDS_BYTES) != hipSuccess || per_cu < 1)
            fprintf(stderr, "kernel_launch: occupancy query reports %d workgroups per CU\n", per_cu);
        (void)hipGetLastError();
        grid = cus;
    }
    if (grid < 0) return;
    (void)hipMemsetAsync((char*)d_ws + WS_CTL, 0, CTL_ZERO_BYTES, stream);
    Args a{};
    for (int i = 0; i < 14; ++i) a.in[i] = (const float*)d_in[i];
    a.out = (float*)d_out; a.ws = (unsigned char*)d_ws;
#if MK_ONE_LAUNCH
    a.ph_lo = 0; a.ph_hi = N_PHASES;
    hipLaunchKernelGGL(fwd, dim3(grid), dim3(NWAVES * 64), LDS_BYTES, stream, a);
#else
    for (int p = 0; p < N_PHASES; ++p) { a.ph_lo = p; a.ph_hi = p + 1; hipLaunchKernelGGL(fwd, dim3(grid), dim3(NWAVES * 64), LDS_BYTES, stream, a); }
#endif
}
```

```cpp
#include <hip/hip_runtime.h>
#include <cstdio>
#include <cstdint>

#ifndef MK_ONE_LAUNCH
#define MK_ONE_LAUNCH 1
#endif

#define GAS __attribute__((address_space(1)))
#define LAS __attribute__((address_space(3)))
typedef unsigned short bf16;
typedef float f32x4 __attribute__((ext_vector_type(4)));
typedef float f32x2 __attribute__((ext_vector_type(2)));
typedef unsigned u32x4 __attribute__((ext_vector_type(4)));
typedef unsigned u32x2 __attribute__((ext_vector_type(2)));
typedef short bf16x8 __attribute__((ext_vector_type(8)));

constexpr int NTOK = 16384, SEQ = 8192, DM = 2048;
constexpr int MH = 16, MHD = 128, MBLK = 256, MNB = 32;
constexpr int RH = 8, RDK = 256, RDV = 512, RL = 256;
constexpr int FF = 5632, FF2 = 11264;
constexpr float ALPHA = 1.681792830507429f;
constexpr float LN_EPS = 1e-5f, GN_EPS = 1e-5f;

__device__ const float INV_A[64] = {1.000000000e+00f, 8.659643531e-01f, 7.498942018e-01f, 6.493816376e-01f, 5.623413324e-01f, 4.869675338e-01f, 4.216965139e-01f, 3.651741147e-01f, 3.162277639e-01f, 2.738419771e-01f, 2.371373773e-01f, 2.053525001e-01f, 1.778279394e-01f, 1.539926529e-01f, 1.333521456e-01f, 1.154781953e-01f, 1.000000015e-01f, 8.659642935e-02f, 7.498942316e-02f, 6.493816525e-02f, 5.623413250e-02f, 4.869675264e-02f, 4.216964915e-02f, 3.651741147e-02f, 3.162277490e-02f, 2.738419548e-02f, 2.371373773e-02f, 2.053525113e-02f, 1.778279431e-02f, 1.539926510e-02f, 1.333521400e-02f, 1.154781971e-02f, 9.999999776e-03f, 8.659643121e-03f, 7.498942316e-03f, 6.493816152e-03f, 5.623413250e-03f, 4.869675264e-03f, 4.216964822e-03f, 3.651741194e-03f, 3.162277630e-03f, 2.738419687e-03f, 2.371373819e-03f, 2.053525066e-03f, 1.778279431e-03f, 1.539926510e-03f, 1.333521446e-03f, 1.154782018e-03f, 1.000000047e-03f, 8.659643354e-04f, 7.498941850e-04f, 6.493816036e-04f, 5.623413017e-04f, 4.869675322e-04f, 4.216965172e-04f, 3.651741135e-04f, 3.162277571e-04f, 2.738419571e-04f, 2.371373703e-04f, 2.053525095e-04f, 1.778279402e-04f, 1.539926598e-04f, 1.333521504e-04f, 1.154782003e-04f};
__device__ const float INV_R[128] = {1.000000000e+00f, 9.305720329e-01f, 8.659643531e-01f, 8.058421612e-01f, 7.498942018e-01f, 6.978305578e-01f, 6.493816376e-01f, 6.042963862e-01f, 5.623413324e-01f, 5.232990980e-01f, 4.869675338e-01f, 4.531583786e-01f, 4.216965139e-01f, 3.924189806e-01f, 3.651741147e-01f, 3.398208320e-01f, 3.162277639e-01f, 2.942727208e-01f, 2.738419771e-01f, 2.548296750e-01f, 2.371373773e-01f, 2.206734121e-01f, 2.053525001e-01f, 1.910952926e-01f, 1.778279394e-01f, 1.654817164e-01f, 1.539926529e-01f, 1.433012635e-01f, 1.333521456e-01f, 1.240937784e-01f, 1.154781953e-01f, 1.074607819e-01f, 1.000000015e-01f, 9.305720776e-02f, 8.659642935e-02f, 8.058422059e-02f, 7.498942316e-02f, 6.978306174e-02f, 6.493816525e-02f, 6.042964011e-02f, 5.623413250e-02f, 5.232991278e-02f, 4.869675264e-02f, 4.531583562e-02f, 4.216964915e-02f, 3.924189880e-02f, 3.651741147e-02f, 3.398208320e-02f, 3.162277490e-02f, 2.942727134e-02f, 2.738419548e-02f, 2.548296750e-02f, 2.371373773e-02f, 2.206734009e-02f, 2.053525113e-02f, 1.910953037e-02f, 1.778279431e-02f, 1.654817164e-02f, 1.539926510e-02f, 1.433012541e-02f, 1.333521400e-02f, 1.240937784e-02f, 1.154781971e-02f, 1.074607857e-02f, 9.999999776e-03f, 9.305720218e-03f, 8.659643121e-03f, 8.058422245e-03f, 7.498942316e-03f, 6.978305988e-03f, 6.493816152e-03f, 6.042963825e-03f, 5.623413250e-03f, 5.232991185e-03f, 4.869675264e-03f, 4.531583749e-03f, 4.216964822e-03f, 3.924189601e-03f, 3.651741194e-03f, 3.398208413e-03f, 3.162277630e-03f, 2.942727180e-03f, 2.738419687e-03f, 2.548296703e-03f, 2.371373819e-03f, 2.206734149e-03f, 2.053525066e-03f, 1.910952968e-03f, 1.778279431e-03f, 1.654817141e-03f, 1.539926510e-03f, 1.433012541e-03f, 1.333521446e-03f, 1.240937738e-03f, 1.154782018e-03f, 1.074607833e-03f, 1.000000047e-03f, 9.305720450e-04f, 8.659643354e-04f, 8.058421663e-04f, 7.498941850e-04f, 6.978305755e-04f, 6.493816036e-04f, 6.042963942e-04f, 5.623413017e-04f, 5.232990952e-04f, 4.869675322e-04f, 4.531583691e-04f, 4.216965172e-04f, 3.924189659e-04f, 3.651741135e-04f, 3.398208355e-04f, 3.162277571e-04f, 2.942727297e-04f, 2.738419571e-04f, 2.548296761e-04f, 2.371373703e-04f, 2.206734061e-04f, 2.053525095e-04f, 1.910952997e-04f, 1.778279402e-04f, 1.654817170e-04f, 1.539926598e-04f, 1.433012512e-04f, 1.333521504e-04f, 1.240937709e-04f, 1.154782003e-04f, 1.074607862e-04f};
__device__ __forceinline__ float log2g(int h) {
    const float t[8] = {-4.58036896131247886e-02f, -2.27200765000835289e-02f, -1.13153132278341461e-02f, -5.64656314114206186e-03f,
                        -2.82051906237866306e-03f, -1.40957025467135363e-03f, -7.04612976589372815e-04f, -3.52263471629021439e-04f};
    float r = t[0];
#pragma unroll
    for (int i = 1; i < 8; ++i) r = (h == i) ? t[i] : r;
    return r;
}

__device__ __forceinline__ float bflo(unsigned w) { return __uint_as_float(w << 16); }
__device__ __forceinline__ float bfhi(unsigned w) { return __uint_as_float(w & 0xffff0000u); }
__device__ __forceinline__ unsigned cvt_pk_bf16(float lo, float hi) { unsigned r; asm volatile("v_cvt_pk_bf16_f32 %0, %1, %2" : "=v"(r) : "v"(lo), "v"(hi)); return r; }
__device__ __forceinline__ float shx(float v, int mask, int lane) { return __builtin_bit_cast(float, __builtin_amdgcn_ds_bpermute((lane ^ mask) << 2, __builtin_bit_cast(int, v))); }
__device__ __forceinline__ float wave_sum(float v, int lane) {
#pragma unroll
    for (int o = 1; o < 64; o <<= 1) v += shx(v, o, lane);
    return v;
}
__device__ __forceinline__ float fast_exp2(float x) { return __builtin_amdgcn_exp2f(x); }
__device__ __forceinline__ float gelu_tanh(float x) {
    const float t = x * (-2.302208198f - 0.1029432397f * x * x);
    return x * __builtin_amdgcn_rcpf(1.0f + fast_exp2(t));
}
__device__ __forceinline__ float silu(float x) { return x * __builtin_amdgcn_rcpf(1.0f + fast_exp2(-x * 1.4426950408889634f)); }
__device__ __forceinline__ void sincos_acc(float angf, float& s, float& c) {
    const double a = (double)angf;
    const double k = __builtin_rint(a * 0.63661977236758134308);
    double r = __builtin_fma(-k, 1.57079632679489655800e+00, a);
    r = __builtin_fma(-k, 6.12323399573676603587e-17, r);
    const double r2 = r * r;
    double sp = 1.0 / 6227020800.0;
    sp = sp * r2 - 1.0 / 39916800.0; sp = sp * r2 + 1.0 / 362880.0; sp = sp * r2 - 1.0 / 5040.0; sp = sp * r2 + 1.0 / 120.0; sp = sp * r2 - 1.0 / 6.0; sp = sp * r2 + 1.0;
    const double sn = sp * r;
    double cp = -1.0 / 87178291200.0;
    cp = cp * r2 + 1.0 / 479001600.0; cp = cp * r2 - 1.0 / 3628800.0; cp = cp * r2 + 1.0 / 40320.0; cp = cp * r2 - 1.0 / 720.0; cp = cp * r2 + 1.0 / 24.0; cp = cp * r2 - 0.5; cp = cp * r2 + 1.0;
    const int q = ((int)k) & 3;
    const double ss = (q & 1) ? cp : sn, cc = (q & 1) ? sn : cp;
    s = (float)((q & 2) ? -ss : ss);
    c = (float)(((q + 1) & 2) ? -cc : cc);
}

namespace pg8 {
constexpr int BM = 256, BK = 64, HALF = 128, HTB = HALF * BK * 2, STAGE_BYTES = 8 * HTB, NXCD = 8, WGM = 8;
__host__ __device__ __forceinline__ int lds_byte(int r, int c) { const int st = (r >> 4) * 2 + (c >> 5), rr = r & 15, cc = c & 31, ob = rr * 64 + cc * 2; return st * 1024 + (ob ^ (((ob >> 9) & 1) << 5)); }
__host__ __device__ __forceinline__ void stage_rc(int b, int& R, int& C) { const int st = b / 1024, sb = b % 1024, swz = sb ^ (((sb >> 9) & 1) << 5); R = (st >> 1) * 16 + swz / 64; C = (st & 1) * 32 + (swz % 64) / 2; }
__host__ __device__ __forceinline__ int perm32(int rho) { const int n = rho >> 4, i = rho & 15; return 8 * (i >> 2) + 4 * n + (i & 3); }

struct Unit { int pm, pn; };
struct Desc {
    const bf16* A; const bf16* B; const bf16* A2; const bf16* B2;
    long lda, ldb, sAm, sAn, sBm, sBn;
    int shAm, shAn, shBm, shBn;
    int nM, nN, nt, nt1;
};
__host__ __device__ inline Desc plain_desc(const bf16* A, const bf16* Bt, int M, int N, int K) {
    Desc d; d.A = A; d.B = Bt; d.A2 = A; d.B2 = Bt; d.lda = K; d.ldb = K; d.sAm = 256L * K; d.sAn = 0; d.sBm = 0; d.sBn = 256L * K;
    d.shAm = 0; d.shAn = 0; d.shBm = 0; d.shBn = 0; d.nM = M / 256; d.nN = N / 256; d.nt = K / 64; d.nt1 = K / 64; return d;
}
struct StaticOrder {
    int nM, nN, nwg, G, c;
    __device__ void init(int nM_, int nN_, int G_, int c_) { nM = nM_; nN = nN_; nwg = nM * nN; G = G_; c = c_; }
    __device__ bool next(int i, Unit& u) const {
        const int L = i * G + c; if (L >= nwg) return false;
        const int wgid = (L & (NXCD - 1)) * (nwg >> 3) + (L >> 3);
        const int nig = WGM * nN, gid = wgid / nig, rem = wgid - gid * nig;
        u.pm = gid * WGM + (rem & (WGM - 1)); u.pn = rem >> 3; return true;
    }
};

__device__ __forceinline__ float row16_sum(float v) {
    v += __builtin_bit_cast(float, __builtin_amdgcn_update_dpp(0, __builtin_bit_cast(int, v), 0xB1, 0xf, 0xf, true));
    v += __builtin_bit_cast(float, __builtin_amdgcn_update_dpp(0, __builtin_bit_cast(int, v), 0x4E, 0xf, 0xf, true));
    v += __builtin_bit_cast(float, __builtin_amdgcn_update_dpp(0, __builtin_bit_cast(int, v), 0x141, 0xf, 0xf, true));
    v += __builtin_bit_cast(float, __builtin_amdgcn_update_dpp(0, __builtin_bit_cast(int, v), 0x140, 0xf, 0xf, true));
    return v;
}
template <class T> __device__ __forceinline__ T ldo(const void* b, unsigned off) { return *(const T*)((const char*)b + off); }
template <class T> __device__ __forceinline__ void sto(void* b, unsigned off, T v) { *(T*)((char*)b + off) = v; }
#define ACC8(ai, bj, m, e) acc[ai][bj][m][(e) >> 2][(e) & 3]
__device__ __forceinline__ u32x4 pack8(const float (&x)[8]) { u32x4 w; w.x = cvt_pk_bf16(x[0], x[1]); w.y = cvt_pk_bf16(x[2], x[3]); w.z = cvt_pk_bf16(x[4], x[5]); w.w = cvt_pk_bf16(x[6], x[7]); return w; }
struct EpiBf16 {
    static constexpr bool PERM = true;
    bf16* O; unsigned ldc;
    __device__ __forceinline__ void operator()(f32x4 (&acc)[2][2][4][2], const Unit& u, int wr, int wc, int fr, int fq) const {
        const unsigned o0 = ((unsigned)(u.pm * BM + wr * 64 + fr) * ldc + (unsigned)(u.pn * BM + wc * 32 + 8 * fq)) * 2u;
#pragma unroll
        for (int ai = 0; ai < 2; ++ai)
#pragma unroll
            for (int m = 0; m < 4; ++m) { const unsigned o = o0 + (unsigned)(ai * HALF + m * 16) * ldc * 2u;
#pragma unroll
                for (int bj = 0; bj < 2; ++bj) { float x[8];
#pragma unroll
                    for (int e = 0; e < 8; ++e) x[e] = ACC8(ai, bj, m, e);
                    sto<u32x4>(O, o + bj * HALF * 2, pack8(x)); } }
    }
};

struct LnFold { const f32x2* stats; const float* gw; const float* bw; };
__device__ __forceinline__ void ln_row_stats(const f32x2* fstats, unsigned off  , float& r, float& rmu) { const f32x2 v = ldo<f32x2>(fstats, off); r = v.x; rmu = v.y; }
__device__ __forceinline__ void ln_correct_nat(f32x4 (&acc)[2][2][4][2], const LnFold& ln, const Unit& u, int wr, int wc, int fr, int fq) {
    __builtin_amdgcn_sched_barrier(0);
    const unsigned so0 = (unsigned)(u.pm * BM + wr * 64 + fr) * 8u, co0 = (unsigned)(u.pn * BM + wc * 32 + 8 * fq) * 4u;
    f32x2 st[8]; f32x4 gb[2][4];
#pragma unroll
    for (int i = 0; i < 8; ++i) st[i] = ldo<f32x2>(ln.stats, so0 + ((i >> 2) * HALF + (i & 3) * 16) * 8);
#pragma unroll
    for (int bj = 0; bj < 2; ++bj) { gb[bj][0] = ldo<f32x4>(ln.gw, co0 + bj * HALF * 4); gb[bj][1] = ldo<f32x4>(ln.gw, co0 + bj * HALF * 4 + 16); gb[bj][2] = ldo<f32x4>(ln.bw, co0 + bj * HALF * 4); gb[bj][3] = ldo<f32x4>(ln.bw, co0 + bj * HALF * 4 + 16); }
    __builtin_amdgcn_sched_barrier(0);
#pragma unroll
    for (int bj = 0; bj < 2; ++bj) {
        float gw[8], bw[8];
#pragma unroll
        for (int e = 0; e < 4; ++e) { gw[e] = gb[bj][0][e]; gw[4 + e] = gb[bj][1][e]; bw[e] = gb[bj][2][e]; bw[4 + e] = gb[bj][3][e]; }
#pragma unroll
        for (int ai = 0; ai < 2; ++ai)
#pragma unroll
            for (int m = 0; m < 4; ++m) { const float r = st[ai * 4 + m].x, rmu = st[ai * 4 + m].y;
#pragma unroll
                for (int e = 0; e < 8; ++e) ACC8(ai, bj, m, e) = ACC8(ai, bj, m, e) * r - rmu * gw[e] + bw[e]; }
        __builtin_amdgcn_sched_barrier(0);
    }
}
__device__ __forceinline__ void ln_correct_swp(f32x4 (&acc)[2][2][4][2], const LnFold& ln, const Unit& u, int wr, int wc, int fr, int fq) {
    __builtin_amdgcn_sched_barrier(0);
    const unsigned ro0 = (unsigned)(u.pm * BM + wr * 64 + fr) * 4u, so0 = (unsigned)(u.pn * BM + wc * 32 + 8 * fq) * 8u;
    float r[2][8], rmu[2][8];
#pragma unroll
    for (int bj = 0; bj < 2; ++bj)
#pragma unroll
        for (int q = 0; q < 4; ++q) { const f32x4 v = ldo<f32x4>(ln.stats, so0 + bj * HALF * 8 + q * 16); r[bj][2 * q] = v[0]; rmu[bj][2 * q] = v[1]; r[bj][2 * q + 1] = v[2]; rmu[bj][2 * q + 1] = v[3]; }
    float g8[8], b8[8];
#pragma unroll
    for (int i = 0; i < 8; ++i) { g8[i] = ldo<float>(ln.gw, ro0 + ((i >> 2) * HALF + (i & 3) * 16) * 4); b8[i] = ldo<float>(ln.bw, ro0 + ((i >> 2) * HALF + (i & 3) * 16) * 4); }
#pragma unroll
    for (int ai = 0; ai < 2; ++ai)
#pragma unroll
        for (int m = 0; m < 4; ++m) { const float g = g8[ai * 4 + m], b = b8[ai * 4 + m];
#pragma unroll
            for (int bj = 0; bj < 2; ++bj)
#pragma unroll
                for (int e = 0; e < 8; ++e) ACC8(ai, bj, m, e) = ACC8(ai, bj, m, e) * r[bj][e] - rmu[bj][e] * g + b; }
    __builtin_amdgcn_sched_barrier(0);
}
struct EpiResLN {
    static constexpr bool PERM = true;
    const float* Xin; bf16* TN; const f32x2* stats_in; f32x2* stats_out; const float* g; const float* b; float alpha; LAS f32x2* red; int tid; unsigned* pcnt; f32x2* fs_out;
    __device__ __forceinline__ void operator()(f32x4 (&acc)[2][2][4][2], const Unit& u, int wr, int wc, int fr, int fq) const {
        const unsigned row0 = (unsigned)(u.pm * BM + wr * 64 + fr), col0 = (unsigned)(u.pn * BM + wc * 32 + 8 * fq); const bool first = stats_in == nullptr;
        float gv[2][8], bv[2][8];
#pragma unroll
        for (int bj = 0; bj < 2; ++bj)
#pragma unroll
            for (int e = 0; e < 8; ++e) { gv[bj][e] = 1.f; bv[bj][e] = 0.f; }
        if (!first) {
#pragma unroll
            for (int bj = 0; bj < 2; ++bj) { const unsigned co = (col0 + bj * HALF) * 4u; const f32x4 g0 = ldo<f32x4>(g, co), g1 = ldo<f32x4>(g, co + 16), b0 = ldo<f32x4>(b, co), b1 = ldo<f32x4>(b, co + 16);
#pragma unroll
                for (int e = 0; e < 4; ++e) { gv[bj][e] = g0[e]; gv[bj][4 + e] = g1[e]; bv[bj][e] = b0[e]; bv[bj][4 + e] = b1[e]; } } }
        u32x4 q0[8], q1[8]; f32x2 qs[8];
#define RL_LOAD(i) do { const unsigned row_ = row0 + (unsigned)(((i) >> 2) * HALF + ((i) & 3) * 16); const unsigned eo_ = row_ * DM + col0; \
            q0[i] = ldo<u32x4>(TN, eo_ * 2u); q1[i] = ldo<u32x4>(TN, (eo_ + HALF) * 2u); qs[i] = ldo<f32x2>(stats_in, row_ * 8u); } while (0)
        if (!first) { RL_LOAD(0); RL_LOAD(1); }
#pragma unroll
        for (int i = 0; i < 8; ++i) { const int ai = i >> 2, m = i & 3; const unsigned row = row0 + ai * HALF + m * 16; float r = 1.f, rmu = 0.f;
                if (!first) { if (i + 2 < 8) RL_LOAD(i + 2); r = qs[i].x; rmu = qs[i].y; }
                float sm = 0.f, sq = 0.f;
#pragma unroll
                for (int bj = 0; bj < 2; ++bj) { const unsigned eo = row * DM + col0 + bj * HALF; float to[8];
                    if (first) { const f32x4 t0 = ldo<f32x4>(Xin, eo * 4u), t1 = ldo<f32x4>(Xin, eo * 4u + 16);
#pragma unroll
                        for (int e = 0; e < 4; ++e) { to[e] = t0[e]; to[4 + e] = t1[e]; } }
                    else { const u32x4 tw = bj ? q1[i] : q0[i];
#pragma unroll
                        for (int q = 0; q < 4; ++q) { to[2 * q] = bflo(tw[q]); to[2 * q + 1] = bfhi(tw[q]); } }
                    float tn[8];
#pragma unroll
                    for (int e = 0; e < 8; ++e) { const float h = (to[e] * r - rmu) * gv[bj][e] + bv[bj][e];
                        const float v = alpha * h + ACC8(ai, bj, m, e); tn[e] = v; sm += v; sq += v * v; }
                    sto<u32x4>(TN, eo * 2u, pack8(tn)); }
                { const int ln_ = fq * 16 + fr; sm += shx(sm, 16, ln_); sm += shx(sm, 32, ln_); sq += shx(sq, 16, ln_); sq += shx(sq, 32, ln_); }
                if (fq == 0) red[(ai * HALF + wr * 64 + m * 16 + fr) * 4 + wc] = (f32x2){sm, sq}; asm volatile("" ::: "memory"); }
#undef RL_LOAD
        asm volatile("s_waitcnt lgkmcnt(0)" ::: "memory"); __builtin_amdgcn_s_barrier(); asm volatile("" ::: "memory");
        if (tid < 256) { const f32x2 a = red[tid * 4 + 0], b2 = red[tid * 4 + 1], c = red[tid * 4 + 2], d = red[tid * 4 + 3];
            const float S = (a.x + b2.x) + (c.x + d.x), Q = (a.y + b2.y) + (c.y + d.y);
            __hip_atomic_store((unsigned long long*)(stats_out + (size_t)(u.pm * BM + tid) * 8 + u.pn), ((unsigned long long)__float_as_uint(Q) << 32) | __float_as_uint(S), __ATOMIC_RELAXED, __HIP_MEMORY_SCOPE_AGENT); }
        asm volatile("s_waitcnt vmcnt(0)" ::: "memory"); __builtin_amdgcn_s_barrier(); asm volatile("" ::: "memory");
        LAS unsigned* flag = (LAS unsigned*)(red + 1024);
        if (tid == 0) { const unsigned old = __hip_atomic_fetch_add(pcnt + 64 * u.pm, 1u, __ATOMIC_RELAXED, __HIP_MEMORY_SCOPE_AGENT); flag[0] = (old == 7u) ? 1u : 0u; }
        asm volatile("s_waitcnt vmcnt(0) lgkmcnt(0)" ::: "memory"); __builtin_amdgcn_s_barrier(); asm volatile("" ::: "memory");
        if (flag[0] != 0u) {
            __builtin_amdgcn_fence(__ATOMIC_ACQUIRE, "agent"); asm volatile("s_waitcnt vmcnt(0)" ::: "memory");
            if (tid < 256) { const unsigned long long* p = (const unsigned long long*)(stats_out + (size_t)(u.pm * BM + tid) * 8); float S = 0.f, Q = 0.f;
                u32x4 w4[4];
                asm volatile("global_load_dwordx4 %0, %4, off sc1\n\tglobal_load_dwordx4 %1, %4, off offset:16 sc1\n\tglobal_load_dwordx4 %2, %4, off offset:32 sc1\n\tglobal_load_dwordx4 %3, %4, off offset:48 sc1\n\ts_waitcnt vmcnt(0)"
                             : "=&v"(w4[0]), "=&v"(w4[1]), "=&v"(w4[2]), "=&v"(w4[3]) : "v"(p) : "memory");
#pragma unroll
                for (int t = 0; t < 4; ++t) { S += __uint_as_float(w4[t].x) + __uint_as_float(w4[t].z); Q += __uint_as_float(w4[t].y) + __uint_as_float(w4[t].w); }
                const float mu = S * (1.0f / DM), var = Q * (1.0f / DM) - mu * mu, r = 1.0f / sqrtf(var + LN_EPS); fs_out[u.pm * BM + tid] = (f32x2){r, r * mu}; }
        }
    }
};
struct EpiMobaQKV {
    static constexpr bool PERM = true;
    bf16* O; const f32x2* tab; LnFold ln;
    __device__ __forceinline__ void operator()(f32x4 (&acc)[2][2][4][2], const Unit& u, int wr, int wc, int fr, int fq) const {
        ln_correct_nat(acc, ln, u, wr, wc, fr, fq);
        const int which = u.pn >> 3, hh = wc >> 1, i0 = 32 * (wc & 1) + 8 * fq;
        const unsigned row0 = (unsigned)(u.pm * BM + wr * 64 + fr);
        const unsigned o0 = (row0 * (3 * DM) + (unsigned)(u.pn * BM + hh * 128 + i0)) * 2u, t0 = ((row0 & (SEQ - 1)) * 64 + i0) * 8u;
        const float scale = which == 0 ? 0.08838834764831845f : 1.0f; const bool rope = which < 2;
#pragma unroll
        for (int ai = 0; ai < 2; ++ai)
#pragma unroll
            for (int m = 0; m < 4; ++m) { const unsigned to = t0 + (ai * HALF + m * 16) * (64 * 8);
#pragma unroll
                for (int q = 0; q < 4; ++q) { f32x4 t = ldo<f32x4>(tab, to + q * 16);
                    t[0] = rope ? t[0] : 1.f; t[1] = rope ? t[1] : 0.f; t[2] = rope ? t[2] : 1.f; t[3] = rope ? t[3] : 0.f;
                    const float a0 = ACC8(ai, 0, m, 2 * q), b0 = ACC8(ai, 1, m, 2 * q), a1 = ACC8(ai, 0, m, 2 * q + 1), b1 = ACC8(ai, 1, m, 2 * q + 1);
                    ACC8(ai, 0, m, 2 * q) = (a0 * t[0] - b0 * t[1]) * scale; ACC8(ai, 1, m, 2 * q) = (a0 * t[1] + b0 * t[0]) * scale;
                    ACC8(ai, 0, m, 2 * q + 1) = (a1 * t[2] - b1 * t[3]) * scale; ACC8(ai, 1, m, 2 * q + 1) = (a1 * t[3] + b1 * t[2]) * scale; }
                if (m & 1) asm volatile("" ::: "memory"); }
        __builtin_amdgcn_sched_barrier(0);
#pragma unroll
        for (int ai = 0; ai < 2; ++ai)
#pragma unroll
            for (int m = 0; m < 4; ++m) { const unsigned o = o0 + (ai * HALF + m * 16) * (3 * DM * 2); float x1[8], x2[8];
#pragma unroll
                for (int e = 0; e < 8; ++e) { x1[e] = ACC8(ai, 0, m, e); x2[e] = ACC8(ai, 1, m, e); }
                sto<u32x4>(O, o, pack8(x1)); sto<u32x4>(O, o + 128, pack8(x2)); }
    }
};
template <bool DUALT> struct EpiRopeNat256 {
    static constexpr bool PERM = true;
    bf16* O; unsigned ldc; const f32x2* tab; float scale; LnFold ln; bf16* OT;
    __device__ __forceinline__ void operator()(f32x4 (&acc)[2][2][4][2], const Unit& u, int wr, int wc, int fr, int fq) const {
        ln_correct_nat(acc, ln, u, wr, wc, fr, fq);
        const int i0 = 32 * wc + 8 * fq; const unsigned row0 = (unsigned)(u.pm * BM + wr * 64 + fr);
        const unsigned o0 = (row0 * ldc + (unsigned)(u.pn * BM + i0)) * 2u, t0 = ((row0 & (SEQ - 1)) * 128 + i0) * 8u;
        f32x4 tb[8][4];
#define RT_LOAD(i) do { const unsigned to_ = t0 + (unsigned)(((i) >> 2) * HALF + ((i) & 3) * 16) * (128 * 8); _Pragma("unroll") for (int q_ = 0; q_ < 4; ++q_) tb[i][q_] = ldo<f32x4>(tab, to_ + q_ * 16); } while (0)
        RT_LOAD(0); RT_LOAD(1);
#pragma unroll
        for (int i = 0; i < 8; ++i) { const int ai = i >> 2, m = i & 3; if (i + 2 < 8) RT_LOAD(i + 2);
            { const unsigned o = o0 + (ai * HALF + m * 16) * ldc * 2u; float x1[8], x2[8];
#pragma unroll
                for (int q = 0; q < 4; ++q) { const f32x4 t = tb[i][q];
                    const float a0 = ACC8(ai, 0, m, 2 * q), b0 = ACC8(ai, 1, m, 2 * q), a1 = ACC8(ai, 0, m, 2 * q + 1), b1 = ACC8(ai, 1, m, 2 * q + 1);
                    x1[2 * q] = (a0 * t[0] - b0 * t[1]) * scale; x2[2 * q] = (a0 * t[1] + b0 * t[0]) * scale; x1[2 * q + 1] = (a1 * t[2] - b1 * t[3]) * scale; x2[2 * q + 1] = (a1 * t[3] + b1 * t[2]) * scale; }
                const u32x4 p1 = pack8(x1), p2 = pack8(x2);
                sto<u32x4>(O, o, p1); sto<u32x4>(O, o + HALF * 2, p2);
                if (DUALT) { const unsigned t0o = (((unsigned)(u.pn * BM + i0)) * NTOK + row0 + ai * HALF + m * 16) * 2u;
#pragma unroll
                    for (int q = 0; q < 4; ++q) { sto<unsigned short>(OT, t0o + (2 * q) * (NTOK * 2), (unsigned short)(p1[q] & 0xffffu)); sto<unsigned short>(OT, t0o + (2 * q + 1) * (NTOK * 2), (unsigned short)(p1[q] >> 16));
                        sto<unsigned short>(OT, t0o + (HALF + 2 * q) * (NTOK * 2), (unsigned short)(p2[q] & 0xffffu)); sto<unsigned short>(OT, t0o + (HALF + 2 * q + 1) * (NTOK * 2), (unsigned short)(p2[q] >> 16)); } }
                if (m & 1) asm volatile("" ::: "memory"); } }
#undef RT_LOAD
    }
};
struct EpiVT {
    static constexpr bool PERM = true;
    bf16* O; unsigned ldc; LnFold ln;
    __device__ __forceinline__ void operator()(f32x4 (&acc)[2][2][4][2], const Unit& u, int wr, int wc, int fr, int fq) const {
        ln_correct_swp(acc, ln, u, wr, wc, fr, fq);
        const unsigned o0 = ((unsigned)(u.pm * BM + wr * 64 + fr) * ldc + (unsigned)(u.pn * BM + wc * 32 + 8 * fq)) * 2u; const float l2 = log2g(u.pm >> 1);
        float sc[2][8];
#pragma unroll
        for (int bj = 0; bj < 2; ++bj)
#pragma unroll
            for (int e = 0; e < 8; ++e) sc[bj][e] = fast_exp2(-(float)(bj * HALF + wc * 32 + 8 * fq + e + 1) * l2);
#pragma unroll
        for (int ai = 0; ai < 2; ++ai)
#pragma unroll
            for (int m = 0; m < 4; ++m) { const unsigned o = o0 + (unsigned)(ai * HALF + m * 16) * ldc * 2u;
#pragma unroll
                for (int bj = 0; bj < 2; ++bj) { float x[8];
#pragma unroll
                    for (int e = 0; e < 8; ++e) x[e] = ACC8(ai, bj, m, e) * sc[bj][e];
                    sto<u32x4>(O, o + bj * HALF * 2, pack8(x)); } }
    }
};
template <int ACT, bool LN> struct EpiAct {
    static constexpr bool PERM = true;
    bf16* O; unsigned ldc; LnFold ln;
    __device__ __forceinline__ void operator()(f32x4 (&acc)[2][2][4][2], const Unit& u, int wr, int wc, int fr, int fq) const {
        if (LN) ln_correct_nat(acc, ln, u, wr, wc, fr, fq);
        const unsigned o0 = ((unsigned)(u.pm * BM + wr * 64 + fr) * ldc + (unsigned)(u.pn * BM + wc * 32 + 8 * fq)) * 2u;
#pragma unroll
        for (int ai = 0; ai < 2; ++ai)
#pragma unroll
            for (int m = 0; m < 4; ++m) { const unsigned o = o0 + (unsigned)(ai * HALF + m * 16) * ldc * 2u; const int rl = ai * HALF + wr * 64 + m * 16 + fr;
#pragma unroll
                for (int bj = 0; bj < 2; ++bj) { float x[8];
#pragma unroll
                    for (int e = 0; e < 8; ++e) { float v = ACC8(ai, bj, m, e);
                        if (ACT == 1) v = silu(v);
                        if (ACT == 2) v = (bj * HALF + wc * 32 + 8 * fq + e <= rl) ? v : 0.f;
                        x[e] = v; }
                    sto<u32x4>(O, o + bj * HALF * 2, pack8(x)); } }
    }
};
struct EpiConv {
    static constexpr bool PERM = true;
    bf16* A; bf16* UH; const float* cw; const float* cb; LnFold ln;
    static __device__ __forceinline__ float conv1(float curf, float prvf, bool has_prev, int fr, float b, float w0, float w1, float w2) {
        const int cur = __builtin_bit_cast(int, curf), prv = __builtin_bit_cast(int, prvf); int r1 = 0, r2 = 0;
        if (has_prev) { r1 = __builtin_amdgcn_update_dpp(0, prv, 0x121, 0xf, 0xf, false); r2 = __builtin_amdgcn_update_dpp(0, prv, 0x122, 0xf, 0xf, false); }
        const int p1 = __builtin_amdgcn_update_dpp(r1, cur, 0x111, 0xf, 0xf, false), p2 = __builtin_amdgcn_update_dpp(r2, cur, 0x112, 0xf, 0xf, false);
        (void)fr;
        return b + w0 * __builtin_bit_cast(float, p2) + w1 * __builtin_bit_cast(float, p1) + w2 * curf;
    }
    __device__ __forceinline__ void operator()(f32x4 (&acc)[2][2][4][2], const Unit& u, int wr, int wc, int fr, int fq) const {
        ln_correct_nat(acc, ln, u, wr, wc, fr, fq);
        const unsigned cn = (unsigned)(u.pn * 128 + wc * 32 + 8 * fq);
#pragma unroll
        for (int ai = 0; ai < 2; ++ai) { const unsigned g4 = ((unsigned)u.pm * 4 + ai * 2 + wr) * 4u;
#pragma unroll
            for (int bj = 0; bj < 2; ++bj) { float x0[8], x3[8];
#pragma unroll
                for (int e = 0; e < 8; ++e) { x0[e] = ACC8(ai, bj, 0, e); x3[e] = ACC8(ai, bj, 3, e); }
                if (fr >= 14) sto<u32x4>(UH, ((g4 + (fr - 14)) * FF2 + bj * FF + cn) * 2u, pack8(x3));
                if (fr < 2) sto<u32x4>(UH, ((g4 + 2 + fr) * FF2 + bj * FF + cn) * 2u, pack8(x0)); } }
        __builtin_amdgcn_sched_barrier(0);
        unsigned ow[2][4][4];
        f32x2 cg0[4], cg1[4], cg2[4], cgb[4], cv0[4], cv1[4], cv2[4], cvb[4];
#pragma unroll
        for (int ep = 0; ep < 4; ++ep) { const unsigned co = (cn + 2 * ep) * 4u;
            cg0[ep] = ldo<f32x2>(cw, co); cg1[ep] = ldo<f32x2>(cw, co + FF2 * 4); cg2[ep] = ldo<f32x2>(cw, co + 2 * FF2 * 4); cgb[ep] = ldo<f32x2>(cb, co);
            cv0[ep] = ldo<f32x2>(cw, co + FF * 4); cv1[ep] = ldo<f32x2>(cw, co + (FF2 + FF) * 4); cv2[ep] = ldo<f32x2>(cw, co + (2 * FF2 + FF) * 4); cvb[ep] = ldo<f32x2>(cb, co + FF * 4); }
        __builtin_amdgcn_sched_barrier(0);
#pragma unroll
        for (int ep = 0; ep < 4; ++ep) {
#pragma unroll
            for (int ai = 0; ai < 2; ++ai)
#pragma unroll
                for (int m = 3; m >= 0; --m) { float r[2];
#pragma unroll
                    for (int hl = 0; hl < 2; ++hl) { const int e = 2 * ep + hl;
                        const float cg = conv1(ACC8(ai, 0, m, e), m > 0 ? ACC8(ai, 0, m > 0 ? m - 1 : 0, e) : 0.f, m > 0, fr, cgb[ep][hl], cg0[ep][hl], cg1[ep][hl], cg2[ep][hl]);
                        const float cv = conv1(ACC8(ai, 1, m, e), m > 0 ? ACC8(ai, 1, m > 0 ? m - 1 : 0, e) : 0.f, m > 0, fr, cvb[ep][hl], cv0[ep][hl], cv1[ep][hl], cv2[ep][hl]);
                        r[hl] = gelu_tanh(cg) * cv; }
                    ow[ai][m][ep] = cvt_pk_bf16(r[0], r[1]); }
            __builtin_amdgcn_sched_barrier(0);
        }
        const unsigned o0 = ((unsigned)(u.pm * BM + wr * 64 + fr) * FF + cn) * 2u;
#pragma unroll
        for (int ai = 0; ai < 2; ++ai)
#pragma unroll
            for (int m = 0; m < 4; ++m)
                if (m > 0 || fr >= 2) sto<u32x4>(A, o0 + (unsigned)(ai * HALF + m * 16) * (FF * 2), (u32x4){ow[ai][m][0], ow[ai][m][1], ow[ai][m][2], ow[ai][m][3]});
    }
};
#undef ACC8
template <class Epi>
__device__ __forceinline__ void gemm_phase(LAS unsigned char* lds, const int tid, const Desc g, const StaticOrder& S, const Epi& E) {
    const int wid = __builtin_amdgcn_readfirstlane(tid >> 6), lane = tid & 63, wr = wid >> 2, wc = wid & 3, fr = lane & 15, fq = lane >> 4;
    const int nt = g.nt, nt1 = g.nt1;
    unsigned voffA[2], voffB[2];
#pragma unroll
    for (int i = 0; i < 2; ++i) { int R, C; stage_rc(tid * 16 + i * 8192, R, C); const int Rb = Epi::PERM ? ((R & ~31) + perm32(R & 31)) : R;
        voffA[i] = (unsigned)(R * g.lda + C) * 2u; voffB[i] = (unsigned)(Rb * g.ldb + C) * 2u; }
    const size_t kstep = (size_t)(BK * 2);
    const size_t hstepA = (size_t)HALF * g.lda * 2, hstepB = (size_t)HALF * g.ldb * 2;
    const unsigned ldsw = (unsigned)wid * 1024u;
    const int aoff = lds_byte(wr * 64 + fr, fq * 8), boff = lds_byte(wc * 32 + fr, fq * 8);
#define PG8_SA(b, h) (((b) * 2 + (h)) * HTB)
#define PG8_SB(b, h) ((4 + (b) * 2 + (h)) * HTB)
#define PG8_STAGE(bufoff, gbase, voff) do { _Pragma("unroll") for (int _i = 0; _i < 2; ++_i) { unsigned keep_; \
        asm volatile("s_mov_b32 %0, m0\n\ts_mov_b32 m0, %3\n\ts_nop 0\n\tglobal_load_lds_dwordx4 %1, %2\n\ts_mov_b32 m0, %0" : "=&s"(keep_) \
                     : "v"((voff)[_i]), "s"((unsigned long long)(uintptr_t)(gbase)), "s"((unsigned)(uintptr_t)(lds + (bufoff) + ldsw + _i * 8192)) : "memory"); } } while (0)
#define PG8_LDA(dst, b, h) do { _Pragma("unroll") for (int m = 0; m < 4; ++m) _Pragma("unroll") for (int k = 0; k < 2; ++k) dst[m][k] = *(const LAS bf16x8*)(lds + PG8_SA(b, h) + aoff + m * 2048 + k * 1024); } while (0)
#define PG8_LDB(dst, b, h) do { _Pragma("unroll") for (int n = 0; n < 2; ++n) _Pragma("unroll") for (int k = 0; k < 2; ++k) dst[n][k] = *(const LAS bf16x8*)(lds + PG8_SB(b, h) + boff + n * 2048 + k * 1024); } while (0)
#define PG8_MMA(ai, bj, At, Bt) do { __builtin_amdgcn_s_setprio(1); _Pragma("unroll") for (int m = 0; m < 4; ++m) _Pragma("unroll") for (int n = 0; n < 2; ++n) _Pragma("unroll") for (int k = 0; k < 2; ++k) \
        acc[ai][bj][m][n] = __builtin_amdgcn_mfma_f32_16x16x32_bf16(Bt[n][k], At[m][k], acc[ai][bj][m][n], 0, 0, 0); __builtin_amdgcn_s_setprio(0); } while (0)
#define PG8_WAIT_V(n) asm volatile("s_waitcnt vmcnt(" #n ")" ::: "memory")
#define PG8_WAIT_L(n) asm volatile("s_waitcnt lgkmcnt(" #n ")" ::: "memory")
#define PG8_BAR __builtin_amdgcn_s_barrier()
#define PG8_SCHED __builtin_amdgcn_sched_barrier(0)
#define PG8_PTRS(u, pa, pb) do { const long oa_ = (long)((u).pm >> g.shAm) * g.sAm + (long)((u).pn >> g.shAn) * g.sAn, ob_ = (long)((u).pm >> g.shBm) * g.sBm + (long)((u).pn >> g.shBn) * g.sBn; \
        pa = (const char*)(g.A + oa_); pb = (const char*)(g.B + ob_); } while (0)
    const long dA2 = ((const char*)g.A2 - (const char*)g.A) - (long)nt1 * (long)kstep, dB2 = ((const char*)g.B2 - (const char*)g.B) - (long)nt1 * (long)kstep;
    Unit cur, nxt; int ui = 0;
    if (!S.next(0, cur)) return;
    f32x4 acc[2][2][4][2];
#pragma unroll
    for (int a = 0; a < 2; ++a)
#pragma unroll
        for (int b = 0; b < 2; ++b)
#pragma unroll
            for (int m = 0; m < 4; ++m)
#pragma unroll
                for (int n = 0; n < 2; ++n) acc[a][b][m][n] = (f32x4){0.f, 0.f, 0.f, 0.f};
    bf16x8 At[4][2], B0[2][2], B1[2][2];
    const char *cA, *cB;
    PG8_PTRS(cur, cA, cB);
    PG8_STAGE(PG8_SB(0, 0), cB, voffB); PG8_STAGE(PG8_SB(0, 1), cB + hstepB, voffB); PG8_STAGE(PG8_SA(0, 0), cA, voffA); PG8_STAGE(PG8_SA(0, 1), cA + hstepA, voffA);
    if (wr == 1) PG8_BAR;
    PG8_WAIT_V(2); PG8_BAR;
    PG8_STAGE(PG8_SB(1, 0), cB + kstep, voffB); PG8_STAGE(PG8_SA(1, 0), cA + kstep, voffA); PG8_STAGE(PG8_SB(1, 1), cB + hstepB + kstep, voffB);
    PG8_WAIT_V(6); PG8_BAR;
    for (;;) {
        const bool has_next = S.next(ui + 1, nxt);
        const char *nA = cA, *nB = cB;
        if (has_next) PG8_PTRS(nxt, nA, nB);
        for (int t = 0; t < nt; t += 2) {
            const bool last = (t == nt - 2);
            const char* a1 = cA + (size_t)(t + 1) * kstep + ((t + 1 < nt1) ? 0L : dA2);
            const char* a2 = last ? nA : cA + (size_t)(t + 2) * kstep + ((t + 2 < nt1) ? 0L : dA2);
            const char* b2 = last ? nB : cB + (size_t)(t + 2) * kstep + ((t + 2 < nt1) ? 0L : dB2);
            const char* a3 = a2 + kstep; const char* b3 = b2 + kstep;
            PG8_LDB(B0, 0, 0); PG8_LDB(B1, 0, 1); PG8_SCHED; PG8_LDA(At, 0, 0); PG8_STAGE(PG8_SA(1, 1), a1 + hstepA, voffA);
            PG8_WAIT_V(8); PG8_WAIT_L(0); PG8_BAR; PG8_MMA(0, 0, At, B0); PG8_MMA(0, 1, At, B1); PG8_BAR; PG8_SCHED;
            PG8_LDA(At, 0, 1); PG8_STAGE(PG8_SB(0, 0), b2, voffB); PG8_STAGE(PG8_SB(0, 1), b2 + hstepB, voffB); PG8_STAGE(PG8_SA(0, 0), a2, voffA);
            PG8_WAIT_V(8); PG8_WAIT_L(0); PG8_BAR; PG8_MMA(1, 0, At, B0); PG8_MMA(1, 1, At, B1); PG8_BAR; PG8_SCHED;
            PG8_LDB(B0, 1, 0); PG8_LDB(B1, 1, 1); PG8_SCHED; PG8_LDA(At, 1, 0); PG8_STAGE(PG8_SA(0, 1), a2 + hstepA, voffA);
            PG8_WAIT_V(8); PG8_WAIT_L(0); PG8_BAR; PG8_MMA(0, 0, At, B0); PG8_MMA(0, 1, At, B1); PG8_BAR; PG8_SCHED;
            PG8_LDA(At, 1, 1); PG8_STAGE(PG8_SB(1, 0), b3, voffB); PG8_STAGE(PG8_SB(1, 1), b3 + hstepB, voffB); PG8_STAGE(PG8_SA(1, 0), a3, voffA);
            PG8_WAIT_V(8); PG8_WAIT_L(0); PG8_BAR; PG8_MMA(1, 0, At, B0); PG8_MMA(1, 1, At, B1); PG8_BAR; PG8_SCHED;
        }
        if (wr == 0) PG8_BAR;
        { int lane_e, wr_ = wr, wc_ = wc; asm volatile("v_mbcnt_lo_u32_b32 %0, -1, 0\n\tv_mbcnt_hi_u32_b32 %0, -1, %0" : "=v"(lane_e)); asm volatile("" : "+s"(wr_), "+s"(wc_));
          E(acc, cur, wr_, wc_, lane_e & 15, lane_e >> 4); }
        if (!has_next) break;
#pragma unroll
        for (int a = 0; a < 2; ++a)
#pragma unroll
            for (int b = 0; b < 2; ++b)
#pragma unroll
                for (int m = 0; m < 4; ++m)
#pragma unroll
                    for (int n = 0; n < 2; ++n) acc[a][b][m][n] = (f32x4){0.f, 0.f, 0.f, 0.f};
        cur = nxt; cA = nA; cB = nB; ++ui;
        if (wr == 1) PG8_BAR;
    }
    PG8_WAIT_V(0);
    PG8_BAR;
#undef PG8_SA
#undef PG8_SB
#undef PG8_STAGE
#undef PG8_LDA
#undef PG8_LDB
#undef PG8_MMA
#undef PG8_WAIT_V
#undef PG8_WAIT_L
#undef PG8_BAR
#undef PG8_SCHED
#undef PG8_PTRS
}
}

constexpr size_t MiB = 1u << 20;
constexpr size_t WS_CTL = 0, CTL_ZERO_BYTES = 1 * MiB;
constexpr size_t WS_TABA = 2 * MiB;
constexpr size_t WS_TABR = 6 * MiB;
constexpr size_t WS_KMEAN = 14 * MiB;
constexpr size_t WS_W = 16 * MiB;
constexpr size_t W_MQKV = WS_W, W_MO = W_MQKV + 48 * MiB, W_RQ = W_MO + 16 * MiB, W_RK = W_RQ + 16 * MiB, W_RV = W_RK + 16 * MiB,
                 W_RG = W_RV + 32 * MiB, W_RO = W_RG + 32 * MiB, W_FI = W_RO + 32 * MiB, W_FO = W_FI + 176 * MiB, W_END = W_FO + 88 * MiB;
constexpr size_t WS_HN = W_END;
constexpr size_t WS_ACT = WS_HN + 64 * MiB;
constexpr size_t A_QKV = WS_ACT, A_MO = WS_ACT + 192 * MiB, A_MLIST = A_MO + 64 * MiB, A_MPO = A_MLIST + 32 * MiB, A_MPML = A_MPO + 192 * MiB;
constexpr size_t A_U = WS_ACT, A_FA = WS_ACT + 352 * MiB;
constexpr size_t A_RQ = WS_ACT, A_RK = A_RQ + 64 * MiB, A_RKT = A_RK + 64 * MiB, A_RVT = A_RKT + 64 * MiB, A_RG = A_RVT + 128 * MiB,
                 A_RP = A_RG + 128 * MiB, A_RU = A_RP + 64 * MiB, A_RRT = A_RU + 128 * MiB, A_REND = A_RRT + 128 * MiB;
constexpr size_t WS_TABRT = A_REND;
constexpr size_t WS_KMP = WS_TABRT + 8 * MiB;
constexpr size_t WS_STATS = WS_KMP + 3 * MiB;
constexpr size_t WS_FSTATS = WS_STATS + 1 * MiB;
constexpr int NCOLG = 75776;
constexpr int CO_M1 = 0, CO_R = 6144, CO_F = 30720, CO_ID = NCOLG, NCOLT = NCOLG + 6144;
constexpr size_t WS_GWP = WS_STATS + 2 * MiB;
constexpr size_t WS_GW = WS_GWP + 20 * MiB;
constexpr size_t WS_NEED = WS_GW + 1 * MiB;
static_assert(W_END == 472 * MiB && WS_ACT == 536 * MiB && WS_NEED == 1338 * MiB && 2 * 32 * NCOLG * 4 <= 20 * MiB, "ws map");

constexpr int RING_BYTES = 131072, LDSCTL_OFF = 144384, MISC_OFF = LDSCTL_OFF + 320, LDS_BYTES = 147456;
constexpr int NWAVES = 8;

#define XB_TMO      128
#define XB_XCNT(j)  (256  + 64 * (j))
#define XB_XSUB(j)  (1280 + 64 * (j))
#define XB_XGEN(j)  (2304 + 64 * (j))
#define XB_TOP      3328
#define XB_TOPGEN   3392
#define XCD_BAR_WORDS 3456
#define XB_SPIN_CAP (1u << 18)
constexpr int CW_BAR = 4096, CW_PANEL = 16384, CW_CNT = 8192;
__device__ __forceinline__ unsigned xb_ld(unsigned* p)              { return __hip_atomic_load(p, __ATOMIC_RELAXED, __HIP_MEMORY_SCOPE_AGENT); }
__device__ __forceinline__ unsigned xb_add(unsigned* p, unsigned v) { return __hip_atomic_fetch_add(p, v, __ATOMIC_RELAXED, __HIP_MEMORY_SCOPE_AGENT); }
__device__ __forceinline__ unsigned xb_xcc_id() { return (unsigned)__builtin_amdgcn_s_getreg((3 << 11) | 20) & 0xFu; }
#define XB_SPIN(cond, bar) do { unsigned _sp = 0; while (cond) { __builtin_amdgcn_s_sleep(1); \
    if ((++_sp & 255u) == 0u) { if (xb_ld(&(bar)[XB_TMO])) break; if (_sp > XB_SPIN_CAP) { atomicAdd(&(bar)[XB_TMO], 1u); break; } } } } while (0)
struct XcdBarrier { unsigned* bar; unsigned x; volatile LAS unsigned* st; };
__device__ __forceinline__ XcdBarrier xcd_barrier_post(unsigned* bar, volatile LAS unsigned* st) {
    XcdBarrier b; b.bar = bar; b.x = xb_xcc_id(); b.st = st;
    if (threadIdx.x == 0) (void)xb_add(&bar[XB_XCNT(b.x)], 1u);
    return b;
}
__device__ __forceinline__ void xcd_barrier_complete(unsigned* bar, unsigned x, unsigned& nloc, unsigned& nx) {
    const unsigned G = gridDim.x * gridDim.y * gridDim.z;
    unsigned sum, cnt, mine, sp = 0u;
    for (;;) {
        sum = 0u; cnt = 0u; mine = 0u;
#pragma unroll
        for (unsigned j = 0; j < 16; ++j) { const unsigned c = xb_ld(&bar[XB_XCNT(j)]); sum += c; cnt += (c > 0u) ? 1u : 0u; mine = (j == x) ? c : mine; }
        if (sum == G) break;
        __builtin_amdgcn_s_sleep(1);
        if ((++sp & 255u) == 0u) { if (xb_ld(&bar[XB_TMO])) break; if (sp > XB_SPIN_CAP) { atomicAdd(&bar[XB_TMO], 1u); break; } }
    }
    nloc = mine > 0u ? mine : 1u; nx = cnt > 0u ? cnt : 1u;
}
__device__ __forceinline__ void xcd_barrier(const XcdBarrier& b) {
    asm volatile("s_waitcnt vmcnt(0)" ::: "memory");
    __syncthreads();
    if (threadIdx.x == 0) {
        unsigned* bar = b.bar;
        __builtin_amdgcn_s_waitcnt(0);
        unsigned nloc = b.st[0], nx = b.st[1];
        if (nloc == 0u) { xcd_barrier_complete(bar, b.x, nloc, nx); b.st[0] = nloc; b.st[1] = nx; }
        const unsigned old = xb_add(&bar[XB_XSUB(b.x)], 1u);
        const unsigned gen = old / nloc;
        if (old + 1u == (gen + 1u) * nloc) {
            __builtin_amdgcn_fence(__ATOMIC_RELEASE, "agent");
            asm volatile("s_waitcnt vmcnt(0)" ::: "memory");
            const unsigned og = xb_add(&bar[XB_TOP], 1u);
            const unsigned tg = og / nx;
            if (og + 1u == (tg + 1u) * nx) xb_add(&bar[XB_TOPGEN], 1u);
            else XB_SPIN(xb_ld(&bar[XB_TOPGEN]) == tg, bar);
            __builtin_amdgcn_fence(__ATOMIC_ACQUIRE, "agent");
            xb_add(&bar[XB_XGEN(b.x)], 1u);
            asm volatile("s_waitcnt vmcnt(0)" ::: "memory");
        } else {
            XB_SPIN(xb_ld(&bar[XB_XGEN(b.x)]) == gen, bar);
            __builtin_amdgcn_fence(__ATOMIC_ACQUIRE, "agent");
            asm volatile("s_waitcnt vmcnt(0)" ::: "memory");
        }
    }
    __syncthreads();
}

struct Args {
    const float* in[14];
    float* out; unsigned char* ws;
    int ph_lo, ph_hi;
};
struct Ctx { int tid, lane, wave, bid, G, gw, NGW, gt, NGT; LAS unsigned char* lds; };

__device__ __forceinline__ void transpose_item(const int PERMODE, const float* W, int K, int N, bf16* WT, LAS float* scr, int item, int lane, const float* fg, const float* fb, float* pgw) {
    const int kblk = K / 64, nb = item / kblk, kb = item % kblk, k0 = 64 * kb, n0 = 64 * nb;
    const int fh = n0 >= FF ? 1 : 0, fw = n0 - fh * FF;
    const int r0 = PERMODE == 1 ? ((n0 >> 8) * 256 + ((n0 >> 6) & 1) * 128 + ((n0 >> 7) & 1) * 64) : PERMODE == 2 ? ((fw >> 7) * 256 + fh * 128 + (fw & 127)) : n0;
    f32x4 v[16];
    const float* src = W + (size_t)(k0 + (lane >> 4)) * N + n0 + 4 * (lane & 15);
#pragma unroll
    for (int i = 0; i < 16; ++i) v[i] = *(const f32x4*)(src + (size_t)(4 * i) * N);
#pragma unroll
    for (int i = 0; i < 16; ++i) { LAS float* d = scr + (4 * i + (lane >> 4)) * 65 + 4 * (lane & 15); d[0] = v[i][0]; d[1] = v[i][1]; d[2] = v[i][2]; d[3] = v[i][3]; }
    asm volatile("s_waitcnt lgkmcnt(0)" ::: "memory");
    const int c = lane & 7;
    float gk[8], bk[8];
#pragma unroll
    for (int t = 0; t < 8; ++t) { gk[t] = 1.f; bk[t] = 0.f; }
    if (fg) {
        const f32x4 g0 = *(const f32x4*)(fg + k0 + 8 * c), g1 = *(const f32x4*)(fg + k0 + 8 * c + 4), b0 = *(const f32x4*)(fb + k0 + 8 * c), b1 = *(const f32x4*)(fb + k0 + 8 * c + 4);
#pragma unroll
        for (int t = 0; t < 4; ++t) { gk[t] = g0[t]; gk[4 + t] = g1[t]; bk[t] = b0[t]; bk[4 + t] = b1[t]; } }
#pragma unroll
    for (int j = 0; j < 8; ++j) { const int n = (lane >> 3) + 8 * j; const LAS float* q = scr + (8 * c) * 65 + n;
        float w[8];
#pragma unroll
        for (int t = 0; t < 8; ++t) w[t] = q[t * 65];
        u32x4 o; o.x = cvt_pk_bf16(w[0] * gk[0], w[1] * gk[1]); o.y = cvt_pk_bf16(w[2] * gk[2], w[3] * gk[3]); o.z = cvt_pk_bf16(w[4] * gk[4], w[5] * gk[5]); o.w = cvt_pk_bf16(w[6] * gk[6], w[7] * gk[7]);
        *(u32x4*)(WT + (size_t)(r0 + n) * K + k0 + 8 * c) = o;
        if (fg) {
            float pg = ((bflo(o.x) + bfhi(o.x)) + (bflo(o.y) + bfhi(o.y))) + ((bflo(o.z) + bfhi(o.z)) + (bflo(o.w) + bfhi(o.w)));
            float pb = ((w[0] * bk[0] + w[1] * bk[1]) + (w[2] * bk[2] + w[3] * bk[3])) + ((w[4] * bk[4] + w[5] * bk[5]) + (w[6] * bk[6] + w[7] * bk[7]));
            pg += shx(pg, 1, lane); pg += shx(pg, 2, lane); pg += shx(pg, 4, lane); pb += shx(pb, 1, lane); pb += shx(pb, 2, lane); pb += shx(pb, 4, lane);
            if (c == 0) { pgw[(size_t)kb * NCOLG + r0 + n] = pg; pgw[(size_t)(32 + kb) * NCOLG + r0 + n] = pb; } } }
    asm volatile("s_waitcnt lgkmcnt(0)" ::: "memory");
}
__device__ __forceinline__ void ph_prologue(const Ctx& C, const Args& a) {
    unsigned char* ws = a.ws;
    {
        LAS float* scr = (LAS float*)(C.lds + C.wave * 16640);
        constexpr int PJ = 12288, PL = 8448, NJ = 2 * PJ, NIT = NJ + 4 * PL;
        for (int g = C.gw; g < NIT; g += C.NGW) {
            const float* W; bf16* WT; int K, N, item; int perm = 0; int lnidx = -1, cob = 0;
            if (g < NJ) { const int j = g / PJ, r = g % PJ;
                if (r < 3072)      { W = a.in[1] + (size_t)j * DM * 3 * DM; WT = (bf16*)(ws + W_MQKV) + (size_t)j * 3 * DM * DM; K = DM; N = 3 * DM; item = r; perm = 1; if (j == 1) { lnidx = 3; cob = CO_M1; } }
                else if (r < 4096) { W = a.in[2] + (size_t)j * DM * DM; WT = (bf16*)(ws + W_MO) + (size_t)j * DM * DM; K = DM; N = DM; item = r - 3072; }
                else if (r < 5120) { W = a.in[3] + (size_t)j * DM * DM; WT = (bf16*)(ws + W_RQ) + (size_t)j * DM * DM; K = DM; N = DM; item = r - 4096; lnidx = 4 * j + 1; cob = CO_R + j * 12288; }
                else if (r < 6144) { W = a.in[4] + (size_t)j * DM * DM; WT = (bf16*)(ws + W_RK) + (size_t)j * DM * DM; K = DM; N = DM; item = r - 5120; lnidx = 4 * j + 1; cob = CO_R + j * 12288 + 2048; }
                else if (r < 8192) { W = a.in[5] + (size_t)j * DM * 2 * DM; WT = (bf16*)(ws + W_RV) + (size_t)j * 2 * DM * DM; K = DM; N = 2 * DM; item = r - 6144; lnidx = 4 * j + 1; cob = CO_R + j * 12288 + 4096; }
                else if (r < 10240) { W = a.in[6] + (size_t)j * DM * 2 * DM; WT = (bf16*)(ws + W_RG) + (size_t)j * 2 * DM * DM; K = DM; N = 2 * DM; item = r - 8192; lnidx = 4 * j + 1; cob = CO_R + j * 12288 + 8192; }
                else               { W = a.in[7] + (size_t)j * 2 * DM * DM; WT = (bf16*)(ws + W_RO) + (size_t)j * 2 * DM * DM; K = 2 * DM; N = DM; item = r - 10240; }
            } else { const int l = (g - NJ) / PL, r = (g - NJ) % PL;
                if (r < 5632) { W = a.in[8] + (size_t)l * DM * FF2; WT = (bf16*)(ws + W_FI) + (size_t)l * FF2 * DM; K = DM; N = FF2; item = r; perm = 2; lnidx = 2 * l; cob = CO_F + l * 11264; }
                else          { W = a.in[11] + (size_t)l * FF * DM; WT = (bf16*)(ws + W_FO) + (size_t)l * FF * DM; K = FF; N = DM; item = r - 5632; }
            }
            const float* fg = lnidx >= 0 ? a.in[12] + (size_t)lnidx * DM : nullptr; const float* fb = lnidx >= 0 ? a.in[13] + (size_t)lnidx * DM : nullptr;
            transpose_item(perm, W, K, N, WT, scr, item, C.lane, fg, fb, (float*)(ws + WS_GWP) + cob);
        }
    }
    f32x2* ta = (f32x2*)(ws + WS_TABA); f32x2* tr = (f32x2*)(ws + WS_TABR);
    for (int i = C.gt; i < SEQ * 64; i += C.NGT) { const int pos = i >> 6, f = i & 63; float s, c; sincos_acc((float)pos * INV_A[f], s, c); ta[i] = (f32x2){c, s}; }
    for (int i = C.gt; i < SEQ * 128; i += C.NGT) { const int pos = i >> 7, f = i & 127; float s, c; sincos_acc((float)pos * INV_R[f], s, c); tr[i] = (f32x2){c, s}; }
    { f32x4* st = (f32x4*)(ws + WS_FSTATS);
      for (int i = C.gt; i < NTOK / 2; i += C.NGT) st[i] = (f32x4){1.f, 0.f, 1.f, 0.f}; }
    const f32x4* x4 = (const f32x4*)a.in[0]; u32x2* hn = (u32x2*)(ws + WS_HN);
    for (int i = C.gt; i < NTOK * DM / 4; i += 4 * C.NGT) { f32x4 v[4];
#pragma unroll
        for (int q = 0; q < 4; ++q) v[q] = x4[i + q * C.NGT];
#pragma unroll
        for (int q = 0; q < 4; ++q) hn[i + q * C.NGT] = (u32x2){cvt_pk_bf16(v[q][0], v[q][1]), cvt_pk_bf16(v[q][2], v[q][3])}; }
}
__device__ __forceinline__ void ph_stats_final(const Ctx& C, const f32x2* part, f32x2* FS) {
    for (int row = C.gt; row < NTOK; row += C.NGT) { const f32x4* p = (const f32x4*)(part + (size_t)row * 8); const f32x4 a = p[0], b = p[1], c = p[2], d = p[3];
        const float S = ((a[0] + a[2]) + (b[0] + b[2])) + ((c[0] + c[2]) + (d[0] + d[2])), Q = ((a[1] + a[3]) + (b[1] + b[3])) + ((c[1] + c[3]) + (d[1] + d[3]));
        const float mu = S * (1.0f / DM), var = Q * (1.0f / DM) - mu * mu, r = 1.0f / sqrtf(var + LN_EPS); FS[row] = (f32x2){r, r * mu}; }
}
__device__ __forceinline__ void ph_fold_reduce(const Ctx& C, const float* P, float* GWv) {
    for (int i = C.gt; i < 2 * NCOLT; i += C.NGT) { const int which = i / NCOLT, col = i % NCOLT; float s = 0.f;
        if (col < NCOLG) for (int kb = 0; kb < 32; ++kb) s += P[(size_t)(which * 32 + kb) * NCOLG + col];
        GWv[i] = s; }
}
__device__ __forceinline__ void ph_ln_final(const Ctx& C, const bf16* TNp, float* Out, const float* g, const float* bta) {
    f32x4 gq[8], bq[8];
#pragma unroll
    for (int j = 0; j < 4; ++j) { const int c0 = 512 * j + 8 * C.lane; gq[2 * j] = *(const f32x4*)(g + c0); gq[2 * j + 1] = *(const f32x4*)(g + c0 + 4); bq[2 * j] = *(const f32x4*)(bta + c0); bq[2 * j + 1] = *(const f32x4*)(bta + c0 + 4); }
    int row = C.gw; u32x4 w4[4];
    if (row < NTOK) {
#pragma unroll
        for (int j = 0; j < 4; ++j) w4[j] = ((const u32x4*)(TNp + (size_t)row * DM) + C.lane)[64 * j]; }
#pragma unroll 1
    for (; row < NTOK; row += C.NGW) {
        u32x4 n4[4]; const int nr = row + C.NGW;
        if (nr < NTOK) {
#pragma unroll
            for (int j = 0; j < 4; ++j) n4[j] = ((const u32x4*)(TNp + (size_t)nr * DM) + C.lane)[64 * j]; }
        else {
#pragma unroll
            for (int j = 0; j < 4; ++j) n4[j] = (u32x4){0u, 0u, 0u, 0u}; }
        float v[32]; float s = 0.f;
#pragma unroll
        for (int j = 0; j < 4; ++j) {
#pragma unroll
            for (int q = 0; q < 4; ++q) { v[8 * j + 2 * q] = bflo(w4[j][q]); v[8 * j + 2 * q + 1] = bfhi(w4[j][q]); s += v[8 * j + 2 * q] + v[8 * j + 2 * q + 1]; } }
        const float mean = wave_sum(s, C.lane) * (1.f / DM); float s2 = 0.f;
#pragma unroll
        for (int j = 0; j < 32; ++j) { v[j] -= mean; s2 += v[j] * v[j]; }
        const float rstd = 1.f / sqrtf(wave_sum(s2, C.lane) * (1.f / DM) + LN_EPS);
#pragma unroll
        for (int j = 0; j < 4; ++j) { const int c0 = 512 * j + 8 * C.lane;
            f32x4 o0, o1;
#pragma unroll
            for (int e = 0; e < 4; ++e) { o0[e] = v[8 * j + e] * rstd * gq[2 * j][e] + bq[2 * j][e]; o1[e] = v[8 * j + 4 + e] * rstd * gq[2 * j + 1][e] + bq[2 * j + 1][e]; }
            *(f32x4*)(Out + (size_t)row * DM + c0) = o0; *(f32x4*)(Out + (size_t)row * DM + c0 + 4) = o1; }
#pragma unroll
        for (int j = 0; j < 4; ++j) w4[j] = n4[j];
    }
}
__device__ __forceinline__ void ph_kmean(const Ctx& C, const bf16* QKV, float* KMo) {
    for (int it = C.gw; it < 2 * MH * MNB; it += C.NGW) {
        const int b = it / (MH * MNB), h = (it / MNB) % MH, j = it % MNB, c = C.lane & 15, rs = C.lane >> 4;
        const bf16* kp = QKV + (size_t)(b * SEQ + j * MBLK + rs) * (3 * DM) + DM + h * MHD + 8 * c;
        float a[8];
#pragma unroll
        for (int e = 0; e < 8; ++e) a[e] = 0.f;
#pragma unroll 1
        for (int r0 = 0; r0 < MBLK / 4; r0 += 16) {
            u32x4 w[16];
#pragma unroll
            for (int r = 0; r < 16; ++r) w[r] = *(const u32x4*)(kp + (size_t)(4 * (r0 + r)) * (3 * DM));
#pragma unroll
            for (int r = 0; r < 16; ++r)
#pragma unroll
                for (int q = 0; q < 4; ++q) { a[2 * q] += bflo(w[r][q]); a[2 * q + 1] += bfhi(w[r][q]); } }
#pragma unroll
        for (int e = 0; e < 8; ++e) { a[e] += shx(a[e], 16, C.lane); a[e] += shx(a[e], 32, C.lane); a[e] *= (1.0f / MBLK); }
        if (rs == 0) { float* o = KMo + (size_t)((b * MH + h) * MNB + j) * MHD + 8 * c; *(f32x4*)o = (f32x4){a[0], a[1], a[2], a[3]}; *(f32x4*)(o + 4) = (f32x4){a[4], a[5], a[6], a[7]}; }
    }
}

namespace mattn {
constexpr int D = 128, KVBLK = 64, SHM_V = KVBLK * D * 2, SHM_K = KVBLK * D * 2;
constexpr int OFF_V = 0, OFF_K = 2 * SHM_V, OFF_WS = 2 * SHM_V + 2 * SHM_K, OFF_STG = OFF_WS + 8 * 1024, OFF_PRE = OFF_STG + 8 * 8192, OFF_WT = OFF_PRE + 1032 * 4;
constexpr long LDQ = 3 * DM;
constexpr int LIST_CAP = 8192;
constexpr float C2 = 1.4426950408889634f;
constexpr float THR = 8.f;
typedef float f32x16 __attribute__((ext_vector_type(16)));
typedef short s16x4 __attribute__((ext_vector_type(4)));
#define KSWZ(row, colB) ((row) * 256 + ((colB) ^ (((row) & 7) << 4)))
#define SBAR() __builtin_amdgcn_sched_barrier(0)
__device__ __forceinline__ int v_st(int k, int c) { const int kk = (k & ~0xC) | ((k & 4) << 1) | ((k & 8) >> 1); return ((kk >> 3) * 4 + (c >> 5)) * 512 + ((kk & 7) * 32 + (c & 31)) * 2; }
__device__ __forceinline__ int v_rd_base(int lane) { return ((lane & 3) << 3) | (((lane >> 2) & 3) << 6) | (((lane >> 4) & 1) << 5) | (((lane >> 5) & 1) << 8); }
constexpr int v_rd_off(int d0, int ks, int half) { return d0 * 512 + ks * 4096 + half * 2048; }
__device__ __forceinline__ int crow(int r, int hi) { return (r & 3) + 8 * (r >> 2) + 4 * hi; }
__device__ __forceinline__ void partialSM(f32x16& p0, f32x16& p1, float& m_reg, float& mn, float& alpha) {
    float pmax = p0[0];
#pragma unroll
    for (int r = 1; r < 16; ++r) pmax = fmaxf(pmax, p0[r]);
#pragma unroll
    for (int r = 0; r < 16; ++r) pmax = fmaxf(pmax, p1[r]);
    { auto rr = __builtin_amdgcn_permlane32_swap(__float_as_uint(pmax), __float_as_uint(pmax), false, false);
      pmax = fmaxf(__uint_as_float(rr[0]), __uint_as_float(rr[1])); }
    if (__builtin_expect(__all((pmax - m_reg) <= THR), 1)) { mn = m_reg; alpha = 1.f; }
    else { mn = fmaxf(m_reg, pmax); alpha = __builtin_amdgcn_exp2f((m_reg - mn) * C2); m_reg = mn; }
    const float mnL = -mn * C2;
#pragma unroll
    for (int r = 0; r < 16; ++r) p0[r] = fmaf(p0[r], C2, mnL);
#pragma unroll
    for (int r = 0; r < 16; ++r) p1[r] = fmaf(p1[r], C2, mnL);
#pragma unroll
    for (int r = 0; r < 16; ++r) p0[r] = __builtin_amdgcn_exp2f(p0[r]);
}
__device__ __forceinline__ void finishSM(f32x16& p0, f32x16& p1, float alpha, float& l_reg, bf16x8& pa0, bf16x8& pa1, bf16x8& pa2, bf16x8& pa3) {
#pragma unroll
    for (int r = 0; r < 16; ++r) p1[r] = __builtin_amdgcn_exp2f(p1[r]);
    float ps = 0;
#pragma unroll
    for (int r = 0; r < 16; ++r) ps += p0[r];
#pragma unroll
    for (int r = 0; r < 16; ++r) ps += p1[r];
    { auto rr = __builtin_amdgcn_permlane32_swap(__float_as_uint(ps), __float_as_uint(ps), false, false);
      ps = __uint_as_float(rr[0]) + __uint_as_float(rr[1]); }
    l_reg = l_reg * alpha + ps;
#define PK4(P, B_, OUT) do { unsigned a0 = cvt_pk_bf16(P[B_+0], P[B_+1]), a1 = cvt_pk_bf16(P[B_+2], P[B_+3]);                          \
        unsigned b0 = cvt_pk_bf16(P[B_+4], P[B_+5]), b1 = cvt_pk_bf16(P[B_+6], P[B_+7]);                                             \
        auto r0 = __builtin_amdgcn_permlane32_swap(a0, b0, false, false); auto r1 = __builtin_amdgcn_permlane32_swap(a1, b1, false, false); \
        u32x4 w = {r0[0], r1[0], r0[1], r1[1]}; OUT = __builtin_bit_cast(bf16x8, w); } while (0)
    PK4(p0, 0, pa0); PK4(p0, 8, pa1); PK4(p1, 0, pa2); PK4(p1, 8, pa3);
#undef PK4
}
template <int KB>
__device__ __forceinline__ void qkt(f32x16& p0, f32x16& p1, const LAS char* K_lds, int r32, int hi, const bf16x8* qr) {
    p0 = f32x16{}; p1 = f32x16{};
    const LAS char* kb[4];
#pragma unroll
    for (int dd = 0; dd < 4; ++dd) kb[dd] = K_lds + KB * SHM_K + KSWZ(r32, (dd * 16 + hi * 8) * 2);
#pragma unroll
    for (int d0 = 0; d0 < 8; ++d0) { const LAS char* a = kb[d0 & 3] + (d0 >> 2) * 128;
        const bf16x8 b0 = *(const LAS bf16x8*)a;
        const bf16x8 b1 = *(const LAS bf16x8*)(a + 32 * 256);
        p0 = __builtin_amdgcn_mfma_f32_32x32x16_bf16(b0, qr[d0], p0, 0, 0, 0);
        p1 = __builtin_amdgcn_mfma_f32_32x32x16_bf16(b1, qr[d0], p1, 0, 0, 0); }
}
template <int VB>
__device__ __forceinline__ void pv_tile(f32x16* o, int vb0, bf16x8 pa0, bf16x8 pa1, bf16x8 pa2, bf16x8 pa3) {
#define TRRD(dst, off) asm volatile("ds_read_b64_tr_b16 %0, %1 offset:%2" : "=&v"(dst) : "v"(vb0), "i"(off) : "memory")
#define PV_D0(d0) do { s16x4 l0, l1, l2, l3, h0, h1, h2, h3; constexpr int b_ = VB * SHM_V + v_rd_off(d0, 0, 0); \
        TRRD(l0, b_); TRRD(h0, b_ + 2048); TRRD(l1, b_ + 4096); TRRD(h1, b_ + 6144); TRRD(l2, b_ + 8192); TRRD(h2, b_ + 10240); TRRD(l3, b_ + 12288); TRRD(h3, b_ + 14336); \
        asm volatile("s_waitcnt lgkmcnt(0)" ::: "memory"); SBAR(); \
        o[d0] = __builtin_amdgcn_mfma_f32_32x32x16_bf16(pa0, (bf16x8){l0[0], l0[1], l0[2], l0[3], h0[0], h0[1], h0[2], h0[3]}, o[d0], 0, 0, 0);   \
        o[d0] = __builtin_amdgcn_mfma_f32_32x32x16_bf16(pa1, (bf16x8){l1[0], l1[1], l1[2], l1[3], h1[0], h1[1], h1[2], h1[3]}, o[d0], 0, 0, 0);   \
        o[d0] = __builtin_amdgcn_mfma_f32_32x32x16_bf16(pa2, (bf16x8){l2[0], l2[1], l2[2], l2[3], h2[0], h2[1], h2[2], h2[3]}, o[d0], 0, 0, 0);   \
        o[d0] = __builtin_amdgcn_mfma_f32_32x32x16_bf16(pa3, (bf16x8){l3[0], l3[1], l3[2], l3[3], h3[0], h3[1], h3[2], h3[3]}, o[d0], 0, 0, 0); } while (0)
    PV_D0(0); PV_D0(1); PV_D0(2); PV_D0(3);
#undef PV_D0
#undef TRRD
}
struct AttnItem { const bf16* qrow; const bf16* Kb; const bf16* Vb; };
__device__ __forceinline__ void attn_offs(int wid, int lane, unsigned (&koff)[2], unsigned (&voff)[2]) {
#pragma unroll
    for (int i = 0; i < 2; ++i) { const int pi = wid * 2 + i, row = 4 * pi + (lane >> 4), c = (lane & 15) ^ (row & 7); koff[i] = (unsigned)(row * (int)LDQ + c * 8) * 2u;
        const int st = pi * 2 + (lane >> 5), kk = ((st >> 2) << 3) | ((lane & 31) >> 2), k = (kk & ~0xC) | ((kk & 4) << 1) | ((kk & 8) >> 1), cc = (st & 3) * 32 + (lane & 3) * 8; voff[i] = (unsigned)(k * (int)LDQ + cc) * 2u; }
}
#define SDMA(KB_, VB_, t, bf) do { _Pragma("unroll") for (int i_ = 0; i_ < 2; ++i_) { \
        __builtin_amdgcn_global_load_lds((const unsigned*)((const char*)(KB_) + (size_t)(t) * 64 * LDQ * 2 + koff[i_]), (LAS unsigned*)(K_lds + (bf) * SHM_K + (wid * 2 + i_) * 1024), 16, 0, 0); \
        __builtin_amdgcn_global_load_lds((const unsigned*)((const char*)(VB_) + (size_t)(t) * 64 * LDQ * 2 + voff[i_]), (LAS unsigned*)(V_lds + (bf) * SHM_V + (wid * 2 + i_) * 1024), 16, 0, 0); } } while (0)
__device__ __forceinline__ void attn_prime(LAS char* lds, int tid, const AttnItem& it, bf16x8 (&qr)[8]) {
    const int wid = __builtin_amdgcn_readfirstlane(tid >> 6), lane = tid & 63, hi = lane >> 5;
    LAS char* V_lds = lds + OFF_V; LAS char* K_lds = lds + OFF_K; unsigned koff[2], voff[2]; attn_offs(wid, lane, koff, voff);
#pragma unroll
    for (int d0 = 0; d0 < 8; ++d0) qr[d0] = *(const bf16x8*)(it.qrow + d0 * 16 + hi * 8);
    SDMA(it.Kb, it.Vb, 0, 0);
}
template <bool CAUSAL>
__device__ __forceinline__ void attn_core(LAS char* lds, int tid, const AttnItem& cur, const AttnItem& nxt, bool has_next, bf16x8 (&qr)[8], f32x16 (&o)[4], float& m_reg, float& l_reg) {
    const int wid = __builtin_amdgcn_readfirstlane(tid >> 6), lane = tid & 63, r32 = lane & 31, hi = lane >> 5;
    LAS char* V_lds = lds + OFF_V; LAS char* K_lds = lds + OFF_K;
    LAS float* al_l = (LAS float*)(lds + OFF_WS) + wid * 256;
    const int vb0 = (int)(unsigned)(uintptr_t)V_lds + v_rd_base(lane);
    unsigned koff[2], voff[2]; attn_offs(wid, lane, koff, voff);
    m_reg = -1e30f; l_reg = 0.f;
#pragma unroll
    for (int d = 0; d < 4; ++d) o[d] = f32x16{};
    const int qrel0 = wid * 32;
    asm volatile("s_waitcnt vmcnt(0)" ::: "memory"); __syncthreads();
#define TILE(t, BUF) do { \
        if ((t) < 3) SDMA(cur.Kb, cur.Vb, (t) + 1, 1 - (BUF)); else if (has_next) SDMA(nxt.Kb, nxt.Vb, 0, 0); \
        if (!CAUSAL || (t) * 64 <= qrel0 + 31) { \
            f32x16 pA0, pA1; float mn, al; bf16x8 pa0, pa1, pa2, pa3; \
            qkt<BUF>(pA0, pA1, K_lds, r32, hi, qr); \
            if ((t) == 3 && has_next) { _Pragma("unroll") for (int d0 = 0; d0 < 8; ++d0) qr[d0] = *(const bf16x8*)(nxt.qrow + d0 * 16 + hi * 8); } \
            if (CAUSAL && (t) * 64 + 63 > qrel0) { const int dq = qrel0 + r32 - (t) * 64 - 4 * hi; const float NEG = -__builtin_inff(); \
                _Pragma("unroll") for (int r = 0; r < 16; ++r) { const int c = (r & 3) + 8 * (r >> 2); if (dq - c < 0) pA0[r] = NEG; if (dq - c - 32 < 0) pA1[r] = NEG; } } \
            partialSM(pA0, pA1, m_reg, mn, al); \
            if (__any(al < 1.f)) { if (hi == 0) al_l[r32] = al; asm volatile("s_waitcnt lgkmcnt(0)" ::: "memory"); \
                _Pragma("unroll") for (int d_ = 0; d_ < 4; ++d_) _Pragma("unroll") for (int r = 0; r < 16; ++r) o[d_][r] *= al_l[crow(r, hi)]; } \
            finishSM(pA0, pA1, al, l_reg, pa0, pa1, pa2, pa3); SBAR(); \
            pv_tile<BUF>(o, vb0, pa0, pa1, pa2, pa3); } \
        else if ((t) == 3 && has_next) { _Pragma("unroll") for (int d0 = 0; d0 < 8; ++d0) qr[d0] = *(const bf16x8*)(nxt.qrow + d0 * 16 + hi * 8); } \
        if ((t) < 3) asm volatile("s_waitcnt vmcnt(0)" ::: "memory"); \
        __syncthreads(); } while (0)
    TILE(0, 0); TILE(1, 1); TILE(2, 0); TILE(3, 1);
#undef TILE
}
#undef SDMA
#undef KSWZ
#undef SBAR
}

__device__ __forceinline__ void stage_o(LAS unsigned short* stg, const mattn::f32x16 (&o)[4], const LAS float* scale, int r32, int hi) {
#pragma unroll
    for (int r = 0; r < 16; ++r) { const int rr = mattn::crow(r, hi); const float f = scale ? scale[rr] : 1.f;
#pragma unroll
        for (int d0 = 0; d0 < 4; ++d0) stg[rr * 128 + d0 * 32 + r32] = (unsigned short)cvt_pk_bf16(o[d0][r] * f, 0.f); }
    asm volatile("s_waitcnt lgkmcnt(0)" ::: "memory");
}
__device__ __forceinline__ void ph_moba_route(const Ctx& C, const bf16* QKV, const float* KMp, unsigned* cnt, unsigned* list) {
    LAS unsigned* lcnt = (LAS unsigned*)C.lds; LAS unsigned* gb = lcnt + 32;
    for (int it = C.gw; it < 2 * MH * 128; it += C.NGW) {
        const int b = it >> 11, qg = b ? 127 - (it & 127) : (it & 127), h = (it >> 7) & 15, blk = qg >> 2;
        const int pos = qg * 64 + C.lane, tok = b * SEQ + pos;
        if (C.tid < 32) lcnt[C.tid] = 0u;
        __syncthreads();
        int s0 = 0, s1 = 0, s2 = 0;
        if (blk > 0) {
            const bf16* qp = QKV + (size_t)tok * (3 * DM) + h * MHD;
            u32x4 qv[16];
#pragma unroll
            for (int i = 0; i < 16; ++i) qv[i] = *(const u32x4*)(qp + 8 * i);
            float v0 = -__builtin_inff(), v1 = v0, v2 = v0;
            const float* km = KMp + (size_t)((b * MH + h) * MNB) * MHD;
            for (int j = 0; j < blk; ++j) {
                const float* kj = km + j * MHD; float sc = 0.f;
#pragma unroll
                for (int i = 0; i < 16; ++i) { const f32x4 ka = *(const f32x4*)(kj + 8 * i), kb = *(const f32x4*)(kj + 8 * i + 4);
                    sc += bflo(qv[i].x) * ka[0] + bfhi(qv[i].x) * ka[1] + bflo(qv[i].y) * ka[2] + bfhi(qv[i].y) * ka[3]
                        + bflo(qv[i].z) * kb[0] + bfhi(qv[i].z) * kb[1] + bflo(qv[i].w) * kb[2] + bfhi(qv[i].w) * kb[3]; }
                const bool g0 = sc > v0, g1 = sc > v1, g2 = sc > v2;
                v2 = g1 ? v1 : (g2 ? sc : v2); s2 = g1 ? s1 : (g2 ? j : s2);
                v1 = g0 ? v0 : (g1 ? sc : v1); s1 = g0 ? s0 : (g1 ? j : s1);
                v0 = g0 ? sc : v0;             s0 = g0 ? j : s0;
            }
        }
        const int nsel = blk < 3 ? blk : 3; const int base = (b * MH + h) * MNB;
        unsigned r0 = 0, r1 = 0, r2 = 0;
        if (nsel > 0) r0 = __hip_atomic_fetch_add(lcnt + s0, 1u, __ATOMIC_RELAXED, __HIP_MEMORY_SCOPE_WORKGROUP);
        if (nsel > 1) r1 = __hip_atomic_fetch_add(lcnt + s1, 1u, __ATOMIC_RELAXED, __HIP_MEMORY_SCOPE_WORKGROUP);
        if (nsel > 2) r2 = __hip_atomic_fetch_add(lcnt + s2, 1u, __ATOMIC_RELAXED, __HIP_MEMORY_SCOPE_WORKGROUP);
        __syncthreads();
        if (C.tid < 32) { const unsigned n = lcnt[C.tid]; gb[C.tid] = n ? atomicAdd(cnt + base + C.tid, n) : 0u; }
        __syncthreads();
        if (nsel > 0) list[(size_t)(base + s0) * mattn::LIST_CAP + gb[s0] + r0] = (unsigned)pos;
        if (nsel > 1) list[(size_t)(base + s1) * mattn::LIST_CAP + gb[s1] + r1] = (unsigned)pos | (1u << 13);
        if (nsel > 2) list[(size_t)(base + s2) * mattn::LIST_CAP + gb[s2] + r2] = (unsigned)pos | (2u << 13);
    }
}
__device__ __forceinline__ void ph_moba_sel(const Ctx& C, const bf16* QKV, const unsigned* cnt, const unsigned* list, bf16* PO, f32x2* PML) {
    using namespace mattn;
    LAS char* lds = (LAS char*)C.lds;
    LAS int* pre = (LAS int*)(lds + OFF_PRE); LAS int* wtot = (LAS int*)(lds + OFF_WT);
    const int tid = C.tid, wid = C.wave, lane = C.lane, r32 = lane & 31, hi = lane >> 5;
    {
        const int c0 = (int)cnt[2 * tid], c1 = (int)cnt[2 * tid + 1], n0 = (c0 + 255) >> 8, n1 = (c1 + 255) >> 8, x = n0 + n1; int incl = x;
#pragma unroll
        for (int o = 1; o < 64; o <<= 1) { const int y = __builtin_amdgcn_ds_bpermute((lane - o) << 2, incl); if (lane >= o) incl += y; }
        if (lane == 63) wtot[wid] = incl;
        __syncthreads();
        int woff = 0;
        for (int w = 0; w < wid; ++w) woff += wtot[w];
        const int excl = woff + incl - x;
        pre[2 * tid] = excl; pre[2 * tid + 1] = excl + n0; if (tid == 511) pre[1024] = excl + x;
        __syncthreads();
    }
    const int T = pre[1024];
#define SEL_DECODE(item_, bhj_, n_, ent_, valid_, AI_) do { int lo_ = 0, hi_ = 1024; \
        while (hi_ - lo_ > 1) { const int mid = (lo_ + hi_) >> 1; if (pre[mid] <= (item_)) lo_ = mid; else hi_ = mid; } \
        bhj_ = lo_; const int chunk_ = (item_) - pre[bhj_]; n_ = (int)cnt[bhj_] - chunk_ * 256; n_ = n_ > 256 ? 256 : n_; \
        valid_ = (wid * 32 + r32) < n_; ent_ = list[(size_t)bhj_ * LIST_CAP + chunk_ * 256 + (valid_ ? (wid * 32 + r32) : 0)]; \
        { const int j_ = bhj_ & 31, h_ = (bhj_ >> 5) & 15, b_ = bhj_ >> 9; AI_.qrow = QKV + (size_t)(b_ * SEQ + (int)(ent_ & 8191u)) * LDQ + h_ * MHD; \
          AI_.Kb = QKV + (size_t)(b_ * SEQ + j_ * MBLK) * LDQ + DM + h_ * MHD; AI_.Vb = AI_.Kb + DM; } } while (0)
    int item = (C.G & 7) == 0 ? (C.bid & 7) * (C.G >> 3) + (C.bid >> 3) : C.bid; if (item >= T) return;
    int bhj, n; unsigned ent; bool valid; AttnItem cur; bf16x8 qr[8];
    SEL_DECODE(item, bhj, n, ent, valid, cur);
    attn_prime(lds, tid, cur, qr);
    for (;;) {
        const int nitem = item + C.G; const bool has_next = nitem < T;
        int bhj2 = bhj, n2 = n; unsigned ent2 = ent; bool valid2 = valid; AttnItem nxt = cur;
        if (has_next) SEL_DECODE(nitem, bhj2, n2, ent2, valid2, nxt);
        const int h = (bhj >> 5) & 15, b = bhj >> 9, pos = ent & 8191, slot = ent >> 13;
        f32x16 o[4]; float m_reg, l_reg;
        attn_core<false>(lds, tid, cur, nxt, has_next, qr, o, m_reg, l_reg);
        const size_t trow = (size_t)slot * NTOK + (size_t)(b * SEQ + pos);
        if (valid && hi == 0) PML[trow * MH + h] = (f32x2){m_reg, l_reg};
        LAS unsigned* dtab = (LAS unsigned*)((LAS float*)(lds + OFF_WS) + wid * 256 + 64);
        if (hi == 0) dtab[r32] = valid ? (unsigned)((trow * DM + h * MHD) * 2) : 0xffffffffu;
        LAS unsigned short* stg = (LAS unsigned short*)(lds + OFF_STG) + wid * 4096;
        stage_o(stg, o, nullptr, r32, hi);
#pragma unroll
        for (int i = 0; i < 8; ++i) { const int rw = (lane >> 4) + 4 * i, c = lane & 15; const unsigned d = dtab[rw];
            const u32x4 v = *(const LAS u32x4*)(stg + rw * 128 + c * 8);
            if (d != 0xffffffffu) *(u32x4*)((char*)PO + d + c * 16) = v; }
        asm volatile("s_waitcnt lgkmcnt(0)" ::: "memory");
        if (!has_next) break;
        item = nitem; bhj = bhj2; n = n2; ent = ent2; valid = valid2; cur = nxt;
    }
#undef SEL_DECODE
}
__device__ __forceinline__ void ph_moba_own(const Ctx& C, const bf16* QKV, const bf16* PO, const f32x2* PML, bf16* O) {
    using namespace mattn;
    LAS char* lds = (LAS char*)C.lds;
    const int tid = C.tid, wid = C.wave, lane = C.lane, r32 = lane & 31, hi = lane >> 5;
    LAS float* tb = (LAS float*)(lds + OFF_WS) + wid * 256 + 64;
#define OWN_DECODE(item_, AI_) do { const int qb_ = (item_) & 31, h_ = ((item_) >> 5) & 15, b_ = (item_) >> 9; \
        AI_.qrow = QKV + (size_t)(b_ * SEQ + qb_ * MBLK + wid * 32 + r32) * LDQ + h_ * MHD; AI_.Kb = QKV + (size_t)(b_ * SEQ + qb_ * MBLK) * LDQ + DM + h_ * MHD; AI_.Vb = AI_.Kb + DM; } while (0)
    if (C.bid >= 2 * MH * MNB) return;
    AttnItem cur; bf16x8 qr[8]; OWN_DECODE(C.bid, cur);
    attn_prime(lds, tid, cur, qr);
    for (int item = C.bid; item < 2 * MH * MNB; item += C.G) {
        const int qb = item & 31, h = (item >> 5) & 15, b = item >> 9;
        const int tok = b * SEQ + qb * MBLK + wid * 32 + r32;
        const bool has_next = item + C.G < 2 * MH * MNB; AttnItem nxt = cur; if (has_next) OWN_DECODE(item + C.G, nxt);
        const int nsel = qb < 3 ? qb : 3;
        f32x16 o[4]; float m_reg, l_reg;
        attn_core<true>(lds, tid, cur, nxt, has_next, qr, o, m_reg, l_reg);
        LAS unsigned short* stg = (LAS unsigned short*)(lds + OFF_STG) + wid * 4096;
        stage_o(stg, o, nullptr, r32, hi);
        const int tok0 = b * SEQ + qb * MBLK + wid * 32;
        f32x2 ml[3];
#pragma unroll
        for (int sl = 0; sl < 3; ++sl) ml[sl] = (sl < nsel) ? PML[((size_t)sl * NTOK + tok) * MH + h] : (f32x2){-1e30f, 0.f};
        u32x4 pv[3][8];
#pragma unroll
        for (int sl = 0; sl < 3; ++sl)
#pragma unroll
            for (int i = 0; i < 8; ++i) { const int rw = (lane >> 4) + 4 * i, c = lane & 15;
                pv[sl][i] = (sl < nsel) ? *(const u32x4*)(PO + (size_t)sl * NTOK * DM + (size_t)(tok0 + rw) * DM + h * MHD + c * 8) : (u32x4){0u, 0u, 0u, 0u}; }
        {
            float M = m_reg;
#pragma unroll
            for (int sl = 0; sl < 3; ++sl) M = fmaxf(M, ml[sl].x);
            const float fo = __builtin_amdgcn_exp2f((m_reg - M) * C2); float L = l_reg * fo; float fs[3];
#pragma unroll
            for (int sl = 0; sl < 3; ++sl) { fs[sl] = (sl < nsel) ? __builtin_amdgcn_exp2f((ml[sl].x - M) * C2) : 0.f; L += ml[sl].y * fs[sl]; }
            const float inv = 1.0f / L;
            if (hi == 0) { tb[r32] = fo * inv; tb[32 + r32] = fs[0] * inv; tb[64 + r32] = fs[1] * inv; tb[96 + r32] = fs[2] * inv; }
            asm volatile("s_waitcnt lgkmcnt(0)" ::: "memory");
        }
#pragma unroll
        for (int i = 0; i < 8; ++i) { const int rw = (lane >> 4) + 4 * i, c = lane & 15;
            const u32x4 ov = *(const LAS u32x4*)(stg + rw * 128 + c * 8); const float f0 = tb[rw];
            float x[8];
#pragma unroll
            for (int q = 0; q < 4; ++q) { x[2 * q] = f0 * bflo(ov[q]); x[2 * q + 1] = f0 * bfhi(ov[q]); }
#pragma unroll
            for (int sl = 0; sl < 3; ++sl) { const float f = tb[32 * (sl + 1) + rw];
#pragma unroll
                for (int q = 0; q < 4; ++q) { x[2 * q] += f * bflo(pv[sl][i][q]); x[2 * q + 1] += f * bfhi(pv[sl][i][q]); } }
            u32x4 w; w.x = cvt_pk_bf16(x[0], x[1]); w.y = cvt_pk_bf16(x[2], x[3]); w.z = cvt_pk_bf16(x[4], x[5]); w.w = cvt_pk_bf16(x[6], x[7]);
            *(u32x4*)(O + (size_t)(tok0 + rw) * DM + h * MHD + c * 8) = w; }
        asm volatile("s_waitcnt lgkmcnt(0)" ::: "memory");
        cur = nxt;
    }
#undef OWN_DECODE
}
__device__ __forceinline__ void ph_conv_fix(const Ctx& C, const bf16* UH, bf16* A, const float* cw, const float* cb) {
    constexpr int FG = FF / 8;
    for (int it = C.gt; it < (NTOK / 64) * 2 * FG; it += C.NGT) {
        const int fg = it % FG, rr = (it / FG) & 1, G = it / (2 * FG), f0 = fg * 8, t = G * 64 + rr; const bool seq0 = (t & (SEQ - 1)) < 2 && ((G * 64) & (SEQ - 1)) == 0;
        const bf16* up = UH + (size_t)(G - 1) * 4 * FF2; const bf16* uc = UH + (size_t)G * 4 * FF2;
        u32x4 g2, g1, g0, v2, v1, v0; const u32x4 z = {0, 0, 0, 0};
        if (rr == 0) { g2 = seq0 ? z : *(const u32x4*)(up + f0); g1 = seq0 ? z : *(const u32x4*)(up + FF2 + f0); g0 = *(const u32x4*)(uc + 2 * FF2 + f0);
                       v2 = seq0 ? z : *(const u32x4*)(up + FF + f0); v1 = seq0 ? z : *(const u32x4*)(up + FF2 + FF + f0); v0 = *(const u32x4*)(uc + 2 * FF2 + FF + f0); }
        else         { g2 = seq0 ? z : *(const u32x4*)(up + FF2 + f0); g1 = *(const u32x4*)(uc + 2 * FF2 + f0); g0 = *(const u32x4*)(uc + 3 * FF2 + f0);
                       v2 = seq0 ? z : *(const u32x4*)(up + FF2 + FF + f0); v1 = *(const u32x4*)(uc + 2 * FF2 + FF + f0); v0 = *(const u32x4*)(uc + 3 * FF2 + FF + f0); }
        u32x4 o;
#pragma unroll
        for (int j = 0; j < 4; ++j) { float r[2];
#pragma unroll
            for (int hl = 0; hl < 2; ++hl) { const int c = f0 + 2 * j + hl;
                const float ug2 = hl ? bfhi(g2[j]) : bflo(g2[j]), ug1 = hl ? bfhi(g1[j]) : bflo(g1[j]), ug0 = hl ? bfhi(g0[j]) : bflo(g0[j]);
                const float uv2 = hl ? bfhi(v2[j]) : bflo(v2[j]), uv1 = hl ? bfhi(v1[j]) : bflo(v1[j]), uv0 = hl ? bfhi(v0[j]) : bflo(v0[j]);
                const float cg = cb[c] + cw[c] * ug2 + cw[FF2 + c] * ug1 + cw[2 * FF2 + c] * ug0;
                const float cv = cb[FF + c] + cw[FF + c] * uv2 + cw[FF2 + FF + c] * uv1 + cw[2 * FF2 + FF + c] * uv0;
                r[hl] = gelu_tanh(cg) * cv; }
            o[j] = cvt_pk_bf16(r[0], r[1]); }
        *(u32x4*)(A + (size_t)t * FF + f0) = o;
    }
}
__device__ __forceinline__ void ph_scan(const Ctx& C, const bf16* U, bf16* RT) {
    for (long it = C.gt; it < (long)RH * RDV * 2 * 128; it += C.NGT) {
        const int row = (int)(it >> 8), b = (int)(it >> 7) & 1, d0 = (int)(it & 127) * 2, h = row / RDV; const float gl = fast_exp2((float)RL * log2g(h));
        unsigned off = ((unsigned)row * NTOK + (unsigned)b * SEQ + (unsigned)d0) * 2u; float r0 = 0.f, r1 = 0.f;
        unsigned w[8];
#pragma unroll
        for (int i = 0; i < 8; ++i) w[i] = pg8::ldo<unsigned>(U, off + (unsigned)i * (RL * 2));
#pragma unroll 1
        for (int g = 0; g < SEQ / RL / 8; ++g, off += 8 * RL * 2) {
            unsigned n[8];
            if (g + 1 < SEQ / RL / 8) {
#pragma unroll
                for (int i = 0; i < 8; ++i) n[i] = pg8::ldo<unsigned>(U, off + 8 * RL * 2 + (unsigned)i * (RL * 2)); }
            else {
#pragma unroll
                for (int i = 0; i < 8; ++i) n[i] = 0u; }
#pragma unroll
            for (int i = 0; i < 8; ++i) {
                pg8::sto<unsigned>(RT, off + (unsigned)i * (RL * 2), cvt_pk_bf16(r0, r1));
                r0 = gl * (r0 + bflo(w[i])); r1 = gl * (r1 + bfhi(w[i])); }
#pragma unroll
            for (int i = 0; i < 8; ++i) w[i] = n[i];
        }
    }
}
__device__ __forceinline__ void ph_groupnorm(const Ctx& C, const bf16* Y, bf16* G) {
    u32x4 yw[8], gw[8];
    const int step = C.NGW * 8; int it0 = C.gw * 8;
    if (it0 < NTOK * RH) {
#pragma unroll
        for (int k = 0; k < 8; ++k) { const unsigned off = ((unsigned)(it0 + k) * RDV + 8u * C.lane) * 2u; yw[k] = *(const u32x4*)((const char*)Y + off); gw[k] = *(const u32x4*)((const char*)G + off); } }
#pragma unroll 1
    for (; it0 < NTOK * RH; it0 += step) {
        u32x4 yn[8], gn[8]; const int nx = it0 + step;
        if (nx < NTOK * RH) {
#pragma unroll
            for (int k = 0; k < 8; ++k) { const unsigned off = ((unsigned)(nx + k) * RDV + 8u * C.lane) * 2u; yn[k] = *(const u32x4*)((const char*)Y + off); gn[k] = *(const u32x4*)((const char*)G + off); } }
        else {
#pragma unroll
            for (int k = 0; k < 8; ++k) { yn[k] = (u32x4){0u, 0u, 0u, 0u}; gn[k] = (u32x4){0u, 0u, 0u, 0u}; } }
#pragma unroll
        for (int k = 0; k < 8; ++k) { const int it = it0 + k, tok = it >> 3, h = it & 7, n = tok & (RL - 1); const float xi = fast_exp2((float)(n + 1) * log2g(h));
            float y[8]; float s = 0.f;
#pragma unroll
            for (int j = 0; j < 4; ++j) { y[2 * j] = bflo(yw[k][j]) * xi; y[2 * j + 1] = bfhi(yw[k][j]) * xi; s += y[2 * j] + y[2 * j + 1]; }
            const float mean = wave_sum(s, C.lane) * (1.f / RDV); float s2 = 0.f;
#pragma unroll
            for (int j = 0; j < 8; ++j) { y[j] -= mean; s2 += y[j] * y[j]; }
            const float rstd = 1.f / sqrtf(wave_sum(s2, C.lane) * (1.f / RDV) + GN_EPS);
            u32x4 o;
#pragma unroll
            for (int j = 0; j < 4; ++j) o[j] = cvt_pk_bf16(bflo(gw[k][j]) * y[2 * j] * rstd, bfhi(gw[k][j]) * y[2 * j + 1] * rstd);
            *(u32x4*)((char*)G + ((unsigned)it * RDV + 8u * C.lane) * 2u) = o; }
#pragma unroll
        for (int k = 0; k < 8; ++k) { yw[k] = yn[k]; gw[k] = gn[k]; }
    }
}

__global__ void __launch_bounds__(NWAVES * 64, 2) fwd(Args args) {
    extern __shared__ __attribute__((aligned(16))) unsigned char lds_raw[];
    LAS unsigned char* const lds0 = (LAS unsigned char*)lds_raw;
    volatile LAS unsigned* MISC = (volatile LAS unsigned*)(lds0 + MISC_OFF);
    for (int u = threadIdx.x; u < (LDS_BYTES - LDSCTL_OFF) / 4; u += NWAVES * 64) ((LAS unsigned*)(lds0 + LDSCTL_OFF))[u] = 0u;
    __syncthreads();
    XcdBarrier bar = xcd_barrier_post((unsigned*)(args.ws + WS_CTL) + CW_BAR, MISC + 8);
    const int lo = args.ph_lo, hi = args.ph_hi;
    const int wave0 = __builtin_amdgcn_readfirstlane(threadIdx.x >> 6);
    int pc = 0;
#define PH_BEGIN { const int pid_ = pc++; if (lo <= pid_ && pid_ < hi) { int lane_; asm volatile("v_mbcnt_lo_u32_b32 %0, -1, 0\n\tv_mbcnt_hi_u32_b32 %0, -1, %0" : "=v"(lane_)); \
        const __attribute__((address_space(4))) unsigned long long* ap_ = (const __attribute__((address_space(4))) unsigned long long*)__builtin_amdgcn_kernarg_segment_ptr(); asm volatile("" : "+s"(ap_)); \
        Args args;   \
        _Pragma("unroll") for (int i_ = 0; i_ < 14; ++i_) args.in[i_] = (const float*)(GAS const float*)ap_[i_]; args.out = (float*)(GAS float*)ap_[14]; args.ph_lo = 0; args.ph_hi = 0; \
        GAS unsigned char* wsg_ = (GAS unsigned char*)ap_[15]; asm volatile("" : "+s"(wsg_)); args.ws = (unsigned char*)wsg_; unsigned char* ws = args.ws;     \
        Ctx C; C.lds = lds0; C.tid = wave0 * 64 + lane_; C.lane = lane_; C.wave = wave0; { int b_ = blockIdx.x, g_ = gridDim.x; asm volatile("" : "+s"(b_), "+s"(g_)); C.bid = b_; C.G = g_; } \
        C.gw = C.bid * NWAVES + C.wave; C.NGW = C.G * NWAVES; C.gt = C.bid * (NWAVES * 64) + C.tid; C.NGT = C.G * NWAVES * 64; \
        float* Hb = args.out; bf16* HN = (bf16*)(ws + WS_HN); pg8::StaticOrder S; (void)Hb; (void)HN; (void)S;
#define PH_END   if (pid_ + 1 < hi) xcd_barrier(bar); } }
#define SUB(...) { GAS unsigned char* wsg2_ = (GAS unsigned char*)ws; asm volatile("" : "+s"(wsg2_), "+s"(C.bid), "+s"(C.G)); unsigned char* ws_ = (unsigned char*)wsg2_; int lane2_; asm volatile("v_mbcnt_lo_u32_b32 %0, -1, 0\n\tv_mbcnt_hi_u32_b32 %0, -1, %0" : "=v"(lane2_)); \
        C.tid = wave0 * 64 + lane2_; C.lane = lane2_; { unsigned char* ws = ws_; bf16* HN = (bf16*)(ws + WS_HN); (void)HN; __VA_ARGS__ } }

#define SPART ((f32x2*)(ws + WS_STATS))
#define FSTATS ((f32x2*)(ws + WS_FSTATS))
#define GWV ((const float*)(ws + WS_GW))
#define BWV ((const float*)(ws + WS_GW) + NCOLT)
#define RED ((LAS f32x2*)(C.lds + RING_BYTES))
#define LNG(i) (args.in[12] + (size_t)(i) * DM)
#define LNB(i) (args.in[13] + (size_t)(i) * DM)
#define TABA ((const f32x2*)(ws + WS_TABA))
#define TABR ((const f32x2*)(ws + WS_TABR))
#define KM ((float*)(ws + WS_KMEAN))

    PH_BEGIN ph_prologue(C, args); PH_END
    PH_BEGIN ph_fold_reduce(C, (const float*)(ws + WS_GWP), (float*)(ws + WS_GW)); PH_END

    for (int l = 0; l < 4; ++l) {
        const int j = l >> 1;
        if ((l & 1) == 0) {
#define QKV ((bf16*)(ws + A_QKV))
#define MO ((bf16*)(ws + A_MO))
            PH_BEGIN { const pg8::Desc g = pg8::plain_desc(HN, (const bf16*)(ws + W_MQKV) + (size_t)j * 3 * DM * DM, NTOK, 3 * DM, DM);
                S.init(g.nM, g.nN, C.G, C.bid); pg8::EpiMobaQKV E{QKV, TABA, {FSTATS, GWV + (l == 0 ? CO_ID : CO_M1), BWV + (l == 0 ? CO_ID : CO_M1)}}; pg8::gemm_phase(C.lds, C.tid, g, S, E); } PH_END
            PH_BEGIN ph_kmean(C, QKV, KM); PH_END
            PH_BEGIN ph_moba_route(C, QKV, KM, (unsigned*)(ws + WS_CTL) + CW_CNT + j * 1024, (unsigned*)(ws + A_MLIST)); PH_END
            PH_BEGIN ph_moba_sel(C, QKV, (const unsigned*)(ws + WS_CTL) + CW_CNT + j * 1024, (const unsigned*)(ws + A_MLIST), (bf16*)(ws + A_MPO), (f32x2*)(ws + A_MPML)); PH_END
            PH_BEGIN ph_moba_own(C, QKV, (const bf16*)(ws + A_MPO), (const f32x2*)(ws + A_MPML), MO); PH_END
            PH_BEGIN { const pg8::Desc g = pg8::plain_desc(MO, (const bf16*)(ws + W_MO) + (size_t)j * DM * DM, NTOK, DM, DM);
                S.init(g.nM, g.nN, C.G, C.bid); pg8::EpiResLN E{args.in[0], HN, l == 0 ? nullptr : FSTATS, SPART, LNG(l == 0 ? 0 : 2 * l - 1), LNB(l == 0 ? 0 : 2 * l - 1), ALPHA, RED, C.tid, (unsigned*)(ws + WS_CTL) + CW_PANEL + (2 * l) * 4096, FSTATS};
                pg8::gemm_phase(C.lds, C.tid, g, S, E); } PH_END
        } else {
#define RQ ((bf16*)(ws + A_RQ))
#define RK ((bf16*)(ws + A_RK))
#define RKT ((bf16*)(ws + A_RKT))
#define RVT ((bf16*)(ws + A_RVT))
#define RG ((bf16*)(ws + A_RG))
#define RP ((bf16*)(ws + A_RP))
#define RU ((bf16*)(ws + A_RU))
#define RRT ((bf16*)(ws + A_RRT))
#define Wq ((const bf16*)(ws + W_RQ) + (size_t)j * DM * DM)
#define Wk ((const bf16*)(ws + W_RK) + (size_t)j * DM * DM)
#define Wv ((const bf16*)(ws + W_RV) + (size_t)j * 2 * DM * DM)
#define Wg ((const bf16*)(ws + W_RG) + (size_t)j * 2 * DM * DM)
            PH_BEGIN {
                SUB({ const pg8::Desc g = pg8::plain_desc(HN, Wq, NTOK, DM, DM); S.init(g.nM, g.nN, C.G, C.bid); pg8::EpiRopeNat256<false> E{RQ, DM, TABR, 1.0f, {FSTATS, GWV + CO_R + j * 12288, BWV + CO_R + j * 12288}, nullptr}; pg8::gemm_phase(C.lds, C.tid, g, S, E); })
                SUB({ const pg8::Desc g = pg8::plain_desc(HN, Wk, NTOK, DM, DM); S.init(g.nM, g.nN, C.G, C.bid); pg8::EpiRopeNat256<true> E{RK, DM, TABR, 0.0625f, {FSTATS, GWV + CO_R + j * 12288 + 2048, BWV + CO_R + j * 12288 + 2048}, RKT}; pg8::gemm_phase(C.lds, C.tid, g, S, E); })
                SUB({ const pg8::Desc g = pg8::plain_desc(HN, Wg, NTOK, 2 * DM, DM); S.init(g.nM, g.nN, C.G, C.bid); pg8::EpiAct<1, true> E{RG, 2 * DM, {FSTATS, GWV + CO_R + j * 12288 + 8192, BWV + CO_R + j * 12288 + 8192}}; pg8::gemm_phase(C.lds, C.tid, g, S, E); })
                SUB({ const pg8::Desc g = pg8::plain_desc(Wv, HN, 2 * DM, NTOK, DM); S.init(g.nM, g.nN, C.G, C.bid); pg8::EpiVT E{RVT, NTOK, {FSTATS, GWV + CO_R + j * 12288 + 4096, BWV + CO_R + j * 12288 + 4096}}; pg8::gemm_phase(C.lds, C.tid, g, S, E); })
            } PH_END
            PH_BEGIN {
                SUB({
                    pg8::Desc g; g.A = RQ; g.B = RK; g.A2 = RQ; g.B2 = RK; g.lda = DM; g.ldb = DM; g.sAm = 256L * DM; g.sAn = 256; g.sBm = 256L * DM; g.sBn = 256;
                    g.shAm = 0; g.shAn = 0; g.shBm = 0; g.shBn = 0; g.nM = NTOK / 256; g.nN = RH; g.nt = RDK / 64; g.nt1 = g.nt;
                    S.init(g.nM, g.nN, C.G, C.bid); pg8::EpiAct<2, false> E{RP, DM, {nullptr, nullptr, nullptr}}; pg8::gemm_phase(C.lds, C.tid, g, S, E); })
                SUB({
                    pg8::Desc g; g.A = RVT; g.B = RKT; g.A2 = RVT; g.B2 = RKT; g.lda = NTOK; g.ldb = NTOK; g.sAm = 256L * NTOK; g.sAn = 256; g.sBm = 256L * NTOK; g.sBn = 256;
                    g.shAm = 0; g.shAn = 0; g.shBm = 1; g.shBn = 0; g.nM = RH * RDV / 256; g.nN = NTOK / 256; g.nt = RL / 64; g.nt1 = g.nt;
                    S.init(g.nM, g.nN, C.G, C.bid); pg8::EpiBf16 E{RU, NTOK}; pg8::gemm_phase(C.lds, C.tid, g, S, E); })
            } PH_END
            PH_BEGIN ph_scan(C, RU, RRT); PH_END
            PH_BEGIN {
                pg8::Desc g; g.A = RP; g.A2 = RQ; g.B = RVT; g.B2 = RRT; g.lda = DM; g.ldb = NTOK; g.sAm = 256L * DM; g.sAn = 256; g.sBm = 256; g.sBn = 256L * NTOK;
                g.shAm = 0; g.shAn = 1; g.shBm = 0; g.shBn = 0; g.nM = NTOK / 256; g.nN = RH * RDV / 256; g.nt = 8; g.nt1 = 4;
                S.init(g.nM, g.nN, C.G, C.bid); pg8::EpiBf16 E{RU, 2 * DM}; pg8::gemm_phase(C.lds, C.tid, g, S, E); } PH_END
            PH_BEGIN ph_groupnorm(C, RU, RG); PH_END
            PH_BEGIN { const pg8::Desc g = pg8::plain_desc(RG, (const bf16*)(ws + W_RO) + (size_t)j * 2 * DM * DM, NTOK, DM, 2 * DM);
                S.init(g.nM, g.nN, C.G, C.bid); pg8::EpiResLN E{args.in[0], HN, FSTATS, SPART, LNG(2 * l - 1), LNB(2 * l - 1), ALPHA, RED, C.tid, (unsigned*)(ws + WS_CTL) + CW_PANEL + (2 * l) * 4096, FSTATS}; pg8::gemm_phase(C.lds, C.tid, g, S, E); } PH_END
        }
#define FU ((bf16*)(ws + A_U))
#define FA ((bf16*)(ws + A_FA))
        PH_BEGIN { const pg8::Desc g = pg8::plain_desc(HN, (const bf16*)(ws + W_FI) + (size_t)l * FF2 * DM, NTOK, FF2, DM);
            S.init(g.nM, g.nN, C.G, C.bid); pg8::EpiConv E{FA, FU, args.in[9] + (size_t)l * 3 * FF2, args.in[10] + (size_t)l * FF2, {FSTATS, GWV + CO_F + l * 11264, BWV + CO_F + l * 11264}};
            pg8::gemm_phase(C.lds, C.tid, g, S, E); } PH_END
        PH_BEGIN ph_conv_fix(C, FU, FA, args.in[9] + (size_t)l * 3 * FF2, args.in[10] + (size_t)l * FF2); PH_END
        PH_BEGIN { const pg8::Desc g = pg8::plain_desc(FA, (const bf16*)(ws + W_FO) + (size_t)l * FF * DM, NTOK, DM, FF);
            S.init(g.nM, g.nN, C.G, C.bid); pg8::EpiResLN E{args.in[0], HN, FSTATS, SPART, LNG(2 * l), LNB(2 * l), ALPHA, RED, C.tid, (unsigned*)(ws + WS_CTL) + CW_PANEL + (2 * l + 1) * 4096, FSTATS}; pg8::gemm_phase(C.lds, C.tid, g, S, E); } PH_END
    }
    PH_BEGIN ph_ln_final(C, HN, Hb, LNG(7), LNB(7)); PH_END
#undef PH_BEGIN
#undef PH_END
}
constexpr int N_PHASES = 2 + 2 * (6 + 3) + 2 * (6 + 3) + 1;

extern "C" void kernel_launch(void* const* d_in, const int* in_sizes, int n_in, void* d_out, int out_size, void* d_ws, size_t ws_size, hipStream_t stream) {
    static int grid = 0;
    if (grid == 0) {
        if (n_in != 14 || out_size != NTOK * DM || ws_size < WS_NEED) { fprintf(stderr, "kernel_launch: unexpected shapes (n_in %d out %d ws %zu)\n", n_in, out_size, ws_size); grid = -1; return; }
        int dev = 0, cus = 0, per_cu = 0;
        if (hipGetDevice(&dev) != hipSuccess || hipDeviceGetAttribute(&cus, hipDeviceAttributeMultiprocessorCount, dev) != hipSuccess) { grid = -1; return; }
        if (hipFuncSetAttribute((const void*)fwd, hipFuncAttributeMaxDynamicSharedMemorySize, LDS_BYTES) != hipSuccess) { fprintf(stderr, "kernel_launch: hipFuncSetAttribute failed\n"); grid = -1; return; }
        if (hipOccupancyMaxActiveBlocksPerMultiprocessor(&per_cu, (const void*)fwd, NWAVES * 64, LDS_BYTES) != hipSuccess || per_cu < 1)
            fprintf(stderr, "kernel_launch: occupancy query reports %d workgroups per CU\n", per_cu);
        (void)hipGetLastError();
        grid = cus;
    }
    if (grid < 0) return;
    (void)hipMemsetAsync((char*)d_ws + WS_CTL, 0, CTL_ZERO_BYTES, stream);
    Args a{};
    for (int i = 0; i < 14; ++i) a.in[i] = (const float*)d_in[i];
    a.out = (float*)d_out; a.ws = (unsigned char*)d_ws;
#if MK_ONE_LAUNCH
    a.ph_lo = 0; a.ph_hi = N_PHASES;
    hipLaunchKernelGGL(fwd, dim3(grid), dim3(NWAVES * 64), LDS_BYTES, stream, a);
#else
    for (int p = 0; p < N_PHASES; ++p) { a.ph_lo = p; a.ph_hi = p + 1; hipLaunchKernelGGL(fwd, dim3(grid), dim3(NWAVES * 64), LDS_BYTES, stream, a); }
#endif
}
```

```cpp
#include <hip/hip_runtime.h>
#include <cstdio>
#include <cstdint>

#ifndef MK_ONE_LAUNCH
#define MK_ONE_LAUNCH 1
#endif

#define GAS __attribute__((address_space(1)))
#define LAS __attribute__((address_space(3)))
typedef unsigned short bf16;
typedef float f32x4 __attribute__((ext_vector_type(4)));
typedef float f32x2 __attribute__((ext_vector_type(2)));
typedef unsigned u32x4 __attribute__((ext_vector_type(4)));
typedef unsigned u32x2 __attribute__((ext_vector_type(2)));
typedef short bf16x8 __attribute__((ext_vector_type(8)));

constexpr int NTOK = 16384, SEQ = 8192, DM = 2048;
constexpr int MH = 16, MHD = 128, MBLK = 256, MNB = 32;
constexpr int RH = 8, RDK = 256, RDV = 512, RL = 256;
constexpr int FF = 5632, FF2 = 11264;
constexpr float ALPHA = 1.681792830507429f;
constexpr float LN_EPS = 1e-5f, GN_EPS = 1e-5f;

__device__ const float INV_A[64] = {1.000000000e+00f, 8.659643531e-01f, 7.498942018e-01f, 6.493816376e-01f, 5.623413324e-01f, 4.869675338e-01f, 4.216965139e-01f, 3.651741147e-01f, 3.162277639e-01f, 2.738419771e-01f, 2.371373773e-01f, 2.053525001e-01f, 1.778279394e-01f, 1.539926529e-01f, 1.333521456e-01f, 1.154781953e-01f, 1.000000015e-01f, 8.659642935e-02f, 7.498942316e-02f, 6.493816525e-02f, 5.623413250e-02f, 4.869675264e-02f, 4.216964915e-02f, 3.651741147e-02f, 3.162277490e-02f, 2.738419548e-02f, 2.371373773e-02f, 2.053525113e-02f, 1.778279431e-02f, 1.539926510e-02f, 1.333521400e-02f, 1.154781971e-02f, 9.999999776e-03f, 8.659643121e-03f, 7.498942316e-03f, 6.493816152e-03f, 5.623413250e-03f, 4.869675264e-03f, 4.216964822e-03f, 3.651741194e-03f, 3.162277630e-03f, 2.738419687e-03f, 2.371373819e-03f, 2.053525066e-03f, 1.778279431e-03f, 1.539926510e-03f, 1.333521446e-03f, 1.154782018e-03f, 1.000000047e-03f, 8.659643354e-04f, 7.498941850e-04f, 6.493816036e-04f, 5.623413017e-04f, 4.869675322e-04f, 4.216965172e-04f, 3.651741135e-04f, 3.162277571e-04f, 2.738419571e-04f, 2.371373703e-04f, 2.053525095e-04f, 1.778279402e-04f, 1.539926598e-04f, 1.333521504e-04f, 1.154782003e-04f};
__device__ const float INV_R[128] = {1.000000000e+00f, 9.305720329e-01f, 8.659643531e-01f, 8.058421612e-01f, 7.498942018e-01f, 6.978305578e-01f, 6.493816376e-01f, 6.042963862e-01f, 5.623413324e-01f, 5.232990980e-01f, 4.869675338e-01f, 4.531583786e-01f, 4.216965139e-01f, 3.924189806e-01f, 3.651741147e-01f, 3.398208320e-01f, 3.162277639e-01f, 2.942727208e-01f, 2.738419771e-01f, 2.548296750e-01f, 2.371373773e-01f, 2.206734121e-01f, 2.053525001e-01f, 1.910952926e-01f, 1.778279394e-01f, 1.654817164e-01f, 1.539926529e-01f, 1.433012635e-01f, 1.333521456e-01f, 1.240937784e-01f, 1.154781953e-01f, 1.074607819e-01f, 1.000000015e-01f, 9.305720776e-02f, 8.659642935e-02f, 8.058422059e-02f, 7.498942316e-02f, 6.978306174e-02f, 6.493816525e-02f, 6.042964011e-02f, 5.623413250e-02f, 5.232991278e-02f, 4.869675264e-02f, 4.531583562e-02f, 4.216964915e-02f, 3.924189880e-02f, 3.651741147e-02f, 3.398208320e-02f, 3.162277490e-02f, 2.942727134e-02f, 2.738419548e-02f, 2.548296750e-02f, 2.371373773e-02f, 2.206734009e-02f, 2.053525113e-02f, 1.910953037e-02f, 1.778279431e-02f, 1.654817164e-02f, 1.539926510e-02f, 1.433012541e-02f, 1.333521400e-02f, 1.240937784e-02f, 1.154781971e-02f, 1.074607857e-02f, 9.999999776e-03f, 9.305720218e-03f, 8.659643121e-03f, 8.058422245e-03f, 7.498942316e-03f, 6.978305988e-03f, 6.493816152e-03f, 6.042963825e-03f, 5.623413250e-03f, 5.232991185e-03f, 4.869675264e-03f, 4.531583749e-03f, 4.216964822e-03f, 3.924189601e-03f, 3.651741194e-03f, 3.398208413e-03f, 3.162277630e-03f, 2.942727180e-03f, 2.738419687e-03f, 2.548296703e-03f, 2.371373819e-03f, 2.206734149e-03f, 2.053525066e-03f, 1.910952968e-03f, 1.778279431e-03f, 1.654817141e-03f, 1.539926510e-03f, 1.433012541e-03f, 1.333521446e-03f, 1.240937738e-03f, 1.154782018e-03f, 1.074607833e-03f, 1.000000047e-03f, 9.305720450e-04f, 8.659643354e-04f, 8.058421663e-04f, 7.498941850e-04f, 6.978305755e-04f, 6.493816036e-04f, 6.042963942e-04f, 5.623413017e-04f, 5.232990952e-04f, 4.869675322e-04f, 4.531583691e-04f, 4.216965172e-04f, 3.924189659e-04f, 3.651741135e-04f, 3.398208355e-04f, 3.162277571e-04f, 2.942727297e-04f, 2.738419571e-04f, 2.548296761e-04f, 2.371373703e-04f, 2.206734061e-04f, 2.053525095e-04f, 1.910952997e-04f, 1.778279402e-04f, 1.654817170e-04f, 1.539926598e-04f, 1.433012512e-04f, 1.333521504e-04f, 1.240937709e-04f, 1.154782003e-04f, 1.074607862e-04f};
__device__ __forceinline__ float log2g(int h) {
    const float t[8] = {-4.58036896131247886e-02f, -2.27200765000835289e-02f, -1.13153132278341461e-02f, -5.64656314114206186e-03f,
                        -2.82051906237866306e-03f, -1.40957025467135363e-03f, -7.04612976589372815e-04f, -3.52263471629021439e-04f};
    float r = t[0];
#pragma unroll
    for (int i = 1; i < 8; ++i) r = (h == i) ? t[i] : r;
    return r;
}

__device__ __forceinline__ float bflo(unsigned w) { return __uint_as_float(w << 16); }
__device__ __forceinline__ float bfhi(unsigned w) { return __uint_as_float(w & 0xffff0000u); }
__device__ __forceinline__ unsigned cvt_pk_bf16(float lo, float hi) { unsigned r; asm volatile("v_cvt_pk_bf16_f32 %0, %1, %2" : "=v"(r) : "v"(lo), "v"(hi)); return r; }
__device__ __forceinline__ float shx(float v, int mask, int lane) { return __builtin_bit_cast(float, __builtin_amdgcn_ds_bpermute((lane ^ mask) << 2, __builtin_bit_cast(int, v))); }
__device__ __forceinline__ float wave_sum(float v, int lane) {
#pragma unroll
    for (int o = 1; o < 64; o <<= 1) v += shx(v, o, lane);
    return v;
}
__device__ __forceinline__ float fast_exp2(float x) { return __builtin_amdgcn_exp2f(x); }
__device__ __forceinline__ float gelu_tanh(float x) {
    const float t = x * (-2.302208198f - 0.1029432397f * x * x);
    return x * __builtin_amdgcn_rcpf(1.0f + fast_exp2(t));
}
__device__ __forceinline__ float silu(float x) { return x * __builtin_amdgcn_rcpf(1.0f + fast_exp2(-x * 1.4426950408889634f)); }
__device__ __forceinline__ void sincos_acc(float angf, float& s, float& c) {
    const double a = (double)angf;
    const double k = __builtin_rint(a * 0.63661977236758134308);
    double r = __builtin_fma(-k, 1.57079632679489655800e+00, a);
    r = __builtin_fma(-k, 6.12323399573676603587e-17, r);
    const double r2 = r * r;
    double sp = 1.0 / 6227020800.0;
    sp = sp * r2 - 1.0 / 39916800.0; sp = sp * r2 + 1.0 / 362880.0; sp = sp * r2 - 1.0 / 5040.0; sp = sp * r2 + 1.0 / 120.0; sp = sp * r2 - 1.0 / 6.0; sp = sp * r2 + 1.0;
    const double sn = sp * r;
    double cp = -1.0 / 87178291200.0;
    cp = cp * r2 + 1.0 / 479001600.0; cp = cp * r2 - 1.0 / 3628800.0; cp = cp * r2 + 1.0 / 40320.0; cp = cp * r2 - 1.0 / 720.0; cp = cp * r2 + 1.0 / 24.0; cp = cp * r2 - 0.5; cp = cp * r2 + 1.0;
    const int q = ((int)k) & 3;
    const double ss = (q & 1) ? cp : sn, cc = (q & 1) ? sn : cp;
    s = (float)((q & 2) ? -ss : ss);
    c = (float)(((q + 1) & 2) ? -cc : cc);
}

namespace pg8 {
constexpr int BM = 256, BK = 64, HALF = 128, HTB = HALF * BK * 2, STAGE_BYTES = 8 * HTB, NXCD = 8, WGM = 8;
__host__ __device__ __forceinline__ int lds_byte(int r, int c) { const int st = (r >> 4) * 2 + (c >> 5), rr = r & 15, cc = c & 31, ob = rr * 64 + cc * 2; return st * 1024 + (ob ^ (((ob >> 9) & 1) << 5)); }
__host__ __device__ __forceinline__ void stage_rc(int b, int& R, int& C) { const int st = b / 1024, sb = b % 1024, swz = sb ^ (((sb >> 9) & 1) << 5); R = (st >> 1) * 16 + swz / 64; C = (st & 1) * 32 + (swz % 64) / 2; }
__host__ __device__ __forceinline__ int perm32(int rho) { const int n = rho >> 4, i = rho & 15; return 8 * (i >> 2) + 4 * n + (i & 3); }

struct Unit { int pm, pn; };
struct Desc {
    const bf16* A; const bf16* B; const bf16* A2; const bf16* B2;
    long lda, ldb, sAm, sAn, sBm, sBn;
    int shAm, shAn, shBm, shBn;
    int nM, nN, nt, nt1;
};
__host__ __device__ inline Desc plain_desc(const bf16* A, const bf16* Bt, int M, int N, int K) {
    Desc d; d.A = A; d.B = Bt; d.A2 = A; d.B2 = Bt; d.lda = K; d.ldb = K; d.sAm = 256L * K; d.sAn = 0; d.sBm = 0; d.sBn = 256L * K;
    d.shAm = 0; d.shAn = 0; d.shBm = 0; d.shBn = 0; d.nM = M / 256; d.nN = N / 256; d.nt = K / 64; d.nt1 = K / 64; return d;
}
struct StaticOrder {
    int nM, nN, nwg, G, c;
    __device__ void init(int nM_, int nN_, int G_, int c_) { nM = nM_; nN = nN_; nwg = nM * nN; G = G_; c = c_; }
    __device__ bool next(int i, Unit& u) const {
        const int L = i * G + c; if (L >= nwg) return false;
        const int wgid = (L & (NXCD - 1)) * (nwg >> 3) + (L >> 3);
        const int nig = WGM * nN, gid = wgid / nig, rem = wgid - gid * nig;
        u.pm = gid * WGM + (rem & (WGM - 1)); u.pn = rem >> 3; return true;
    }
};

__device__ __forceinline__ float row16_sum(float v) {
    v += __builtin_bit_cast(float, __builtin_amdgcn_update_dpp(0, __builtin_bit_cast(int, v), 0xB1, 0xf, 0xf, true));
    v += __builtin_bit_cast(float, __builtin_amdgcn_update_dpp(0, __builtin_bit_cast(int, v), 0x4E, 0xf, 0xf, true));
    v += __builtin_bit_cast(float, __builtin_amdgcn_update_dpp(0, __builtin_bit_cast(int, v), 0x141, 0xf, 0xf, true));
    v += __builtin_bit_cast(float, __builtin_amdgcn_update_dpp(0, __builtin_bit_cast(int, v), 0x140, 0xf, 0xf, true));
    return v;
}
template <class T> __device__ __forceinline__ T ldo(const void* b, unsigned off) { return *(const T*)((const char*)b + off); }
template <class T> __device__ __forceinline__ void sto(void* b, unsigned off, T v) { *(T*)((char*)b + off) = v; }
#define ACC8(ai, bj, m, e) acc[ai][bj][m][(e) >> 2][(e) & 3]
__device__ __forceinline__ u32x4 pack8(const float (&x)[8]) { u32x4 w; w.x = cvt_pk_bf16(x[0], x[1]); w.y = cvt_pk_bf16(x[2], x[3]); w.z = cvt_pk_bf16(x[4], x[5]); w.w = cvt_pk_bf16(x[6], x[7]); return w; }
struct EpiBf16 {
    static constexpr bool PERM = true;
    bf16* O; unsigned ldc;
    __device__ __forceinline__ void operator()(f32x4 (&acc)[2][2][4][2], const Unit& u, int wr, int wc, int fr, int fq) const {
        const unsigned o0 = ((unsigned)(u.pm * BM + wr * 64 + fr) * ldc + (unsigned)(u.pn * BM + wc * 32 + 8 * fq)) * 2u;
#pragma unroll
        for (int ai = 0; ai < 2; ++ai)
#pragma unroll
            for (int m = 0; m < 4; ++m) { const unsigned o = o0 + (unsigned)(ai * HALF + m * 16) * ldc * 2u;
#pragma unroll
                for (int bj = 0; bj < 2; ++bj) { float x[8];
#pragma unroll
                    for (int e = 0; e < 8; ++e) x[e] = ACC8(ai, bj, m, e);
                    sto<u32x4>(O, o + bj * HALF * 2, pack8(x)); } }
    }
};

struct LnFold { const f32x2* stats; const float* gw; const float* bw; };
__device__ __forceinline__ void ln_row_stats(const f32x2* fstats, unsigned off  , float& r, float& rmu) { const f32x2 v = ldo<f32x2>(fstats, off); r = v.x; rmu = v.y; }
__device__ __forceinline__ void ln_correct_nat(f32x4 (&acc)[2][2][4][2], const LnFold& ln, const Unit& u, int wr, int wc, int fr, int fq) {
    __builtin_amdgcn_sched_barrier(0);
    const unsigned so0 = (unsigned)(u.pm * BM + wr * 64 + fr) * 8u, co0 = (unsigned)(u.pn * BM + wc * 32 + 8 * fq) * 4u;
    f32x2 st[8]; f32x4 gb[2][4];
#pragma unroll
    for (int i = 0; i < 8; ++i) st[i] = ldo<f32x2>(ln.stats, so0 + ((i >> 2) * HALF + (i & 3) * 16) * 8);
#pragma unroll
    for (int bj = 0; bj < 2; ++bj) { gb[bj][0] = ldo<f32x4>(ln.gw, co0 + bj * HALF * 4); gb[bj][1] = ldo<f32x4>(ln.gw, co0 + bj * HALF * 4 + 16); gb[bj][2] = ldo<f32x4>(ln.bw, co0 + bj * HALF * 4); gb[bj][3] = ldo<f32x4>(ln.bw, co0 + bj * HALF * 4 + 16); }
    __builtin_amdgcn_sched_barrier(0);
#pragma unroll
    for (int bj = 0; bj < 2; ++bj) {
        float gw[8], bw[8];
#pragma unroll
        for (int e = 0; e < 4; ++e) { gw[e] = gb[bj][0][e]; gw[4 + e] = gb[bj][1][e]; bw[e] = gb[bj][2][e]; bw[4 + e] = gb[bj][3][e]; }
#pragma unroll
        for (int ai = 0; ai < 2; ++ai)
#pragma unroll
            for (int m = 0; m < 4; ++m) { const float r = st[ai * 4 + m].x, rmu = st[ai * 4 + m].y;
#pragma unroll
                for (int e = 0; e < 8; ++e) ACC8(ai, bj, m, e) = ACC8(ai, bj, m, e) * r - rmu * gw[e] + bw[e]; }
        __builtin_amdgcn_sched_barrier(0);
    }
}
__device__ __forceinline__ void ln_correct_swp(f32x4 (&acc)[2][2][4][2], const LnFold& ln, const Unit& u, int wr, int wc, int fr, int fq) {
    __builtin_amdgcn_sched_barrier(0);
    const unsigned ro0 = (unsigned)(u.pm * BM + wr * 64 + fr) * 4u, so0 = (unsigned)(u.pn * BM + wc * 32 + 8 * fq) * 8u;
    float r[2][8], rmu[2][8];
#pragma unroll
    for (int bj = 0; bj < 2; ++bj)
#pragma unroll
        for (int q = 0; q < 4; ++q) { const f32x4 v = ldo<f32x4>(ln.stats, so0 + bj * HALF * 8 + q * 16); r[bj][2 * q] = v[0]; rmu[bj][2 * q] = v[1]; r[bj][2 * q + 1] = v[2]; rmu[bj][2 * q + 1] = v[3]; }
    float g8[8], b8[8];
#pragma unroll
    for (int i = 0; i < 8; ++i) { g8[i] = ldo<float>(ln.gw, ro0 + ((i >> 2) * HALF + (i & 3) * 16) * 4); b8[i] = ldo<float>(ln.bw, ro0 + ((i >> 2) * HALF + (i & 3) * 16) * 4); }
#pragma unroll
    for (int ai = 0; ai < 2; ++ai)
#pragma unroll
        for (int m = 0; m < 4; ++m) { const float g = g8[ai * 4 + m], b = b8[ai * 4 + m];
#pragma unroll
            for (int bj = 0; bj < 2; ++bj)
#pragma unroll
                for (int e = 0; e < 8; ++e) ACC8(ai, bj, m, e) = ACC8(ai, bj, m, e) * r[bj][e] - rmu[bj][e] * g + b; }
    __builtin_amdgcn_sched_barrier(0);
}
struct EpiResLN {
    static constexpr bool PERM = true;
    const float* Xin; bf16* TN; const f32x2* stats_in; f32x2* stats_out; const float* g; const float* b; float alpha; LAS f32x2* red; int tid; unsigned* pcnt; f32x2* fs_out;
    __device__ __forceinline__ void operator()(f32x4 (&acc)[2][2][4][2], const Unit& u, int wr, int wc, int fr, int fq) const {
        const unsigned row0 = (unsigned)(u.pm * BM + wr * 64 + fr), col0 = (unsigned)(u.pn * BM + wc * 32 + 8 * fq); const bool first = stats_in == nullptr;
        float gv[2][8], bv[2][8];
#pragma unroll
        for (int bj = 0; bj < 2; ++bj)
#pragma unroll
            for (int e = 0; e < 8; ++e) { gv[bj][e] = 1.f; bv[bj][e] = 0.f; }
        if (!first) {
#pragma unroll
            for (int bj = 0; bj < 2; ++bj) { const unsigned co = (col0 + bj * HALF) * 4u; const f32x4 g0 = ldo<f32x4>(g, co), g1 = ldo<f32x4>(g, co + 16), b0 = ldo<f32x4>(b, co), b1 = ldo<f32x4>(b, co + 16);
#pragma unroll
                for (int e = 0; e < 4; ++e) { gv[bj][e] = g0[e]; gv[bj][4 + e] = g1[e]; bv[bj][e] = b0[e]; bv[bj][4 + e] = b1[e]; } } }
        u32x4 q0[8], q1[8]; f32x2 qs[8];
#define RL_LOAD(i) do { const unsigned row_ = row0 + (unsigned)(((i) >> 2) * HALF + ((i) & 3) * 16); const unsigned eo_ = row_ * DM + col0; \
            q0[i] = ldo<u32x4>(TN, eo_ * 2u); q1[i] = ldo<u32x4>(TN, (eo_ + HALF) * 2u); qs[i] = ldo<f32x2>(stats_in, row_ * 8u); } while (0)
        if (!first) { RL_LOAD(0); RL_LOAD(1); }
#pragma unroll
        for (int i = 0; i < 8; ++i) { const int ai = i >> 2, m = i & 3; const unsigned row = row0 + ai * HALF + m * 16; float r = 1.f, rmu = 0.f;
                if (!first) { if (i + 2 < 8) RL_LOAD(i + 2); r = qs[i].x; rmu = qs[i].y; }
                float sm = 0.f, sq = 0.f;
#pragma unroll
                for (int bj = 0; bj < 2; ++bj) { const unsigned eo = row * DM + col0 + bj * HALF; float to[8];
                    if (first) { const f32x4 t0 = ldo<f32x4>(Xin, eo * 4u), t1 = ldo<f32x4>(Xin, eo * 4u + 16);
#pragma unroll
                        for (int e = 0; e < 4; ++e) { to[e] = t0[e]; to[4 + e] = t1[e]; } }
                    else { const u32x4 tw = bj ? q1[i] : q0[i];
#pragma unroll
                        for (int q = 0; q < 4; ++q) { to[2 * q] = bflo(tw[q]); to[2 * q + 1] = bfhi(tw[q]); } }
                    float tn[8];
#pragma unroll
                    for (int e = 0; e < 8; ++e) { const float h = (to[e] * r - rmu) * gv[bj][e] + bv[bj][e];
                        const float v = alpha * h + ACC8(ai, bj, m, e); tn[e] = v; sm += v; sq += v * v; }
                    sto<u32x4>(TN, eo * 2u, pack8(tn)); }
                { const int ln_ = fq * 16 + fr; sm += shx(sm, 16, ln_); sm += shx(sm, 32, ln_); sq += shx(sq, 16, ln_); sq += shx(sq, 32, ln_); }
                if (fq == 0) red[(ai * HALF + wr * 64 + m * 16 + fr) * 4 + wc] = (f32x2){sm, sq}; asm volatile("" ::: "memory"); }
#undef RL_LOAD
        asm volatile("s_waitcnt lgkmcnt(0)" ::: "memory"); __builtin_amdgcn_s_barrier(); asm volatile("" ::: "memory");
        if (tid < 256) { const f32x2 a = red[tid * 4 + 0], b2 = red[tid * 4 + 1], c = red[tid * 4 + 2], d = red[tid * 4 + 3];
            const float S = (a.x + b2.x) + (c.x + d.x), Q = (a.y + b2.y) + (c.y + d.y);
            __hip_atomic_store((unsigned long long*)(stats_out + (size_t)(u.pm * BM + tid) * 8 + u.pn), ((unsigned long long)__float_as_uint(Q) << 32) | __float_as_uint(S), __ATOMIC_RELAXED, __HIP_MEMORY_SCOPE_AGENT); }
        asm volatile("s_waitcnt vmcnt(0)" ::: "memory"); __builtin_amdgcn_s_barrier(); asm volatile("" ::: "memory");
        LAS unsigned* flag = (LAS unsigned*)(red + 1024);
        if (tid == 0) { const unsigned old = __hip_atomic_fetch_add(pcnt + 64 * u.pm, 1u, __ATOMIC_RELAXED, __HIP_MEMORY_SCOPE_AGENT); flag[0] = (old == 7u) ? 1u : 0u; }
        asm volatile("s_waitcnt vmcnt(0) lgkmcnt(0)" ::: "memory"); __builtin_amdgcn_s_barrier(); asm volatile("" ::: "memory");
        if (flag[0] != 0u) {
            __builtin_amdgcn_fence(__ATOMIC_ACQUIRE, "agent"); asm volatile("s_waitcnt vmcnt(0)" ::: "memory");
            if (tid < 256) { const unsigned long long* p = (const unsigned long long*)(stats_out + (size_t)(u.pm * BM + tid) * 8); float S = 0.f, Q = 0.f;
                u32x4 w4[4];
                asm volatile("global_load_dwordx4 %0, %4, off sc1\n\tglobal_load_dwordx4 %1, %4, off offset:16 sc1\n\tglobal_load_dwordx4 %2, %4, off offset:32 sc1\n\tglobal_load_dwordx4 %3, %4, off offset:48 sc1\n\ts_waitcnt vmcnt(0)"
                             : "=&v"(w4[0]), "=&v"(w4[1]), "=&v"(w4[2]), "=&v"(w4[3]) : "v"(p) : "memory");
#pragma unroll
                for (int t = 0; t < 4; ++t) { S += __uint_as_float(w4[t].x) + __uint_as_float(w4[t].z); Q += __uint_as_float(w4[t].y) + __uint_as_float(w4[t].w); }
                const float mu = S * (1.0f / DM), var = Q * (1.0f / DM) - mu * mu, r = 1.0f / sqrtf(var + LN_EPS); fs_out[u.pm * BM + tid] = (f32x2){r, r * mu}; }
        }
    }
};
struct EpiMobaQKV {
    static constexpr bool PERM = true;
    bf16* O; const f32x2* tab; LnFold ln;
    __device__ __forceinline__ void operator()(f32x4 (&acc)[2][2][4][2], const Unit& u, int wr, int wc, int fr, int fq) const {
        ln_correct_nat(acc, ln, u, wr, wc, fr, fq);
        const int which = u.pn >> 3, hh = wc >> 1, i0 = 32 * (wc & 1) + 8 * fq;
        const unsigned row0 = (unsigned)(u.pm * BM + wr * 64 + fr);
        const unsigned o0 = (row0 * (3 * DM) + (unsigned)(u.pn * BM + hh * 128 + i0)) * 2u, t0 = ((row0 & (SEQ - 1)) * 64 + i0) * 8u;
        const float scale = which == 0 ? 0.08838834764831845f : 1.0f; const bool rope = which < 2;
#pragma unroll
        for (int ai = 0; ai < 2; ++ai)
#pragma unroll
            for (int m = 0; m < 4; ++m) { const unsigned to = t0 + (ai * HALF + m * 16) * (64 * 8);
#pragma unroll
                for (int q = 0; q < 4; ++q) { f32x4 t = ldo<f32x4>(tab, to + q * 16);
                    t[0] = rope ? t[0] : 1.f; t[1] = rope ? t[1] : 0.f; t[2] = rope ? t[2] : 1.f; t[3] = rope ? t[3] : 0.f;
                    const float a0 = ACC8(ai, 0, m, 2 * q), b0 = ACC8(ai, 1, m, 2 * q), a1 = ACC8(ai, 0, m, 2 * q + 1), b1 = ACC8(ai, 1, m, 2 * q + 1);
                    ACC8(ai, 0, m, 2 * q) = (a0 * t[0] - b0 * t[1]) * scale; ACC8(ai, 1, m, 2 * q) = (a0 * t[1] + b0 * t[0]) * scale;
                    ACC8(ai, 0, m, 2 * q + 1) = (a1 * t[2] - b1 * t[3]) * scale; ACC8(ai, 1, m, 2 * q + 1) = (a1 * t[3] + b1 * t[2]) * scale; }
                if (m & 1) asm volatile("" ::: "memory"); }
        __builtin_amdgcn_sched_barrier(0);
#pragma unroll
        for (int ai = 0; ai < 2; ++ai)
#pragma unroll
            for (int m = 0; m < 4; ++m) { const unsigned o = o0 + (ai * HALF + m * 16) * (3 * DM * 2); float x1[8], x2[8];
#pragma unroll
                for (int e = 0; e < 8; ++e) { x1[e] = ACC8(ai, 0, m, e); x2[e] = ACC8(ai, 1, m, e); }
                sto<u32x4>(O, o, pack8(x1)); sto<u32x4>(O, o + 128, pack8(x2)); }
    }
};
template <bool DUALT> struct EpiRopeNat256 {
    static constexpr bool PERM = true;
    bf16* O; unsigned ldc; const f32x2* tab; float scale; LnFold ln; bf16* OT;
    __device__ __forceinline__ void operator()(f32x4 (&acc)[2][2][4][2], const Unit& u, int wr, int wc, int fr, int fq) const {
        ln_correct_nat(acc, ln, u, wr, wc, fr, fq);
        const int i0 = 32 * wc + 8 * fq; const unsigned row0 = (unsigned)(u.pm * BM + wr * 64 + fr);
        const unsigned o0 = (row0 * ldc + (unsigned)(u.pn * BM + i0)) * 2u, t0 = ((row0 & (SEQ - 1)) * 128 + i0) * 8u;
        f32x4 tb[8][4];
#define RT_LOAD(i) do { const unsigned to_ = t0 + (unsigned)(((i) >> 2) * HALF + ((i) & 3) * 16) * (128 * 8); _Pragma("unroll") for (int q_ = 0; q_ < 4; ++q_) tb[i][q_] = ldo<f32x4>(tab, to_ + q_ * 16); } while (0)
        RT_LOAD(0); RT_LOAD(1);
#pragma unroll
        for (int i = 0; i < 8; ++i) { const int ai = i >> 2, m = i & 3; if (i + 2 < 8) RT_LOAD(i + 2);
            { const unsigned o = o0 + (ai * HALF + m * 16) * ldc * 2u; float x1[8], x2[8];
#pragma unroll
                for (int q = 0; q < 4; ++q) { const f32x4 t = tb[i][q];
                    const float a0 = ACC8(ai, 0, m, 2 * q), b0 = ACC8(ai, 1, m, 2 * q), a1 = ACC8(ai, 0, m, 2 * q + 1), b1 = ACC8(ai, 1, m, 2 * q + 1);
                    x1[2 * q] = (a0 * t[0] - b0 * t[1]) * scale; x2[2 * q] = (a0 * t[1] + b0 * t[0]) * scale; x1[2 * q + 1] = (a1 * t[2] - b1 * t[3]) * scale; x2[2 * q + 1] = (a1 * t[3] + b1 * t[2]) * scale; }
                const u32x4 p1 = pack8(x1), p2 = pack8(x2);
                sto<u32x4>(O, o, p1); sto<u32x4>(O, o + HALF * 2, p2);
                if (DUALT) { const unsigned t0o = (((unsigned)(u.pn * BM + i0)) * NTOK + row0 + ai * HALF + m * 16) * 2u;
#pragma unroll
                    for (int q = 0; q < 4; ++q) { sto<unsigned short>(OT, t0o + (2 * q) * (NTOK * 2), (unsigned short)(p1[q] & 0xffffu)); sto<unsigned short>(OT, t0o + (2 * q + 1) * (NTOK * 2), (unsigned short)(p1[q] >> 16));
                        sto<unsigned short>(OT, t0o + (HALF + 2 * q) * (NTOK * 2), (unsigned short)(p2[q] & 0xffffu)); sto<unsigned short>(OT, t0o + (HALF + 2 * q + 1) * (NTOK * 2), (unsigned short)(p2[q] >> 16)); } }
                if (m & 1) asm volatile("" ::: "memory"); } }
#undef RT_LOAD
    }
};
struct EpiVT {
    static constexpr bool PERM = true;
    bf16* O; unsigned ldc; LnFold ln;
    __device__ __forceinline__ void operator()(f32x4 (&acc)[2][2][4][2], const Unit& u, int wr, int wc, int fr, int fq) const {
        ln_correct_swp(acc, ln, u, wr, wc, fr, fq);
        const unsigned o0 = ((unsigned)(u.pm * BM + wr * 64 + fr) * ldc + (unsigned)(u.pn * BM + wc * 32 + 8 * fq)) * 2u; const float l2 = log2g(u.pm >> 1);
        float sc[2][8];
#pragma unroll
        for (int bj = 0; bj < 2; ++bj)
#pragma unroll
            for (int e = 0; e < 8; ++e) sc[bj][e] = fast_exp2(-(float)(bj * HALF + wc * 32 + 8 * fq + e + 1) * l2);
#pragma unroll
        for (int ai = 0; ai < 2; ++ai)
#pragma unroll
            for (int m = 0; m < 4; ++m) { const unsigned o = o0 + (unsigned)(ai * HALF + m * 16) * ldc * 2u;
#pragma unroll
                for (int bj = 0; bj < 2; ++bj) { float x[8];
#pragma unroll
                    for (int e = 0; e < 8; ++e) x[e] = ACC8(ai, bj, m, e) * sc[bj][e];
                    sto<u32x4>(O, o + bj * HALF * 2, pack8(x)); } }
    }
};
template <int ACT, bool LN> struct EpiAct {
    static constexpr bool PERM = true;
    bf16* O; unsigned ldc; LnFold ln;
    __device__ __forceinline__ void operator()(f32x4 (&acc)[2][2][4][2], const Unit& u, int wr, int wc, int fr, int fq) const {
        if (LN) ln_correct_nat(acc, ln, u, wr, wc, fr, fq);
        const unsigned o0 = ((unsigned)(u.pm * BM + wr * 64 + fr) * ldc + (unsigned)(u.pn * BM + wc * 32 + 8 * fq)) * 2u;
#pragma unroll
        for (int ai = 0; ai < 2; ++ai)
#pragma unroll
            for (int m = 0; m < 4; ++m) { const unsigned o = o0 + (unsigned)(ai * HALF + m * 16) * ldc * 2u; const int rl = ai * HALF + wr * 64 + m * 16 + fr;
#pragma unroll
                for (int bj = 0; bj < 2; ++bj) { float x[8];
#pragma unroll
                    for (int e = 0; e < 8; ++e) { float v = ACC8(ai, bj, m, e);
                        if (ACT == 1) v = silu(v);
                        if (ACT == 2) v = (bj * HALF + wc * 32 + 8 * fq + e <= rl) ? v : 0.f;
                        x[e] = v; }
                    sto<u32x4>(O, o + bj * HALF * 2, pack8(x)); } }
    }
};
struct EpiConv {
    static constexpr bool PERM = true;
    bf16* A; bf16* UH; const float* cw; const float* cb; LnFold ln;
    static __device__ __forceinline__ float conv1(float curf, float prvf, bool has_prev, int fr, float b, float w0, float w1, float w2) {
        const int cur = __builtin_bit_cast(int, curf), prv = __builtin_bit_cast(int, prvf); int r1 = 0, r2 = 0;
        if (has_prev) { r1 = __builtin_amdgcn_update_dpp(0, prv, 0x121, 0xf, 0xf, false); r2 = __builtin_amdgcn_update_dpp(0, prv, 0x122, 0xf, 0xf, false); }
        const int p1 = __builtin_amdgcn_update_dpp(r1, cur, 0x111, 0xf, 0xf, false), p2 = __builtin_amdgcn_update_dpp(r2, cur, 0x112, 0xf, 0xf, false);
        (void)fr;
        return b + w0 * __builtin_bit_cast(float, p2) + w1 * __builtin_bit_cast(float, p1) + w2 * curf;
    }
    __device__ __forceinline__ void operator()(f32x4 (&acc)[2][2][4][2], const Unit& u, int wr, int wc, int fr, int fq) const {
        ln_correct_nat(acc, ln, u, wr, wc, fr, fq);
        const unsigned cn = (unsigned)(u.pn * 128 + wc * 32 + 8 * fq);
#pragma unroll
        for (int ai = 0; ai < 2; ++ai) { const unsigned g4 = ((unsigned)u.pm * 4 + ai * 2 + wr) * 4u;
#pragma unroll
            for (int bj = 0; bj < 2; ++bj) { float x0[8], x3[8];
#pragma unroll
                for (int e = 0; e < 8; ++e) { x0[e] = ACC8(ai, bj, 0, e); x3[e] = ACC8(ai, bj, 3, e); }
                if (fr >= 14) sto<u32x4>(UH, ((g4 + (fr - 14)) * FF2 + bj * FF + cn) * 2u, pack8(x3));
                if (fr < 2) sto<u32x4>(UH, ((g4 + 2 + fr) * FF2 + bj * FF + cn) * 2u, pack8(x0)); } }
        __builtin_amdgcn_sched_barrier(0);
        unsigned ow[2][4][4];
        f32x2 cg0[4], cg1[4], cg2[4], cgb[4], cv0[4], cv1[4], cv2[4], cvb[4];
#pragma unroll
        for (int ep = 0; ep < 4; ++ep) { const unsigned co = (cn + 2 * ep) * 4u;
            cg0[ep] = ldo<f32x2>(cw, co); cg1[ep] = ldo<f32x2>(cw, co + FF2 * 4); cg2[ep] = ldo<f32x2>(cw, co + 2 * FF2 * 4); cgb[ep] = ldo<f32x2>(cb, co);
            cv0[ep] = ldo<f32x2>(cw, co + FF * 4); cv1[ep] = ldo<f32x2>(cw, co + (FF2 + FF) * 4); cv2[ep] = ldo<f32x2>(cw, co + (2 * FF2 + FF) * 4); cvb[ep] = ldo<f32x2>(cb, co + FF * 4); }
        __builtin_amdgcn_sched_barrier(0);
#pragma unroll
        for (int ep = 0; ep < 4; ++ep) {
#pragma unroll
            for (int ai = 0; ai < 2; ++ai)
#pragma unroll
                for (int m = 3; m >= 0; --m) { float r[2];
#pragma unroll
                    for (int hl = 0; hl < 2; ++hl) { const int e = 2 * ep + hl;
                        const float cg = conv1(ACC8(ai, 0, m, e), m > 0 ? ACC8(ai, 0, m > 0 ? m - 1 : 0, e) : 0.f, m > 0, fr, cgb[ep][hl], cg0[ep][hl], cg1[ep][hl], cg2[ep][hl]);
                        const float cv = conv1(ACC8(ai, 1, m, e), m > 0 ? ACC8(ai, 1, m > 0 ? m - 1 : 0, e) : 0.f, m > 0, fr, cvb[ep][hl], cv0[ep][hl], cv1[ep][hl], cv2[ep][hl]);
                        r[hl] = gelu_tanh(cg) * cv; }
                    ow[ai][m][ep] = cvt_pk_bf16(r[0], r[1]); }
            __builtin_amdgcn_sched_barrier(0);
        }
        const unsigned o0 = ((unsigned)(u.pm * BM + wr * 64 + fr) * FF + cn) * 2u;
#pragma unroll
        for (int ai = 0; ai < 2; ++ai)
#pragma unroll
            for (int m = 0; m < 4; ++m)
                if (m > 0 || fr >= 2) sto<u32x4>(A, o0 + (unsigned)(ai * HALF + m * 16) * (FF * 2), (u32x4){ow[ai][m][0], ow[ai][m][1], ow[ai][m][2], ow[ai][m][3]});
    }
};
#undef ACC8
template <class Epi>
__device__ __forceinline__ void gemm_phase(LAS unsigned char* lds, const int tid, const Desc g, const StaticOrder& S, const Epi& E) {
    const int wid = __builtin_amdgcn_readfirstlane(tid >> 6), lane = tid & 63, wr = wid >> 2, wc = wid & 3, fr = lane & 15, fq = lane >> 4;
    const int nt = g.nt, nt1 = g.nt1;
    unsigned voffA[2], voffB[2];
#pragma unroll
    for (int i = 0; i < 2; ++i) { int R, C; stage_rc(tid * 16 + i * 8192, R, C); const int Rb = Epi::PERM ? ((R & ~31) + perm32(R & 31)) : R;
        voffA[i] = (unsigned)(R * g.lda + C) * 2u; voffB[i] = (unsigned)(Rb * g.ldb + C) * 2u; }
    const size_t kstep = (size_t)(BK * 2);
    const size_t hstepA = (size_t)HALF * g.lda * 2, hstepB = (size_t)HALF * g.ldb * 2;
    const unsigned ldsw = (unsigned)wid * 1024u;
    const int aoff = lds_byte(wr * 64 + fr, fq * 8), boff = lds_byte(wc * 32 + fr, fq * 8);
#define PG8_SA(b, h) (((b) * 2 + (h)) * HTB)
#define PG8_SB(b, h) ((4 + (b) * 2 + (h)) * HTB)
#define PG8_STAGE(bufoff, gbase, voff) do { _Pragma("unroll") for (int _i = 0; _i < 2; ++_i) { unsigned keep_; \
        asm volatile("s_mov_b32 %0, m0\n\ts_mov_b32 m0, %3\n\ts_nop 0\n\tglobal_load_lds_dwordx4 %1, %2\n\ts_mov_b32 m0, %0" : "=&s"(keep_) \
                     : "v"((voff)[_i]), "s"((unsigned long long)(uintptr_t)(gbase)), "s"((unsigned)(uintptr_t)(lds + (bufoff) + ldsw + _i * 8192)) : "memory"); } } while (0)
#define PG8_LDA(dst, b, h) do { _Pragma("unroll") for (int m = 0; m < 4; ++m) _Pragma("unroll") for (int k = 0; k < 2; ++k) dst[m][k] = *(const LAS bf16x8*)(lds + PG8_SA(b, h) + aoff + m * 2048 + k * 1024); } while (0)
#define PG8_LDB(dst, b, h) do { _Pragma("unroll") for (int n = 0; n < 2; ++n) _Pragma("unroll") for (int k = 0; k < 2; ++k) dst[n][k] = *(const LAS bf16x8*)(lds + PG8_SB(b, h) + boff + n * 2048 + k * 1024); } while (0)
#define PG8_MMA(ai, bj, At, Bt) do { __builtin_amdgcn_s_setprio(1); _Pragma("unroll") for (int m = 0; m < 4; ++m) _Pragma("unroll") for (int n = 0; n < 2; ++n) _Pragma("unroll") for (int k = 0; k < 2; ++k) \
        acc[ai][bj][m][n] = __builtin_amdgcn_mfma_f32_16x16x32_bf16(Bt[n][k], At[m][k], acc[ai][bj][m][n], 0, 0, 0); __builtin_amdgcn_s_setprio(0); } while (0)
#define PG8_WAIT_V(n) asm volatile("s_waitcnt vmcnt(" #n ")" ::: "memory")
#define PG8_WAIT_L(n) asm volatile("s_waitcnt lgkmcnt(" #n ")" ::: "memory")
#define PG8_BAR __builtin_amdgcn_s_barrier()
#define PG8_SCHED __builtin_amdgcn_sched_barrier(0)
#define PG8_PTRS(u, pa, pb) do { const long oa_ = (long)((u).pm >> g.shAm) * g.sAm + (long)((u).pn >> g.shAn) * g.sAn, ob_ = (long)((u).pm >> g.shBm) * g.sBm + (long)((u).pn >> g.shBn) * g.sBn; \
        pa = (const char*)(g.A + oa_); pb = (const char*)(g.B + ob_); } while (0)
    const long dA2 = ((const char*)g.A2 - (const char*)g.A) - (long)nt1 * (long)kstep, dB2 = ((const char*)g.B2 - (const char*)g.B) - (long)nt1 * (long)kstep;
    Unit cur, nxt; int ui = 0;
    if (!S.next(0, cur)) return;
    f32x4 acc[2][2][4][2];
#pragma unroll
    for (int a = 0; a < 2; ++a)
#pragma unroll
        for (int b = 0; b < 2; ++b)
#pragma unroll
            for (int m = 0; m < 4; ++m)
#pragma unroll
                for (int n = 0; n < 2; ++n) acc[a][b][m][n] = (f32x4){0.f, 0.f, 0.f, 0.f};
    bf16x8 At[4][2], B0[2][2], B1[2][2];
    const char *cA, *cB;
    PG8_PTRS(cur, cA, cB);
    PG8_STAGE(PG8_SB(0, 0), cB, voffB); PG8_STAGE(PG8_SB(0, 1), cB + hstepB, voffB); PG8_STAGE(PG8_SA(0, 0), cA, voffA); PG8_STAGE(PG8_SA(0, 1), cA + hstepA, voffA);
    if (wr == 1) PG8_BAR;
    PG8_WAIT_V(2); PG8_BAR;
    PG8_STAGE(PG8_SB(1, 0), cB + kstep, voffB); PG8_STAGE(PG8_SA(1, 0), cA + kstep, voffA); PG8_STAGE(PG8_SB(1, 1), cB + hstepB + kstep, voffB);
    PG8_WAIT_V(6); PG8_BAR;
    for (;;) {
        const bool has_next = S.next(ui + 1, nxt);
        const char *nA = cA, *nB = cB;
        if (has_next) PG8_PTRS(nxt, nA, nB);
        for (int t = 0; t < nt; t += 2) {
            const bool last = (t == nt - 2);
            const char* a1 = cA + (size_t)(t + 1) * kstep + ((t + 1 < nt1) ? 0L : dA2);
            const char* a2 = last ? nA : cA + (size_t)(t + 2) * kstep + ((t + 2 < nt1) ? 0L : dA2);
            const char* b2 = last ? nB : cB + (size_t)(t + 2) * kstep + ((t + 2 < nt1) ? 0L : dB2);
            const char* a3 = a2 + kstep; const char* b3 = b2 + kstep;
            PG8_LDB(B0, 0, 0); PG8_LDB(B1, 0, 1); PG8_SCHED; PG8_LDA(At, 0, 0); PG8_STAGE(PG8_SA(1, 1), a1 + hstepA, voffA);
            PG8_WAIT_V(8); PG8_WAIT_L(0); PG8_BAR; PG8_MMA(0, 0, At, B0); PG8_MMA(0, 1, At, B1); PG8_BAR; PG8_SCHED;
            PG8_LDA(At, 0, 1); PG8_STAGE(PG8_SB(0, 0), b2, voffB); PG8_STAGE(PG8_SB(0, 1), b2 + hstepB, voffB); PG8_STAGE(PG8_SA(0, 0), a2, voffA);
            PG8_WAIT_V(8); PG8_WAIT_L(0); PG8_BAR; PG8_MMA(1, 0, At, B0); PG8_MMA(1, 1, At, B1); PG8_BAR; PG8_SCHED;
            PG8_LDB(B0, 1, 0); PG8_LDB(B1, 1, 1); PG8_SCHED; PG8_LDA(At, 1, 0); PG8_STAGE(PG8_SA(0, 1), a2 + hstepA, voffA);
            PG8_WAIT_V(8); PG8_WAIT_L(0); PG8_BAR; PG8_MMA(0, 0, At, B0); PG8_MMA(0, 1, At, B1); PG8_BAR; PG8_SCHED;
            PG8_LDA(At, 1, 1); PG8_STAGE(PG8_SB(1, 0), b3, voffB); PG8_STAGE(PG8_SB(1, 1), b3 + hstepB, voffB); PG8_STAGE(PG8_SA(1, 0), a3, voffA);
            PG8_WAIT_V(8); PG8_WAIT_L(0); PG8_BAR; PG8_MMA(1, 0, At, B0); PG8_MMA(1, 1, At, B1); PG8_BAR; PG8_SCHED;
        }
        if (wr == 0) PG8_BAR;
        { int lane_e, wr_ = wr, wc_ = wc; asm volatile("v_mbcnt_lo_u32_b32 %0, -1, 0\n\tv_mbcnt_hi_u32_b32 %0, -1, %0" : "=v"(lane_e)); asm volatile("" : "+s"(wr_), "+s"(wc_));
          E(acc, cur, wr_, wc_, lane_e & 15, lane_e >> 4); }
        if (!has_next) break;
#pragma unroll
        for (int a = 0; a < 2; ++a)
#pragma unroll
            for (int b = 0; b < 2; ++b)
#pragma unroll
                for (int m = 0; m < 4; ++m)
#pragma unroll
                    for (int n = 0; n < 2; ++n) acc[a][b][m][n] = (f32x4){0.f, 0.f, 0.f, 0.f};
        cur = nxt; cA = nA; cB = nB; ++ui;
        if (wr == 1) PG8_BAR;
    }
    PG8_WAIT_V(0);
    PG8_BAR;
#undef PG8_SA
#undef PG8_SB
#undef PG8_STAGE
#undef PG8_LDA
#undef PG8_LDB
#undef PG8_MMA
#undef PG8_WAIT_V
#undef PG8_WAIT_L
#undef PG8_BAR
#undef PG8_SCHED
#undef PG8_PTRS
}
}

constexpr size_t MiB = 1u << 20;
constexpr size_t WS_CTL = 0, CTL_ZERO_BYTES = 1 * MiB;
constexpr size_t WS_TABA = 2 * MiB;
constexpr size_t WS_TABR = 6 * MiB;
constexpr size_t WS_KMEAN = 14 * MiB;
constexpr size_t WS_W = 16 * MiB;
constexpr size_t W_MQKV = WS_W, W_MO = W_MQKV + 48 * MiB, W_RQ = W_MO + 16 * MiB, W_RK = W_RQ + 16 * MiB, W_RV = W_RK + 16 * MiB,
                 W_RG = W_RV + 32 * MiB, W_RO = W_RG + 32 * MiB, W_FI = W_RO + 32 * MiB, W_FO = W_FI + 176 * MiB, W_END = W_FO + 88 * MiB;
constexpr size_t WS_HN = W_END;
constexpr size_t WS_ACT = WS_HN + 64 * MiB;
constexpr size_t A_QKV = WS_ACT, A_MO = WS_ACT + 192 * MiB, A_MLIST = A_MO + 64 * MiB, A_MPO = A_MLIST + 32 * MiB, A_MPML = A_MPO + 192 * MiB;
constexpr size_t A_U = WS_ACT, A_FA = WS_ACT + 352 * MiB;
constexpr size_t A_RQ = WS_ACT, A_RK = A_RQ + 64 * MiB, A_RKT = A_RK + 64 * MiB, A_RVT = A_RKT + 64 * MiB, A_RG = A_RVT + 128 * MiB,
                 A_RP = A_RG + 128 * MiB, A_RU = A_RP + 64 * MiB, A_RRT = A_RU + 128 * MiB, A_REND = A_RRT + 128 * MiB;
constexpr size_t WS_TABRT = A_REND;
constexpr size_t WS_KMP = WS_TABRT + 8 * MiB;
constexpr size_t WS_STATS = WS_KMP + 3 * MiB;
constexpr size_t WS_FSTATS = WS_STATS + 1 * MiB;
constexpr int NCOLG = 75776;
constexpr int CO_M1 = 0, CO_R = 6144, CO_F = 30720, CO_ID = NCOLG, NCOLT = NCOLG + 6144;
constexpr size_t WS_GWP = WS_STATS + 2 * MiB;
constexpr size_t WS_GW = WS_GWP + 20 * MiB;
constexpr size_t WS_NEED = WS_GW + 1 * MiB;
static_assert(W_END == 472 * MiB && WS_ACT == 536 * MiB && WS_NEED == 1338 * MiB && 2 * 32 * NCOLG * 4 <= 20 * MiB, "ws map");

constexpr int RING_BYTES = 131072, LDSCTL_OFF = 144384, MISC_OFF = LDSCTL_OFF + 320, LDS_BYTES = 147456;
constexpr int NWAVES = 8;

#define XB_TMO      128
#define XB_XCNT(j)  (256  + 64 * (j))
#define XB_XSUB(j)  (1280 + 64 * (j))
#define XB_XGEN(j)  (2304 + 64 * (j))
#define XB_TOP      3328
#define XB_TOPGEN   3392
#define XCD_BAR_WORDS 3456
#define XB_SPIN_CAP (1u << 18)
constexpr int CW_BAR = 4096, CW_PANEL = 16384, CW_CNT = 8192;
__device__ __forceinline__ unsigned xb_ld(unsigned* p)              { return __hip_atomic_load(p, __ATOMIC_RELAXED, __HIP_MEMORY_SCOPE_AGENT); }
__device__ __forceinline__ unsigned xb_add(unsigned* p, unsigned v) { return __hip_atomic_fetch_add(p, v, __ATOMIC_RELAXED, __HIP_MEMORY_SCOPE_AGENT); }
__device__ __forceinline__ unsigned xb_xcc_id() { return (unsigned)__builtin_amdgcn_s_getreg((3 << 11) | 20) & 0xFu; }
#define XB_SPIN(cond, bar) do { unsigned _sp = 0; while (cond) { __builtin_amdgcn_s_sleep(1); \
    if ((++_sp & 255u) == 0u) { if (xb_ld(&(bar)[XB_TMO])) break; if (_sp > XB_SPIN_CAP) { atomicAdd(&(bar)[XB_TMO], 1u); break; } } } } while (0)
struct XcdBarrier { unsigned* bar; unsigned x; volatile LAS unsigned* st; };
__device__ __forceinline__ XcdBarrier xcd_barrier_post(unsigned* bar, volatile LAS unsigned* st) {
    XcdBarrier b; b.bar = bar; b.x = xb_xcc_id(); b.st = st;
    if (threadIdx.x == 0) (void)xb_add(&bar[XB_XCNT(b.x)], 1u);
    return b;
}
__device__ __forceinline__ void xcd_barrier_complete(unsigned* bar, unsigned x, unsigned& nloc, unsigned& nx) {
    const unsigned G = gridDim.x * gridDim.y * gridDim.z;
    unsigned sum, cnt, mine, sp = 0u;
    for (;;) {
        sum = 0u; cnt = 0u; mine = 0u;
#pragma unroll
        for (unsigned j = 0; j < 16; ++j) { const unsigned c = xb_ld(&bar[XB_XCNT(j)]); sum += c; cnt += (c > 0u) ? 1u : 0u; mine = (j == x) ? c : mine; }
        if (sum == G) break;
        __builtin_amdgcn_s_sleep(1);
        if ((++sp & 255u) == 0u) { if (xb_ld(&bar[XB_TMO])) break; if (sp > XB_SPIN_CAP) { atomicAdd(&bar[XB_TMO], 1u); break; } }
    }
    nloc = mine > 0u ? mine : 1u; nx = cnt > 0u ? cnt : 1u;
}
__device__ __forceinline__ void xcd_barrier(const XcdBarrier& b) {
    asm volatile("s_waitcnt vmcnt(0)" ::: "memory");
    __syncthreads();
    if (threadIdx.x == 0) {
        unsigned* bar = b.bar;
        __builtin_amdgcn_s_waitcnt(0);
        unsigned nloc = b.st[0], nx = b.st[1];
        if (nloc == 0u) { xcd_barrier_complete(bar, b.x, nloc, nx); b.st[0] = nloc; b.st[1] = nx; }
        const unsigned old = xb_add(&bar[XB_XSUB(b.x)], 1u);
        const unsigned gen = old / nloc;
        if (old + 1u == (gen + 1u) * nloc) {
            __builtin_amdgcn_fence(__ATOMIC_RELEASE, "agent");
            asm volatile("s_waitcnt vmcnt(0)" ::: "memory");
            const unsigned og = xb_add(&bar[XB_TOP], 1u);
            const unsigned tg = og / nx;
            if (og + 1u == (tg + 1u) * nx) xb_add(&bar[XB_TOPGEN], 1u);
            else XB_SPIN(xb_ld(&bar[XB_TOPGEN]) == tg, bar);
            __builtin_amdgcn_fence(__ATOMIC_ACQUIRE, "agent");
            xb_add(&bar[XB_XGEN(b.x)], 1u);
            asm volatile("s_waitcnt vmcnt(0)" ::: "memory");
        } else {
            XB_SPIN(xb_ld(&bar[XB_XGEN(b.x)]) == gen, bar);
            __builtin_amdgcn_fence(__ATOMIC_ACQUIRE, "agent");
            asm volatile("s_waitcnt vmcnt(0)" ::: "memory");
        }
    }
    __syncthreads();
}

struct Args {
    const float* in[14];
    float* out; unsigned char* ws;
    int ph_lo, ph_hi;
};
struct Ctx { int tid, lane, wave, bid, G, gw, NGW, gt, NGT; LAS unsigned char* lds; };

__device__ __forceinline__ void transpose_item(const int PERMODE, const float* W, int K, int N, bf16* WT, LAS float* scr, int item, int lane, const float* fg, const float* fb, float* pgw) {
    const int kblk = K / 64, nb = item / kblk, kb = item % kblk, k0 = 64 * kb, n0 = 64 * nb;
    const int fh = n0 >= FF ? 1 : 0, fw = n0 - fh * FF;
    const int r0 = PERMODE == 1 ? ((n0 >> 8) * 256 + ((n0 >> 6) & 1) * 128 + ((n0 >> 7) & 1) * 64) : PERMODE == 2 ? ((fw >> 7) * 256 + fh * 128 + (fw & 127)) : n0;
    f32x4 v[16];
    const float* src = W + (size_t)(k0 + (lane >> 4)) * N + n0 + 4 * (lane & 15);
#pragma unroll
    for (int i = 0; i < 16; ++i) v[i] = *(const f32x4*)(src + (size_t)(4 * i) * N);
#pragma unroll
    for (int i = 0; i < 16; ++i) { LAS float* d = scr + (4 * i + (lane >> 4)) * 65 + 4 * (lane & 15); d[0] = v[i][0]; d[1] = v[i][1]; d[2] = v[i][2]; d[3] = v[i][3]; }
    asm volatile("s_waitcnt lgkmcnt(0)" ::: "memory");
    const int c = lane & 7;
    float gk[8], bk[8];
#pragma unroll
    for (int t = 0; t < 8; ++t) { gk[t] = 1.f; bk[t] = 0.f; }
    if (fg) {
        const f32x4 g0 = *(const f32x4*)(fg + k0 + 8 * c), g1 = *(const f32x4*)(fg + k0 + 8 * c + 4), b0 = *(const f32x4*)(fb + k0 + 8 * c), b1 = *(const f32x4*)(fb + k0 + 8 * c + 4);
#pragma unroll
        for (int t = 0; t < 4; ++t) { gk[t] = g0[t]; gk[4 + t] = g1[t]; bk[t] = b0[t]; bk[4 + t] = b1[t]; } }
#pragma unroll
    for (int j = 0; j < 8; ++j) { const int n = (lane >> 3) + 8 * j; const LAS float* q = scr + (8 * c) * 65 + n;
        float w[8];
#pragma unroll
        for (int t = 0; t < 8; ++t) w[t] = q[t * 65];
        u32x4 o; o.x = cvt_pk_bf16(w[0] * gk[0], w[1] * gk[1]); o.y = cvt_pk_bf16(w[2] * gk[2], w[3] * gk[3]); o.z = cvt_pk_bf16(w[4] * gk[4], w[5] * gk[5]); o.w = cvt_pk_bf16(w[6] * gk[6], w[7] * gk[7]);
        *(u32x4*)(WT + (size_t)(r0 + n) * K + k0 + 8 * c) = o;
        if (fg) {
            float pg = ((bflo(o.x) + bfhi(o.x)) + (bflo(o.y) + bfhi(o.y))) + ((bflo(o.z) + bfhi(o.z)) + (bflo(o.w) + bfhi(o.w)));
            float pb = ((w[0] * bk[0] + w[1] * bk[1]) + (w[2] * bk[2] + w[3] * bk[3])) + ((w[4] * bk[4] + w[5] * bk[5]) + (w[6] * bk[6] + w[7] * bk[7]));
            pg += shx(pg, 1, lane); pg += shx(pg, 2, lane); pg += shx(pg, 4, lane); pb += shx(pb, 1, lane); pb += shx(pb, 2, lane); pb += shx(pb, 4, lane);
            if (c == 0) { pgw[(size_t)kb * NCOLG + r0 + n] = pg; pgw[(size_t)(32 + kb) * NCOLG + r0 + n] = pb; } } }
    asm volatile("s_waitcnt lgkmcnt(0)" ::: "memory");
}
__device__ __forceinline__ void ph_prologue(const Ctx& C, const Args& a) {
    unsigned char* ws = a.ws;
    {
        LAS float* scr = (LAS float*)(C.lds + C.wave * 16640);
        constexpr int PJ = 12288, PL = 8448, NJ = 2 * PJ, NIT = NJ + 4 * PL;
        for (int g = C.gw; g < NIT; g += C.NGW) {
            const float* W; bf16* WT; int K, N, item; int perm = 0; int lnidx = -1, cob = 0;
            if (g < NJ) { const int j = g / PJ, r = g % PJ;
                if (r < 3072)      { W = a.in[1] + (size_t)j * DM * 3 * DM; WT = (bf16*)(ws + W_MQKV) + (size_t)j * 3 * DM * DM; K = DM; N = 3 * DM; item = r; perm = 1; if (j == 1) { lnidx = 3; cob = CO_M1; } }
                else if (r < 4096) { W = a.in[2] + (size_t)j * DM * DM; WT = (bf16*)(ws + W_MO) + (size_t)j * DM * DM; K = DM; N = DM; item = r - 3072; }
                else if (r < 5120) { W = a.in[3] + (size_t)j * DM * DM; WT = (bf16*)(ws + W_RQ) + (size_t)j * DM * DM; K = DM; N = DM; item = r - 4096; lnidx = 4 * j + 1; cob = CO_R + j * 12288; }
                else if (r < 6144) { W = a.in[4] + (size_t)j * DM * DM; WT = (bf16*)(ws + W_RK) + (size_t)j * DM * DM; K = DM; N = DM; item = r - 5120; lnidx = 4 * j + 1; cob = CO_R + j * 12288 + 2048; }
                else if (r < 8192) { W = a.in[5] + (size_t)j * DM * 2 * DM; WT = (bf16*)(ws + W_RV) + (size_t)j * 2 * DM * DM; K = DM; N = 2 * DM; item = r - 6144; lnidx = 4 * j + 1; cob = CO_R + j * 12288 + 4096; }
                else if (r < 10240) { W = a.in[6] + (size_t)j * DM * 2 * DM; WT = (bf16*)(ws + W_RG) + (size_t)j * 2 * DM * DM; K = DM; N = 2 * DM; item = r - 8192; lnidx = 4 * j + 1; cob = CO_R + j * 12288 + 8192; }
                else               { W = a.in[7] + (size_t)j * 2 * DM * DM; WT = (bf16*)(ws + W_RO) + (size_t)j * 2 * DM * DM; K = 2 * DM; N = DM; item = r - 10240; }
            } else { const int l = (g - NJ) / PL, r = (g - NJ) % PL;
                if (r < 5632) { W = a.in[8] + (size_t)l * DM * FF2; WT = (bf16*)(ws + W_FI) + (size_t)l * FF2 * DM; K = DM; N = FF2; item = r; perm = 2; lnidx = 2 * l; cob = CO_F + l * 11264; }
                else          { W = a.in[11] + (size_t)l * FF * DM; WT = (bf16*)(ws + W_FO) + (size_t)l * FF * DM; K = FF; N = DM; item = r - 5632; }
            }
            const float* fg = lnidx >= 0 ? a.in[12] + (size_t)lnidx * DM : nullptr; const float* fb = lnidx >= 0 ? a.in[13] + (size_t)lnidx * DM : nullptr;
            transpose_item(perm, W, K, N, WT, scr, item, C.lane, fg, fb, (float*)(ws + WS_GWP) + cob);
        }
    }
    f32x2* ta = (f32x2*)(ws + WS_TABA); f32x2* tr = (f32x2*)(ws + WS_TABR);
    for (int i = C.gt; i < SEQ * 64; i += C.NGT) { const int pos = i >> 6, f = i & 63; float s, c; sincos_acc((float)pos * INV_A[f], s, c); ta[i] = (f32x2){c, s}; }
    for (int i = C.gt; i < SEQ * 128; i += C.NGT) { const int pos = i >> 7, f = i & 127; float s, c; sincos_acc((float)pos * INV_R[f], s, c); tr[i] = (f32x2){c, s}; }
    { f32x4* st = (f32x4*)(ws + WS_FSTATS);
      for (int i = C.gt; i < NTOK / 2; i += C.NGT) st[i] = (f32x4){1.f, 0.f, 1.f, 0.f}; }
    const f32x4* x4 = (const f32x4*)a.in[0]; u32x2* hn = (u32x2*)(ws + WS_HN);
    for (int i = C.gt; i < NTOK * DM / 4; i += 4 * C.NGT) { f32x4 v[4];
#pragma unroll
        for (int q = 0; q < 4; ++q) v[q] = x4[i + q * C.NGT];
#pragma unroll
        for (int q = 0; q < 4; ++q) hn[i + q * C.NGT] = (u32x2){cvt_pk_bf16(v[q][0], v[q][1]), cvt_pk_bf16(v[q][2], v[q][3])}; }
}
__device__ __forceinline__ void ph_stats_final(const Ctx& C, const f32x2* part, f32x2* FS) {
    for (int row = C.gt; row < NTOK; row += C.NGT) { const f32x4* p = (const f32x4*)(part + (size_t)row * 8); const f32x4 a = p[0], b = p[1], c = p[2], d = p[3];
        const float S = ((a[0] + a[2]) + (b[0] + b[2])) + ((c[0] + c[2]) + (d[0] + d[2])), Q = ((a[1] + a[3]) + (b[1] + b[3])) + ((c[1] + c[3]) + (d[1] + d[3]));
        const float mu = S * (1.0f / DM), var = Q * (1.0f / DM) - mu * mu, r = 1.0f / sqrtf(var + LN_EPS); FS[row] = (f32x2){r, r * mu}; }
}
__device__ __forceinline__ void ph_fold_reduce(const Ctx& C, const float* P, float* GWv) {
    for (int i = C.gt; i < 2 * NCOLT; i += C.NGT) { const int which = i / NCOLT, col = i % NCOLT; float s = 0.f;
        if (col < NCOLG) for (int kb = 0; kb < 32; ++kb) s += P[(size_t)(which * 32 + kb) * NCOLG + col];
        GWv[i] = s; }
}
__device__ __forceinline__ void ph_ln_final(const Ctx& C, const bf16* TNp, float* Out, const float* g, const float* bta) {
    f32x4 gq[8], bq[8];
#pragma unroll
    for (int j = 0; j < 4; ++j) { const int c0 = 512 * j + 8 * C.lane; gq[2 * j] = *(const f32x4*)(g + c0); gq[2 * j + 1] = *(const f32x4*)(g + c0 + 4); bq[2 * j] = *(const f32x4*)(bta + c0); bq[2 * j + 1] = *(const f32x4*)(bta + c0 + 4); }
    int row = C.gw; u32x4 w4[4];
    if (row < NTOK) {
#pragma unroll
        for (int j = 0; j < 4; ++j) w4[j] = ((const u32x4*)(TNp + (size_t)row * DM) + C.lane)[64 * j]; }
#pragma unroll 1
    for (; row < NTOK; row += C.NGW) {
        u32x4 n4[4]; const int nr = row + C.NGW;
        if (nr < NTOK) {
#pragma unroll
            for (int j = 0; j < 4; ++j) n4[j] = ((const u32x4*)(TNp + (size_t)nr * DM) + C.lane)[64 * j]; }
        else {
#pragma unroll
            for (int j = 0; j < 4; ++j) n4[j] = (u32x4){0u, 0u, 0u, 0u}; }
        float v[32]; float s = 0.f;
#pragma unroll
        for (int j = 0; j < 4; ++j) {
#pragma unroll
            for (int q = 0; q < 4; ++q) { v[8 * j + 2 * q] = bflo(w4[j][q]); v[8 * j + 2 * q + 1] = bfhi(w4[j][q]); s += v[8 * j + 2 * q] + v[8 * j + 2 * q + 1]; } }
        const float mean = wave_sum(s, C.lane) * (1.f / DM); float s2 = 0.f;
#pragma unroll
        for (int j = 0; j < 32; ++j) { v[j] -= mean; s2 += v[j] * v[j]; }
        const float rstd = 1.f / sqrtf(wave_sum(s2, C.lane) * (1.f / DM) + LN_EPS);
#pragma unroll
        for (int j = 0; j < 4; ++j) { const int c0 = 512 * j + 8 * C.lane;
            f32x4 o0, o1;
#pragma unroll
            for (int e = 0; e < 4; ++e) { o0[e] = v[8 * j + e] * rstd * gq[2 * j][e] + bq[2 * j][e]; o1[e] = v[8 * j + 4 + e] * rstd * gq[2 * j + 1][e] + bq[2 * j + 1][e]; }
            *(f32x4*)(Out + (size_t)row * DM + c0) = o0; *(f32x4*)(Out + (size_t)row * DM + c0 + 4) = o1; }
#pragma unroll
        for (int j = 0; j < 4; ++j) w4[j] = n4[j];
    }
}
__device__ __forceinline__ void ph_kmean(const Ctx& C, const bf16* QKV, float* KMo) {
    for (int it = C.gw; it < 2 * MH * MNB; it += C.NGW) {
        const int b = it / (MH * MNB), h = (it / MNB) % MH, j = it % MNB, c = C.lane & 15, rs = C.lane >> 4;
        const bf16* kp = QKV + (size_t)(b * SEQ + j * MBLK + rs) * (3 * DM) + DM + h * MHD + 8 * c;
        float a[8];
#pragma unroll
        for (int e = 0; e < 8; ++e) a[e] = 0.f;
#pragma unroll 1
        for (int r0 = 0; r0 < MBLK / 4; r0 += 16) {
            u32x4 w[16];
#pragma unroll
            for (int r = 0; r < 16; ++r) w[r] = *(const u32x4*)(kp + (size_t)(4 * (r0 + r)) * (3 * DM));
#pragma unroll
            for (int r = 0; r < 16; ++r)
#pragma unroll
                for (int q = 0; q < 4; ++q) { a[2 * q] += bflo(w[r][q]); a[2 * q + 1] += bfhi(w[r][q]); } }
#pragma unroll
        for (int e = 0; e < 8; ++e) { a[e] += shx(a[e], 16, C.lane); a[e] += shx(a[e], 32, C.lane); a[e] *= (1.0f / MBLK); }
        if (rs == 0) { float* o = KMo + (size_t)((b * MH + h) * MNB + j) * MHD + 8 * c; *(f32x4*)o = (f32x4){a[0], a[1], a[2], a[3]}; *(f32x4*)(o + 4) = (f32x4){a[4], a[5], a[6], a[7]}; }
    }
}

namespace mattn {
constexpr int D = 128, KVBLK = 64, SHM_V = KVBLK * D * 2, SHM_K = KVBLK * D * 2;
constexpr int OFF_V = 0, OFF_K = 2 * SHM_V, OFF_WS = 2 * SHM_V + 2 * SHM_K, OFF_STG = OFF_WS + 8 * 1024, OFF_PRE = OFF_STG + 8 * 8192, OFF_WT = OFF_PRE + 1032 * 4;
constexpr long LDQ = 3 * DM;
constexpr int LIST_CAP = 8192;
constexpr float C2 = 1.4426950408889634f;
constexpr float THR = 8.f;
typedef float f32x16 __attribute__((ext_vector_type(16)));
typedef short s16x4 __attribute__((ext_vector_type(4)));
#define KSWZ(row, colB) ((row) * 256 + ((colB) ^ (((row) & 7) << 4)))
#define SBAR() __builtin_amdgcn_sched_barrier(0)
__device__ __forceinline__ int v_st(int k, int c) { const int kk = (k & ~0xC) | ((k & 4) << 1) | ((k & 8) >> 1); return ((kk >> 3) * 4 + (c >> 5)) * 512 + ((kk & 7) * 32 + (c & 31)) * 2; }
__device__ __forceinline__ int v_rd_base(int lane) { return ((lane & 3) << 3) | (((lane >> 2) & 3) << 6) | (((lane >> 4) & 1) << 5) | (((lane >> 5) & 1) << 8); }
constexpr int v_rd_off(int d0, int ks, int half) { return d0 * 512 + ks * 4096 + half * 2048; }
__device__ __forceinline__ int crow(int r, int hi) { return (r & 3) + 8 * (r >> 2) + 4 * hi; }
__device__ __forceinline__ void partialSM(f32x16& p0, f32x16& p1, float& m_reg, float& mn, float& alpha) {
    float pmax = p0[0];
#pragma unroll
    for (int r = 1; r < 16; ++r) pmax = fmaxf(pmax, p0[r]);
#pragma unroll
    for (int r = 0; r < 16; ++r) pmax = fmaxf(pmax, p1[r]);
    { auto rr = __builtin_amdgcn_permlane32_swap(__float_as_uint(pmax), __float_as_uint(pmax), false, false);
      pmax = fmaxf(__uint_as_float(rr[0]), __uint_as_float(rr[1])); }
    if (__builtin_expect(__all((pmax - m_reg) <= THR), 1)) { mn = m_reg; alpha = 1.f; }
    else { mn = fmaxf(m_reg, pmax); alpha = __builtin_amdgcn_exp2f((m_reg - mn) * C2); m_reg = mn; }
    const float mnL = -mn * C2;
#pragma unroll
    for (int r = 0; r < 16; ++r) p0[r] = fmaf(p0[r], C2, mnL);
#pragma unroll
    for (int r = 0; r < 16; ++r) p1[r] = fmaf(p1[r], C2, mnL);
#pragma unroll
    for (int r = 0; r < 16; ++r) p0[r] = __builtin_amdgcn_exp2f(p0[r]);
}
__device__ __forceinline__ void finishSM(f32x16& p0, f32x16& p1, float alpha, float& l_reg, bf16x8& pa0, bf16x8& pa1, bf16x8& pa2, bf16x8& pa3) {
#pragma unroll
    for (int r = 0; r < 16; ++r) p1[r] = __builtin_amdgcn_exp2f(p1[r]);
    float ps = 0;
#pragma unroll
    for (int r = 0; r < 16; ++r) ps += p0[r];
#pragma unroll
    for (int r = 0; r < 16; ++r) ps += p1[r];
    { auto rr = __builtin_amdgcn_permlane32_swap(__float_as_uint(ps), __float_as_uint(ps), false, false);
      ps = __uint_as_float(rr[0]) + __uint_as_float(rr[1]); }
    l_reg = l_reg * alpha + ps;
#define PK4(P, B_, OUT) do { unsigned a0 = cvt_pk_bf16(P[B_+0], P[B_+1]), a1 = cvt_pk_bf16(P[B_+2], P[B_+3]);                          \
        unsigned b0 = cvt_pk_bf16(P[B_+4], P[B_+5]), b1 = cvt_pk_bf16(P[B_+6], P[B_+7]);                                             \
        auto r0 = __builtin_amdgcn_permlane32_swap(a0, b0, false, false); auto r1 = __builtin_amdgcn_permlane32_swap(a1, b1, false, false); \
        u32x4 w = {r0[0], r1[0], r0[1], r1[1]}; OUT = __builtin_bit_cast(bf16x8, w); } while (0)
    PK4(p0, 0, pa0); PK4(p0, 8, pa1); PK4(p1, 0, pa2); PK4(p1, 8, pa3);
#undef PK4
}
template <int KB>
__device__ __forceinline__ void qkt(f32x16& p0, f32x16& p1, const LAS char* K_lds, int r32, int hi, const bf16x8* qr) {
    p0 = f32x16{}; p1 = f32x16{};
    const LAS char* kb[4];
#pragma unroll
    for (int dd = 0; dd < 4; ++dd) kb[dd] = K_lds + KB * SHM_K + KSWZ(r32, (dd * 16 + hi * 8) * 2);
#pragma unroll
    for (int d0 = 0; d0 < 8; ++d0) { const LAS char* a = kb[d0 & 3] + (d0 >> 2) * 128;
        const bf16x8 b0 = *(const LAS bf16x8*)a;
        const bf16x8 b1 = *(const LAS bf16x8*)(a + 32 * 256);
        p0 = __builtin_amdgcn_mfma_f32_32x32x16_bf16(b0, qr[d0], p0, 0, 0, 0);
        p1 = __builtin_amdgcn_mfma_f32_32x32x16_bf16(b1, qr[d0], p1, 0, 0, 0); }
}
template <int VB>
__device__ __forceinline__ void pv_tile(f32x16* o, int vb0, bf16x8 pa0, bf16x8 pa1, bf16x8 pa2, bf16x8 pa3) {
#define TRRD(dst, off) asm volatile("ds_read_b64_tr_b16 %0, %1 offset:%2" : "=&v"(dst) : "v"(vb0), "i"(off) : "memory")
#define PV_D0(d0) do { s16x4 l0, l1, l2, l3, h0, h1, h2, h3; constexpr int b_ = VB * SHM_V + v_rd_off(d0, 0, 0); \
        TRRD(l0, b_); TRRD(h0, b_ + 2048); TRRD(l1, b_ + 4096); TRRD(h1, b_ + 6144); TRRD(l2, b_ + 8192); TRRD(h2, b_ + 10240); TRRD(l3, b_ + 12288); TRRD(h3, b_ + 14336); \
        asm volatile("s_waitcnt lgkmcnt(0)" ::: "memory"); SBAR(); \
        o[d0] = __builtin_amdgcn_mfma_f32_32x32x16_bf16(pa0, (bf16x8){l0[0], l0[1], l0[2], l0[3], h0[0], h0[1], h0[2], h0[3]}, o[d0], 0, 0, 0);   \
        o[d0] = __builtin_amdgcn_mfma_f32_32x32x16_bf16(pa1, (bf16x8){l1[0], l1[1], l1[2], l1[3], h1[0], h1[1], h1[2], h1[3]}, o[d0], 0, 0, 0);   \
        o[d0] = __builtin_amdgcn_mfma_f32_32x32x16_bf16(pa2, (bf16x8){l2[0], l2[1], l2[2], l2[3], h2[0], h2[1], h2[2], h2[3]}, o[d0], 0, 0, 0);   \
        o[d0] = __builtin_amdgcn_mfma_f32_32x32x16_bf16(pa3, (bf16x8){l3[0], l3[1], l3[2], l3[3], h3[0], h3[1], h3[2], h3[3]}, o[d0], 0, 0, 0); } while (0)
    PV_D0(0); PV_D0(1); PV_D0(2); PV_D0(3);
#undef PV_D0
#undef TRRD
}
struct AttnItem { const bf16* qrow; const bf16* Kb; const bf16* Vb; };
__device__ __forceinline__ void attn_offs(int wid, int lane, unsigned (&koff)[2], unsigned (&voff)[2]) {
#pragma unroll
    for (int i = 0; i < 2; ++i) { const int pi = wid * 2 + i, row = 4 * pi + (lane >> 4), c = (lane & 15) ^ (row & 7); koff[i] = (unsigned)(row * (int)LDQ + c * 8) * 2u;
        const int st = pi * 2 + (lane >> 5), kk = ((st >> 2) << 3) | ((lane & 31) >> 2), k = (kk & ~0xC) | ((kk & 4) << 1) | ((kk & 8) >> 1), cc = (st & 3) * 32 + (lane & 3) * 8; voff[i] = (unsigned)(k * (int)LDQ + cc) * 2u; }
}
#define SDMA(KB_, VB_, t, bf) do { _Pragma("unroll") for (int i_ = 0; i_ < 2; ++i_) { \
        __builtin_amdgcn_global_load_lds((const unsigned*)((const char*)(KB_) + (size_t)(t) * 64 * LDQ * 2 + koff[i_]), (LAS unsigned*)(K_lds + (bf) * SHM_K + (wid * 2 + i_) * 1024), 16, 0, 0); \
        __builtin_amdgcn_global_load_lds((const unsigned*)((const char*)(VB_) + (size_t)(t) * 64 * LDQ * 2 + voff[i_]), (LAS unsigned*)(V_lds + (bf) * SHM_V + (wid * 2 + i_) * 1024), 16, 0, 0); } } while (0)
__device__ __forceinline__ void attn_prime(LAS char* lds, int tid, const AttnItem& it, bf16x8 (&qr)[8]) {
    const int wid = __builtin_amdgcn_readfirstlane(tid >> 6), lane = tid & 63, hi = lane >> 5;
    LAS char* V_lds = lds + OFF_V; LAS char* K_lds = lds + OFF_K; unsigned koff[2], voff[2]; attn_offs(wid, lane, koff, voff);
#pragma unroll
    for (int d0 = 0; d0 < 8; ++d0) qr[d0] = *(const bf16x8*)(it.qrow + d0 * 16 + hi * 8);
    SDMA(it.Kb, it.Vb, 0, 0);
}
template <bool CAUSAL>
__device__ __forceinline__ void attn_core(LAS char* lds, int tid, const AttnItem& cur, const AttnItem& nxt, bool has_next, bf16x8 (&qr)[8], f32x16 (&o)[4], float& m_reg, float& l_reg) {
    const int wid = __builtin_amdgcn_readfirstlane(tid >> 6), lane = tid & 63, r32 = lane & 31, hi = lane >> 5;
    LAS char* V_lds = lds + OFF_V; LAS char* K_lds = lds + OFF_K;
    LAS float* al_l = (LAS float*)(lds + OFF_WS) + wid * 256;
    const int vb0 = (int)(unsigned)(uintptr_t)V_lds + v_rd_base(lane);
    unsigned koff[2], voff[2]; attn_offs(wid, lane, koff, voff);
    m_reg = -1e30f; l_reg = 0.f;
#pragma unroll
    for (int d = 0; d < 4; ++d) o[d] = f32x16{};
    const int qrel0 = wid * 32;
    asm volatile("s_waitcnt vmcnt(0)" ::: "memory"); __syncthreads();
#define TILE(t, BUF) do { \
        if ((t) < 3) SDMA(cur.Kb, cur.Vb, (t) + 1, 1 - (BUF)); else if (has_next) SDMA(nxt.Kb, nxt.Vb, 0, 0); \
        if (!CAUSAL || (t) * 64 <= qrel0 + 31) { \
            f32x16 pA0, pA1; float mn, al; bf16x8 pa0, pa1, pa2, pa3; \
            qkt<BUF>(pA0, pA1, K_lds, r32, hi, qr); \
            if ((t) == 3 && has_next) { _Pragma("unroll") for (int d0 = 0; d0 < 8; ++d0) qr[d0] = *(const bf16x8*)(nxt.qrow + d0 * 16 + hi * 8); } \
            if (CAUSAL && (t) * 64 + 63 > qrel0) { const int dq = qrel0 + r32 - (t) * 64 - 4 * hi; const float NEG = -__builtin_inff(); \
                _Pragma("unroll") for (int r = 0; r < 16; ++r) { const int c = (r & 3) + 8 * (r >> 2); if (dq - c < 0) pA0[r] = NEG; if (dq - c - 32 < 0) pA1[r] = NEG; } } \
            partialSM(pA0, pA1, m_reg, mn, al); \
            if (__any(al < 1.f)) { if (hi == 0) al_l[r32] = al; asm volatile("s_waitcnt lgkmcnt(0)" ::: "memory"); \
                _Pragma("unroll") for (int d_ = 0; d_ < 4; ++d_) _Pragma("unroll") for (int r = 0; r < 16; ++r) o[d_][r] *= al_l[crow(r, hi)]; } \
            finishSM(pA0, pA1, al, l_reg, pa0, pa1, pa2, pa3); SBAR(); \
            pv_tile<BUF>(o, vb0, pa0, pa1, pa2, pa3); } \
        else if ((t) == 3 && has_next) { _Pragma("unroll") for (int d0 = 0; d0 < 8; ++d0) qr[d0] = *(const bf16x8*)(nxt.qrow + d0 * 16 + hi * 8); } \
        if ((t) < 3) asm volatile("s_waitcnt vmcnt(0)" ::: "memory"); \
        __syncthreads(); } while (0)
    TILE(0, 0); TILE(1, 1); TILE(2, 0); TILE(3, 1);
#undef TILE
}
#undef SDMA
#undef KSWZ
#undef SBAR
}

__device__ __forceinline__ void stage_o(LAS unsigned short* stg, const mattn::f32x16 (&o)[4], const LAS float* scale, int r32, int hi) {
#pragma unroll
    for (int r = 0; r < 16; ++r) { const int rr = mattn::crow(r, hi); const float f = scale ? scale[rr] : 1.f;
#pragma unroll
        for (int d0 = 0; d0 < 4; ++d0) stg[rr * 128 + d0 * 32 + r32] = (unsigned short)cvt_pk_bf16(o[d0][r] * f, 0.f); }
    asm volatile("s_waitcnt lgkmcnt(0)" ::: "memory");
}
__device__ __forceinline__ void ph_moba_route(const Ctx& C, const bf16* QKV, const float* KMp, unsigned* cnt, unsigned* list) {
    LAS unsigned* lcnt = (LAS unsigned*)C.lds; LAS unsigned* gb = lcnt + 32;
    for (int it = C.gw; it < 2 * MH * 128; it += C.NGW) {
        const int b = it >> 11, qg = b ? 127 - (it & 127) : (it & 127), h = (it >> 7) & 15, blk = qg >> 2;
        const int pos = qg * 64 + C.lane, tok = b * SEQ + pos;
        if (C.tid < 32) lcnt[C.tid] = 0u;
        {
            const f32x4* src = (const f32x4*)(KMp + (size_t)((b * MH + h) * MNB) * MHD); LAS f32x4* dst = (LAS f32x4*)(C.lds + 256);
            const f32x4 t0 = src[C.tid], t1 = src[C.tid + 512]; dst[C.tid] = t0; dst[C.tid + 512] = t1; }
        __syncthreads();
        int s0 = 0, s1 = 0, s2 = 0;
        if (blk > 0) {
            const bf16* qp = QKV + (size_t)tok * (3 * DM) + h * MHD;
            u32x4 qv[16];
#pragma unroll
            for (int i = 0; i < 16; ++i) qv[i] = *(const u32x4*)(qp + 8 * i);
            float v0 = -__builtin_inff(), v1 = v0, v2 = v0;
            const LAS f32x4* km = (const LAS f32x4*)(C.lds + 256);
            for (int j = 0; j < blk; ++j) {
                const LAS f32x4* kj = km + j * (MHD / 4); float sc = 0.f;
#pragma unroll
                for (int i = 0; i < 16; ++i) { const f32x4 ka = kj[2 * i], kb = kj[2 * i + 1];
                    sc += bflo(qv[i].x) * ka[0] + bfhi(qv[i].x) * ka[1] + bflo(qv[i].y) * ka[2] + bfhi(qv[i].y) * ka[3]
                        + bflo(qv[i].z) * kb[0] + bfhi(qv[i].z) * kb[1] + bflo(qv[i].w) * kb[2] + bfhi(qv[i].w) * kb[3]; }
                const bool g0 = sc > v0, g1 = sc > v1, g2 = sc > v2;
                v2 = g1 ? v1 : (g2 ? sc : v2); s2 = g1 ? s1 : (g2 ? j : s2);
                v1 = g0 ? v0 : (g1 ? sc : v1); s1 = g0 ? s0 : (g1 ? j : s1);
                v0 = g0 ? sc : v0;             s0 = g0 ? j : s0;
            }
        }
        const int nsel = blk < 3 ? blk : 3; const int base = (b * MH + h) * MNB;
        unsigned r0 = 0, r1 = 0, r2 = 0;
        if (nsel > 0) r0 = __hip_atomic_fetch_add(lcnt + s0, 1u, __ATOMIC_RELAXED, __HIP_MEMORY_SCOPE_WORKGROUP);
        if (nsel > 1) r1 = __hip_atomic_fetch_add(lcnt + s1, 1u, __ATOMIC_RELAXED, __HIP_MEMORY_SCOPE_WORKGROUP);
        if (nsel > 2) r2 = __hip_atomic_fetch_add(lcnt + s2, 1u, __ATOMIC_RELAXED, __HIP_MEMORY_SCOPE_WORKGROUP);
        __syncthreads();
        if (C.tid < 32) { const unsigned n = lcnt[C.tid]; gb[C.tid] = n ? atomicAdd(cnt + base + C.tid, n) : 0u; }
        __syncthreads();
        if (nsel > 0) list[(size_t)(base + s0) * mattn::LIST_CAP + gb[s0] + r0] = (unsigned)pos;
        if (nsel > 1) list[(size_t)(base + s1) * mattn::LIST_CAP + gb[s1] + r1] = (unsigned)pos | (1u << 13);
        if (nsel > 2) list[(size_t)(base + s2) * mattn::LIST_CAP + gb[s2] + r2] = (unsigned)pos | (2u << 13);
    }
}
__device__ __forceinline__ void ph_moba_sel(const Ctx& C, const bf16* QKV, const unsigned* cnt, const unsigned* list, bf16* PO, f32x2* PML) {
    using namespace mattn;
    LAS char* lds = (LAS char*)C.lds;
    LAS int* pre = (LAS int*)(lds + OFF_PRE); LAS int* wtot = (LAS int*)(lds + OFF_WT);
    const int tid = C.tid, wid = C.wave, lane = C.lane, r32 = lane & 31, hi = lane >> 5;
    {
        const int c0 = (int)cnt[2 * tid], c1 = (int)cnt[2 * tid + 1], n0 = (c0 + 255) >> 8, n1 = (c1 + 255) >> 8, x = n0 + n1; int incl = x;
#pragma unroll
        for (int o = 1; o < 64; o <<= 1) { const int y = __builtin_amdgcn_ds_bpermute((lane - o) << 2, incl); if (lane >= o) incl += y; }
        if (lane == 63) wtot[wid] = incl;
        __syncthreads();
        int woff = 0;
        for (int w = 0; w < wid; ++w) woff += wtot[w];
        const int excl = woff + incl - x;
        pre[2 * tid] = excl; pre[2 * tid + 1] = excl + n0; if (tid == 511) pre[1024] = excl + x;
        __syncthreads();
    }
    const int T = pre[1024];
#define SEL_DECODE(item_, bhj_, n_, ent_, valid_, AI_) do { int lo_ = 0, hi_ = 1024; \
        while (hi_ - lo_ > 1) { const int mid = (lo_ + hi_) >> 1; if (pre[mid] <= (item_)) lo_ = mid; else hi_ = mid; } \
        bhj_ = lo_; const int chunk_ = (item_) - pre[bhj_]; n_ = (int)cnt[bhj_] - chunk_ * 256; n_ = n_ > 256 ? 256 : n_; \
        valid_ = (wid * 32 + r32) < n_; ent_ = list[(size_t)bhj_ * LIST_CAP + chunk_ * 256 + (valid_ ? (wid * 32 + r32) : 0)]; \
        { const int j_ = bhj_ & 31, h_ = (bhj_ >> 5) & 15, b_ = bhj_ >> 9; AI_.qrow = QKV + (size_t)(b_ * SEQ + (int)(ent_ & 8191u)) * LDQ + h_ * MHD; \
          AI_.Kb = QKV + (size_t)(b_ * SEQ + j_ * MBLK) * LDQ + DM + h_ * MHD; AI_.Vb = AI_.Kb + DM; } } while (0)
    int item = (C.G & 7) == 0 ? (C.bid & 7) * (C.G >> 3) + (C.bid >> 3) : C.bid; if (item >= T) return;
    int bhj, n; unsigned ent; bool valid; AttnItem cur; bf16x8 qr[8];
    SEL_DECODE(item, bhj, n, ent, valid, cur);
    attn_prime(lds, tid, cur, qr);
    for (;;) {
        const int nitem = item + C.G; const bool has_next = nitem < T;
        int bhj2 = bhj, n2 = n; unsigned ent2 = ent; bool valid2 = valid; AttnItem nxt = cur;
        if (has_next) SEL_DECODE(nitem, bhj2, n2, ent2, valid2, nxt);
        const int h = (bhj >> 5) & 15, b = bhj >> 9, pos = ent & 8191, slot = ent >> 13;
        f32x16 o[4]; float m_reg, l_reg;
        attn_core<false>(lds, tid, cur, nxt, has_next, qr, o, m_reg, l_reg);
        const size_t trow = (size_t)slot * NTOK + (size_t)(b * SEQ + pos);
        if (valid && hi == 0) PML[trow * MH + h] = (f32x2){m_reg, l_reg};
        LAS unsigned* dtab = (LAS unsigned*)((LAS float*)(lds + OFF_WS) + wid * 256 + 64);
        if (hi == 0) dtab[r32] = valid ? (unsigned)((trow * DM + h * MHD) * 2) : 0xffffffffu;
        LAS unsigned short* stg = (LAS unsigned short*)(lds + OFF_STG) + wid * 4096;
        stage_o(stg, o, nullptr, r32, hi);
#pragma unroll
        for (int i = 0; i < 8; ++i) { const int rw = (lane >> 4) + 4 * i, c = lane & 15; const unsigned d = dtab[rw];
            const u32x4 v = *(const LAS u32x4*)(stg + rw * 128 + c * 8);
            if (d != 0xffffffffu) *(u32x4*)((char*)PO + d + c * 16) = v; }
        asm volatile("s_waitcnt lgkmcnt(0)" ::: "memory");
        if (!has_next) break;
        item = nitem; bhj = bhj2; n = n2; ent = ent2; valid = valid2; cur = nxt;
    }
#undef SEL_DECODE
}
__device__ __forceinline__ void ph_moba_own(const Ctx& C, const bf16* QKV, const bf16* PO, const f32x2* PML, bf16* O) {
    using namespace mattn;
    LAS char* lds = (LAS char*)C.lds;
    const int tid = C.tid, wid = C.wave, lane = C.lane, r32 = lane & 31, hi = lane >> 5;
    LAS float* tb = (LAS float*)(lds + OFF_WS) + wid * 256 + 64;
#define OWN_DECODE(item_, AI_) do { const int qb_ = (item_) & 31, h_ = ((item_) >> 5) & 15, b_ = (item_) >> 9; \
        AI_.qrow = QKV + (size_t)(b_ * SEQ + qb_ * MBLK + wid * 32 + r32) * LDQ + h_ * MHD; AI_.Kb = QKV + (size_t)(b_ * SEQ + qb_ * MBLK) * LDQ + DM + h_ * MHD; AI_.Vb = AI_.Kb + DM; } while (0)
    if (C.bid >= 2 * MH * MNB) return;
    AttnItem cur; bf16x8 qr[8]; OWN_DECODE(C.bid, cur);
    attn_prime(lds, tid, cur, qr);
    for (int item = C.bid; item < 2 * MH * MNB; item += C.G) {
        const int qb = item & 31, h = (item >> 5) & 15, b = item >> 9;
        const int tok = b * SEQ + qb * MBLK + wid * 32 + r32;
        const bool has_next = item + C.G < 2 * MH * MNB; AttnItem nxt = cur; if (has_next) OWN_DECODE(item + C.G, nxt);
        const int nsel = qb < 3 ? qb : 3;
        f32x16 o[4]; float m_reg, l_reg;
        attn_core<true>(lds, tid, cur, nxt, has_next, qr, o, m_reg, l_reg);
        LAS unsigned short* stg = (LAS unsigned short*)(lds + OFF_STG) + wid * 4096;
        stage_o(stg, o, nullptr, r32, hi);
        const int tok0 = b * SEQ + qb * MBLK + wid * 32;
        f32x2 ml[3];
#pragma unroll
        for (int sl = 0; sl < 3; ++sl) ml[sl] = (sl < nsel) ? PML[((size_t)sl * NTOK + tok) * MH + h] : (f32x2){-1e30f, 0.f};
        u32x4 pv[3][8];
#pragma unroll
        for (int sl = 0; sl < 3; ++sl)
#pragma unroll
            for (int i = 0; i < 8; ++i) { const int rw = (lane >> 4) + 4 * i, c = lane & 15;
                pv[sl][i] = (sl < nsel) ? *(const u32x4*)(PO + (size_t)sl * NTOK * DM + (size_t)(tok0 + rw) * DM + h * MHD + c * 8) : (u32x4){0u, 0u, 0u, 0u}; }
        {
            float M = m_reg;
#pragma unroll
            for (int sl = 0; sl < 3; ++sl) M = fmaxf(M, ml[sl].x);
            const float fo = __builtin_amdgcn_exp2f((m_reg - M) * C2); float L = l_reg * fo; float fs[3];
#pragma unroll
            for (int sl = 0; sl < 3; ++sl) { fs[sl] = (sl < nsel) ? __builtin_amdgcn_exp2f((ml[sl].x - M) * C2) : 0.f; L += ml[sl].y * fs[sl]; }
            const float inv = 1.0f / L;
            if (hi == 0) { tb[r32] = fo * inv; tb[32 + r32] = fs[0] * inv; tb[64 + r32] = fs[1] * inv; tb[96 + r32] = fs[2] * inv; }
            asm volatile("s_waitcnt lgkmcnt(0)" ::: "memory");
        }
#pragma unroll
        for (int i = 0; i < 8; ++i) { const int rw = (lane >> 4) + 4 * i, c = lane & 15;
            const u32x4 ov = *(const LAS u32x4*)(stg + rw * 128 + c * 8); const float f0 = tb[rw];
            float x[8];
#pragma unroll
            for (int q = 0; q < 4; ++q) { x[2 * q] = f0 * bflo(ov[q]); x[2 * q + 1] = f0 * bfhi(ov[q]); }
#pragma unroll
            for (int sl = 0; sl < 3; ++sl) { const float f = tb[32 * (sl + 1) + rw];
#pragma unroll
                for (int q = 0; q < 4; ++q) { x[2 * q] += f * bflo(pv[sl][i][q]); x[2 * q + 1] += f * bfhi(pv[sl][i][q]); } }
            u32x4 w; w.x = cvt_pk_bf16(x[0], x[1]); w.y = cvt_pk_bf16(x[2], x[3]); w.z = cvt_pk_bf16(x[4], x[5]); w.w = cvt_pk_bf16(x[6], x[7]);
            *(u32x4*)(O + (size_t)(tok0 + rw) * DM + h * MHD + c * 8) = w; }
        asm volatile("s_waitcnt lgkmcnt(0)" ::: "memory");
        cur = nxt;
    }
#undef OWN_DECODE
}
__device__ __forceinline__ void ph_conv_fix(const Ctx& C, const bf16* UH, bf16* A, const float* cw, const float* cb) {
    constexpr int FG = FF / 8;
    for (int it = C.gt; it < (NTOK / 64) * 2 * FG; it += C.NGT) {
        const int fg = it % FG, rr = (it / FG) & 1, G = it / (2 * FG), f0 = fg * 8, t = G * 64 + rr; const bool seq0 = (t & (SEQ - 1)) < 2 && ((G * 64) & (SEQ - 1)) == 0;
        const bf16* up = UH + (size_t)(G - 1) * 4 * FF2; const bf16* uc = UH + (size_t)G * 4 * FF2;
        u32x4 g2, g1, g0, v2, v1, v0; const u32x4 z = {0, 0, 0, 0};
        if (rr == 0) { g2 = seq0 ? z : *(const u32x4*)(up + f0); g1 = seq0 ? z : *(const u32x4*)(up + FF2 + f0); g0 = *(const u32x4*)(uc + 2 * FF2 + f0);
                       v2 = seq0 ? z : *(const u32x4*)(up + FF + f0); v1 = seq0 ? z : *(const u32x4*)(up + FF2 + FF + f0); v0 = *(const u32x4*)(uc + 2 * FF2 + FF + f0); }
        else         { g2 = seq0 ? z : *(const u32x4*)(up + FF2 + f0); g1 = *(const u32x4*)(uc + 2 * FF2 + f0); g0 = *(const u32x4*)(uc + 3 * FF2 + f0);
                       v2 = seq0 ? z : *(const u32x4*)(up + FF2 + FF + f0); v1 = *(const u32x4*)(uc + 2 * FF2 + FF + f0); v0 = *(const u32x4*)(uc + 3 * FF2 + FF + f0); }
        u32x4 o;
#pragma unroll
        for (int j = 0; j < 4; ++j) { float r[2];
#pragma unroll
            for (int hl = 0; hl < 2; ++hl) { const int c = f0 + 2 * j + hl;
                const float ug2 = hl ? bfhi(g2[j]) : bflo(g2[j]), ug1 = hl ? bfhi(g1[j]) : bflo(g1[j]), ug0 = hl ? bfhi(g0[j]) : bflo(g0[j]);
                const float uv2 = hl ? bfhi(v2[j]) : bflo(v2[j]), uv1 = hl ? bfhi(v1[j]) : bflo(v1[j]), uv0 = hl ? bfhi(v0[j]) : bflo(v0[j]);
                const float cg = cb[c] + cw[c] * ug2 + cw[FF2 + c] * ug1 + cw[2 * FF2 + c] * ug0;
                const float cv = cb[FF + c] + cw[FF + c] * uv2 + cw[FF2 + FF + c] * uv1 + cw[2 * FF2 + FF + c] * uv0;
                r[hl] = gelu_tanh(cg) * cv; }
            o[j] = cvt_pk_bf16(r[0], r[1]); }
        *(u32x4*)(A + (size_t)t * FF + f0) = o;
    }
}
__device__ __forceinline__ void ph_scan(const Ctx& C, const bf16* U, bf16* RT) {
    for (long it = C.gt; it < (long)RH * RDV * 2 * 128; it += C.NGT) {
        const int row = (int)(it >> 8), b = (int)(it >> 7) & 1, d0 = (int)(it & 127) * 2, h = row / RDV; const float gl = fast_exp2((float)RL * log2g(h));
        unsigned off = ((unsigned)row * NTOK + (unsigned)b * SEQ + (unsigned)d0) * 2u; float r0 = 0.f, r1 = 0.f;
        unsigned w[8];
#pragma unroll
        for (int i = 0; i < 8; ++i) w[i] = pg8::ldo<unsigned>(U, off + (unsigned)i * (RL * 2));
#pragma unroll 1
        for (int g = 0; g < SEQ / RL / 8; ++g, off += 8 * RL * 2) {
            unsigned n[8];
            if (g + 1 < SEQ / RL / 8) {
#pragma unroll
                for (int i = 0; i < 8; ++i) n[i] = pg8::ldo<unsigned>(U, off + 8 * RL * 2 + (unsigned)i * (RL * 2)); }
            else {
#pragma unroll
                for (int i = 0; i < 8; ++i) n[i] = 0u; }
#pragma unroll
            for (int i = 0; i < 8; ++i) {
                pg8::sto<unsigned>(RT, off + (unsigned)i * (RL * 2), cvt_pk_bf16(r0, r1));
                r0 = gl * (r0 + bflo(w[i])); r1 = gl * (r1 + bfhi(w[i])); }
#pragma unroll
            for (int i = 0; i < 8; ++i) w[i] = n[i];
        }
    }
}
__device__ __forceinline__ void ph_groupnorm(const Ctx& C, const bf16* Y, bf16* G) {
    u32x4 yw[8], gw[8];
    const int step = C.NGW * 8; int it0 = C.gw * 8;
    if (it0 < NTOK * RH) {
#pragma unroll
        for (int k = 0; k < 8; ++k) { const unsigned off = ((unsigned)(it0 + k) * RDV + 8u * C.lane) * 2u; yw[k] = *(const u32x4*)((const char*)Y + off); gw[k] = *(const u32x4*)((const char*)G + off); } }
#pragma unroll 1
    for (; it0 < NTOK * RH; it0 += step) {
        u32x4 yn[8], gn[8]; const int nx = it0 + step;
        if (nx < NTOK * RH) {
#pragma unroll
            for (int k = 0; k < 8; ++k) { const unsigned off = ((unsigned)(nx + k) * RDV + 8u * C.lane) * 2u; yn[k] = *(const u32x4*)((const char*)Y + off); gn[k] = *(const u32x4*)((const char*)G + off); } }
        else {
#pragma unroll
            for (int k = 0; k < 8; ++k) { yn[k] = (u32x4){0u, 0u, 0u, 0u}; gn[k] = (u32x4){0u, 0u, 0u, 0u}; } }
#pragma unroll
        for (int k = 0; k < 8; ++k) { const int it = it0 + k, tok = it >> 3, h = it & 7, n = tok & (RL - 1); const float xi = fast_exp2((float)(n + 1) * log2g(h));
            float y[8]; float s = 0.f;
#pragma unroll
            for (int j = 0; j < 4; ++j) { y[2 * j] = bflo(yw[k][j]) * xi; y[2 * j + 1] = bfhi(yw[k][j]) * xi; s += y[2 * j] + y[2 * j + 1]; }
            const float mean = wave_sum(s, C.lane) * (1.f / RDV); float s2 = 0.f;
#pragma unroll
            for (int j = 0; j < 8; ++j) { y[j] -= mean; s2 += y[j] * y[j]; }
            const float rstd = 1.f / sqrtf(wave_sum(s2, C.lane) * (1.f / RDV) + GN_EPS);
            u32x4 o;
#pragma unroll
            for (int j = 0; j < 4; ++j) o[j] = cvt_pk_bf16(bflo(gw[k][j]) * y[2 * j] * rstd, bfhi(gw[k][j]) * y[2 * j + 1] * rstd);
            *(u32x4*)((char*)G + ((unsigned)it * RDV + 8u * C.lane) * 2u) = o; }
#pragma unroll
        for (int k = 0; k < 8; ++k) { yw[k] = yn[k]; gw[k] = gn[k]; }
    }
}

__global__ void __launch_bounds__(NWAVES * 64, 2) fwd(Args args) {
    extern __shared__ __attribute__((aligned(16))) unsigned char lds_raw[];
    LAS unsigned char* const lds0 = (LAS unsigned char*)lds_raw;
    volatile LAS unsigned* MISC = (volatile LAS unsigned*)(lds0 + MISC_OFF);
    for (int u = threadIdx.x; u < (LDS_BYTES - LDSCTL_OFF) / 4; u += NWAVES * 64) ((LAS unsigned*)(lds0 + LDSCTL_OFF))[u] = 0u;
    __syncthreads();
    XcdBarrier bar = xcd_barrier_post((unsigned*)(args.ws + WS_CTL) + CW_BAR, MISC + 8);
    const int lo = args.ph_lo, hi = args.ph_hi;
    const int wave0 = __builtin_amdgcn_readfirstlane(threadIdx.x >> 6);
    int pc = 0;
#define PH_BEGIN { const int pid_ = pc++; if (lo <= pid_ && pid_ < hi) { int lane_; asm volatile("v_mbcnt_lo_u32_b32 %0, -1, 0\n\tv_mbcnt_hi_u32_b32 %0, -1, %0" : "=v"(lane_)); \
        const __attribute__((address_space(4))) unsigned long long* ap_ = (const __attribute__((address_space(4))) unsigned long long*)__builtin_amdgcn_kernarg_segment_ptr(); asm volatile("" : "+s"(ap_)); \
        Args args;   \
        _Pragma("unroll") for (int i_ = 0; i_ < 14; ++i_) args.in[i_] = (const float*)(GAS const float*)ap_[i_]; args.out = (float*)(GAS float*)ap_[14]; args.ph_lo = 0; args.ph_hi = 0; \
        GAS unsigned char* wsg_ = (GAS unsigned char*)ap_[15]; asm volatile("" : "+s"(wsg_)); args.ws = (unsigned char*)wsg_; unsigned char* ws = args.ws;     \
        Ctx C; C.lds = lds0; C.tid = wave0 * 64 + lane_; C.lane = lane_; C.wave = wave0; { int b_ = blockIdx.x, g_ = gridDim.x; asm volatile("" : "+s"(b_), "+s"(g_)); C.bid = b_; C.G = g_; } \
        C.gw = C.bid * NWAVES + C.wave; C.NGW = C.G * NWAVES; C.gt = C.bid * (NWAVES * 64) + C.tid; C.NGT = C.G * NWAVES * 64; \
        float* Hb = args.out; bf16* HN = (bf16*)(ws + WS_HN); pg8::StaticOrder S; (void)Hb; (void)HN; (void)S;
#define PH_END   if (pid_ + 1 < hi) xcd_barrier(bar); } }
#define SUB(...) { GAS unsigned char* wsg2_ = (GAS unsigned char*)ws; asm volatile("" : "+s"(wsg2_), "+s"(C.bid), "+s"(C.G)); unsigned char* ws_ = (unsigned char*)wsg2_; int lane2_; asm volatile("v_mbcnt_lo_u32_b32 %0, -1, 0\n\tv_mbcnt_hi_u32_b32 %0, -1, %0" : "=v"(lane2_)); \
        C.tid = wave0 * 64 + lane2_; C.lane = lane2_; { unsigned char* ws = ws_; bf16* HN = (bf16*)(ws + WS_HN); (void)HN; __VA_ARGS__ } }

#define SPART ((f32x2*)(ws + WS_STATS))
#define FSTATS ((f32x2*)(ws + WS_FSTATS))
#define GWV ((const float*)(ws + WS_GW))
#define BWV ((const float*)(ws + WS_GW) + NCOLT)
#define RED ((LAS f32x2*)(C.lds + RING_BYTES))
#define LNG(i) (args.in[12] + (size_t)(i) * DM)
#define LNB(i) (args.in[13] + (size_t)(i) * DM)
#define TABA ((const f32x2*)(ws + WS_TABA))
#define TABR ((const f32x2*)(ws + WS_TABR))
#define KM ((float*)(ws + WS_KMEAN))

    PH_BEGIN ph_prologue(C, args); PH_END
    PH_BEGIN ph_fold_reduce(C, (const float*)(ws + WS_GWP), (float*)(ws + WS_GW)); PH_END

    for (int l = 0; l < 4; ++l) {
        const int j = l >> 1;
        if ((l & 1) == 0) {
#define QKV ((bf16*)(ws + A_QKV))
#define MO ((bf16*)(ws + A_MO))
            PH_BEGIN { const pg8::Desc g = pg8::plain_desc(HN, (const bf16*)(ws + W_MQKV) + (size_t)j * 3 * DM * DM, NTOK, 3 * DM, DM);
                S.init(g.nM, g.nN, C.G, C.bid); pg8::EpiMobaQKV E{QKV, TABA, {FSTATS, GWV + (l == 0 ? CO_ID : CO_M1), BWV + (l == 0 ? CO_ID : CO_M1)}}; pg8::gemm_phase(C.lds, C.tid, g, S, E); } PH_END
            PH_BEGIN ph_kmean(C, QKV, KM); PH_END
            PH_BEGIN ph_moba_route(C, QKV, KM, (unsigned*)(ws + WS_CTL) + CW_CNT + j * 1024, (unsigned*)(ws + A_MLIST)); PH_END
            PH_BEGIN ph_moba_sel(C, QKV, (const unsigned*)(ws + WS_CTL) + CW_CNT + j * 1024, (const unsigned*)(ws + A_MLIST), (bf16*)(ws + A_MPO), (f32x2*)(ws + A_MPML)); PH_END
            PH_BEGIN ph_moba_own(C, QKV, (const bf16*)(ws + A_MPO), (const f32x2*)(ws + A_MPML), MO); PH_END
            PH_BEGIN { const pg8::Desc g = pg8::plain_desc(MO, (const bf16*)(ws + W_MO) + (size_t)j * DM * DM, NTOK, DM, DM);
                S.init(g.nM, g.nN, C.G, C.bid); pg8::EpiResLN E{args.in[0], HN, l == 0 ? nullptr : FSTATS, SPART, LNG(l == 0 ? 0 : 2 * l - 1), LNB(l == 0 ? 0 : 2 * l - 1), ALPHA, RED, C.tid, (unsigned*)(ws + WS_CTL) + CW_PANEL + (2 * l) * 4096, FSTATS};
                pg8::gemm_phase(C.lds, C.tid, g, S, E); } PH_END
        } else {
#define RQ ((bf16*)(ws + A_RQ))
#define RK ((bf16*)(ws + A_RK))
#define RKT ((bf16*)(ws + A_RKT))
#define RVT ((bf16*)(ws + A_RVT))
#define RG ((bf16*)(ws + A_RG))
#define RP ((bf16*)(ws + A_RP))
#define RU ((bf16*)(ws + A_RU))
#define RRT ((bf16*)(ws + A_RRT))
#define Wq ((const bf16*)(ws + W_RQ) + (size_t)j * DM * DM)
#define Wk ((const bf16*)(ws + W_RK) + (size_t)j * DM * DM)
#define Wv ((const bf16*)(ws + W_RV) + (size_t)j * 2 * DM * DM)
#define Wg ((const bf16*)(ws + W_RG) + (size_t)j * 2 * DM * DM)
            PH_BEGIN {
                SUB({ const pg8::Desc g = pg8::plain_desc(HN, Wq, NTOK, DM, DM); S.init(g.nM, g.nN, C.G, C.bid); pg8::EpiRopeNat256<false> E{RQ, DM, TABR, 1.0f, {FSTATS, GWV + CO_R + j * 12288, BWV + CO_R + j * 12288}, nullptr}; pg8::gemm_phase(C.lds, C.tid, g, S, E); })
                SUB({ const pg8::Desc g = pg8::plain_desc(HN, Wk, NTOK, DM, DM); S.init(g.nM, g.nN, C.G, C.bid); pg8::EpiRopeNat256<true> E{RK, DM, TABR, 0.0625f, {FSTATS, GWV + CO_R + j * 12288 + 2048, BWV + CO_R + j * 12288 + 2048}, RKT}; pg8::gemm_phase(C.lds, C.tid, g, S, E); })
                SUB({ const pg8::Desc g = pg8::plain_desc(HN, Wg, NTOK, 2 * DM, DM); S.init(g.nM, g.nN, C.G, C.bid); pg8::EpiAct<1, true> E{RG, 2 * DM, {FSTATS, GWV + CO_R + j * 12288 + 8192, BWV + CO_R + j * 12288 + 8192}}; pg8::gemm_phase(C.lds, C.tid, g, S, E); })
                SUB({ const pg8::Desc g = pg8::plain_desc(Wv, HN, 2 * DM, NTOK, DM); S.init(g.nM, g.nN, C.G, C.bid); pg8::EpiVT E{RVT, NTOK, {FSTATS, GWV + CO_R + j * 12288 + 4096, BWV + CO_R + j * 12288 + 4096}}; pg8::gemm_phase(C.lds, C.tid, g, S, E); })
            } PH_END
            PH_BEGIN {
                SUB({
                    pg8::Desc g; g.A = RQ; g.B = RK; g.A2 = RQ; g.B2 = RK; g.lda = DM; g.ldb = DM; g.sAm = 256L * DM; g.sAn = 256; g.sBm = 256L * DM; g.sBn = 256;
                    g.shAm = 0; g.shAn = 0; g.shBm = 0; g.shBn = 0; g.nM = NTOK / 256; g.nN = RH; g.nt = RDK / 64; g.nt1 = g.nt;
                    S.init(g.nM, g.nN, C.G, C.bid); pg8::EpiAct<2, false> E{RP, DM, {nullptr, nullptr, nullptr}}; pg8::gemm_phase(C.lds, C.tid, g, S, E); })
                SUB({
                    pg8::Desc g; g.A = RVT; g.B = RKT; g.A2 = RVT; g.B2 = RKT; g.lda = NTOK; g.ldb = NTOK; g.sAm = 256L * NTOK; g.sAn = 256; g.sBm = 256L * NTOK; g.sBn = 256;
                    g.shAm = 0; g.shAn = 0; g.shBm = 1; g.shBn = 0; g.nM = RH * RDV / 256; g.nN = NTOK / 256; g.nt = RL / 64; g.nt1 = g.nt;
                    S.init(g.nM, g.nN, C.G, C.bid); pg8::EpiBf16 E{RU, NTOK}; pg8::gemm_phase(C.lds, C.tid, g, S, E); })
            } PH_END
            PH_BEGIN ph_scan(C, RU, RRT); PH_END
            PH_BEGIN {
                pg8::Desc g; g.A = RP; g.A2 = RQ; g.B = RVT; g.B2 = RRT; g.lda = DM; g.ldb = NTOK; g.sAm = 256L * DM; g.sAn = 256; g.sBm = 256; g.sBn = 256L * NTOK;
                g.shAm = 0; g.shAn = 1; g.shBm = 0; g.shBn = 0; g.nM = NTOK / 256; g.nN = RH * RDV / 256; g.nt = 8; g.nt1 = 4;
                S.init(g.nM, g.nN, C.G, C.bid); pg8::EpiBf16 E{RU, 2 * DM}; pg8::gemm_phase(C.lds, C.tid, g, S, E); } PH_END
            PH_BEGIN ph_groupnorm(C, RU, RG); PH_END
            PH_BEGIN { const pg8::Desc g = pg8::plain_desc(RG, (const bf16*)(ws + W_RO) + (size_t)j * 2 * DM * DM, NTOK, DM, 2 * DM);
                S.init(g.nM, g.nN, C.G, C.bid); pg8::EpiResLN E{args.in[0], HN, FSTATS, SPART, LNG(2 * l - 1), LNB(2 * l - 1), ALPHA, RED, C.tid, (unsigned*)(ws + WS_CTL) + CW_PANEL + (2 * l) * 4096, FSTATS}; pg8::gemm_phase(C.lds, C.tid, g, S, E); } PH_END
        }
#define FU ((bf16*)(ws + A_U))
#define FA ((bf16*)(ws + A_FA))
        PH_BEGIN { const pg8::Desc g = pg8::plain_desc(HN, (const bf16*)(ws + W_FI) + (size_t)l * FF2 * DM, NTOK, FF2, DM);
            S.init(g.nM, g.nN, C.G, C.bid); pg8::EpiConv E{FA, FU, args.in[9] + (size_t)l * 3 * FF2, args.in[10] + (size_t)l * FF2, {FSTATS, GWV + CO_F + l * 11264, BWV + CO_F + l * 11264}};
            pg8::gemm_phase(C.lds, C.tid, g, S, E); } PH_END
        PH_BEGIN ph_conv_fix(C, FU, FA, args.in[9] + (size_t)l * 3 * FF2, args.in[10] + (size_t)l * FF2); PH_END
        PH_BEGIN { const pg8::Desc g = pg8::plain_desc(FA, (const bf16*)(ws + W_FO) + (size_t)l * FF * DM, NTOK, DM, FF);
            S.init(g.nM, g.nN, C.G, C.bid); pg8::EpiResLN E{args.in[0], HN, FSTATS, SPART, LNG(2 * l), LNB(2 * l), ALPHA, RED, C.tid, (unsigned*)(ws + WS_CTL) + CW_PANEL + (2 * l + 1) * 4096, FSTATS}; pg8::gemm_phase(C.lds, C.tid, g, S, E); } PH_END
    }
    PH_BEGIN ph_ln_final(C, HN, Hb, LNG(7), LNB(7)); PH_END
#undef PH_BEGIN
#undef PH_END
}
constexpr int N_PHASES = 2 + 2 * (6 + 3) + 2 * (6 + 3) + 1;

extern "C" void kernel_launch(void* const* d_in, const int* in_sizes, int n_in, void* d_out, int out_size, void* d_ws, size_t ws_size, hipStream_t stream) {
    static int grid = 0;
    if (grid == 0) {
        if (n_in != 14 || out_size != NTOK * DM || ws_size < WS_NEED) { fprintf(stderr, "kernel_launch: unexpected shapes (n_in %d out %d ws %zu)\n", n_in, out_size, ws_size); grid = -1; return; }
        int dev = 0, cus = 0, per_cu = 0;
        if (hipGetDevice(&dev) != hipSuccess || hipDeviceGetAttribute(&cus, hipDeviceAttributeMultiprocessorCount, dev) != hipSuccess) { grid = -1; return; }
        if (hipFuncSetAttribute((const void*)fwd, hipFuncAttributeMaxDynamicSharedMemorySize, LDS_BYTES) != hipSuccess) { fprintf(stderr, "kernel_launch: hipFuncSetAttribute failed\n"); grid = -1; return; }
        if (hipOccupancyMaxActiveBlocksPerMultiprocessor(&per_cu, (const void*)fwd, NWAVES * 64, LDS_BYTES) != hipSuccess || per_cu < 1)
            fprintf(stderr, "kernel_launch: occupancy query reports %d workgroups per CU\n", per_cu);
        (void)hipGetLastError();
        grid = cus;
    }
    if (grid < 0) return;
    (void)hipMemsetAsync((char*)d_ws + WS_CTL, 0, CTL_ZERO_BYTES, stream);
    Args a{};
    for (int i = 0; i < 14; ++i) a.in[i] = (const float*)d_in[i];
    a.out = (float*)d_out; a.ws = (unsigned char*)d_ws;
#if MK_ONE_LAUNCH
    a.ph_lo = 0; a.ph_hi = N_PHASES;
    hipLaunchKernelGGL(fwd, dim3(grid), dim3(NWAVES * 64), LDS_BYTES, stream, a);
#else
    for (int p = 0; p < N_PHASES; ++p) { a.ph_lo = p; a.ph_hi = p + 1; hipLaunchKernelGGL(fwd, dim3(grid), dim3(NWAVES * 64), LDS_BYTES, stream, a); }
#endif
}
```
